# Optimizing an MI355X kernel written in HIP

```python
import jax, jax.numpy as jnp
from jax import lax
import numpy as np

D_MODEL = 1024
BATCH = 32
SEQ = 2048
DEPTH = 2

CHUNK = 64
N_BRANCH = 4
D_MIX = 512
LRU_BLOCKS = 8
LRU_BLOCK = D_MIX // LRU_BLOCKS
LRU_CONV = 4
LRU_C = 8.0
SCONV_WIDTH = 3
RWKV_HEAD = 64
RWKV_HEADS = D_MIX // RWKV_HEAD
DECAY_LORA = 64
ICLR_LORA = 64
GATE_LORA = 128
GN_EPS = RWKV_HEAD * 1e-5
ATT_HEAD = 64
ATT_HEADS = D_MIX // ATT_HEAD
LEFT_CHUNKS = 8
BAND = (LEFT_CHUNKS + 1) * CHUNK
REL_CLIP = 128
NEG_INF = -1e30
D_FF = 4 * D_MODEL
D_PLE = 256
ALPHA = (2 * DEPTH) ** 0.25
BETA = (8 * DEPTH) ** -0.25
LN_EPS = 1e-5
COLS_A = 2 * D_MIX
COLS_B = 3 * D_MIX
COLS_C = 3 * D_MIX + DECAY_LORA + ICLR_LORA + GATE_LORA
COLS_D = 3 * D_MIX
IN_COLS = COLS_A + COLS_B + COLS_C + COLS_D
IN_SPLITS = (COLS_A, COLS_A + COLS_B, COLS_A + COLS_B + COLS_C)
RWKV_SPLITS = (D_MIX, 2 * D_MIX, 3 * D_MIX, 3 * D_MIX + DECAY_LORA, 3 * D_MIX + DECAY_LORA + ICLR_LORA)

kernel_name = 'hybrid_gated_streaming_encoder'


def layer_norm(x, g, b):
    xf = x.astype(jnp.float32)
    mu = xf.mean(-1, keepdims=True)
    var = jnp.square(xf - mu).mean(-1, keepdims=True)
    return ((xf - mu) * lax.rsqrt(var + LN_EPS) * g + b).astype(x.dtype)


def causal_dwconv(x, w):
    k_width, chans = w.shape
    return lax.conv_general_dilated(x, w[:, None, :], window_strides=(1,), padding=[(k_width - 1, 0)],
                                    dimension_numbers=('NWC', 'WIO', 'NWC'), feature_group_count=chans)


def token_shift(z):
    return jnp.pad(z, ((0, 0), (1, 0), (0, 0)))[:, :-1]


def _linear_combine(left, right):
    a_l, b_l = left
    a_r, b_r = right
    return a_l * a_r, a_r * b_l + b_r


def rglru_branch(xa, ya, conv_w, conv_b, wr, br, wi, bi, lam):
    bsz, seq, _ = xa.shape
    xc = causal_dwconv(xa, conv_w) + conv_b
    xg = xc.reshape(bsz, seq, LRU_BLOCKS, LRU_BLOCK)
    r = jax.nn.sigmoid(jnp.einsum('bsgi,gij->bsgj', xg, wr).reshape(bsz, seq, D_MIX) + br)
    i = jax.nn.sigmoid(jnp.einsum('bsgi,gij->bsgj', xg, wi).reshape(bsz, seq, D_MIX) + bi)
    log_a = -LRU_C * r.astype(jnp.float32) * jax.nn.softplus(-lam.astype(jnp.float32))
    a = jnp.exp(log_a)
    u = (i * xc).astype(jnp.float32) * jnp.sqrt(-jnp.expm1(2.0 * log_a))
    _, h = lax.associative_scan(_linear_combine, (a, u), axis=1)
    return h.astype(xa.dtype) * jax.nn.gelu(ya, approximate=True)


def short_conv_branch(b_gate, c_gate, xh, conv_w):
    return b_gate * causal_dwconv(c_gate * xh, conv_w)


def rwkv7_branch(z, mu, w0, w2, a0, a2, g2, k_k, k_a, r_k, gn_g, gn_b):
    bsz, seq, _ = z.shape
    f32 = jnp.float32
    z = z + (token_shift(z) - z) * mu
    r, k, v, wd, ad, gd = jnp.split(z, RWKV_SPLITS, axis=-1)
    w_log = -jax.nn.softplus(-(w0 + jnp.tanh(wd) @ w2).astype(f32)) - 0.5
    decay = jnp.exp(-jnp.exp(w_log))
    a = jax.nn.sigmoid(a0 + ad @ a2)
    g = jax.nn.sigmoid(gd) @ g2

    def heads(t):
        return t.astype(f32).reshape(bsz, seq, RWKV_HEADS, RWKV_HEAD)

    kk = heads(k * k_k)
    kk = kk / jnp.maximum(jnp.sqrt(jnp.sum(kk * kk, axis=-1, keepdims=True)), 1e-12)
    k = heads(k * (1.0 + (a - 1.0) * k_a))
    r, v, a, decay = heads(r), heads(v), heads(a), heads(decay)

    def time_major(t):
        return jnp.moveaxis(t, 1, 0)

    def step(state, inp):
        r_t, w_t, k_t, v_t, a_t, b_t = inp
        sa = jnp.einsum('bhvk,bhk->bhv', state, a_t)
        state = (state * w_t[:, :, None, :] + sa[..., None] * b_t[:, :, None, :]
                 + v_t[..., None] * k_t[:, :, None, :])
        return state, jnp.einsum('bhvk,bhk->bhv', state, r_t)

    state0 = jnp.zeros((bsz, RWKV_HEADS, RWKV_HEAD, RWKV_HEAD), f32)
    _, o = lax.scan(step, state0, (time_major(r), time_major(decay), time_major(k), time_major(v),
                                   time_major(-kk), time_major(kk * a)))
    o = jnp.moveaxis(o, 0, 1)
    mean = o.mean(-1, keepdims=True)
    var = jnp.square(o - mean).mean(-1, keepdims=True)
    o = ((o - mean) * lax.rsqrt(var + GN_EPS) * gn_g.reshape(RWKV_HEADS, RWKV_HEAD)
         + gn_b.reshape(RWKV_HEADS, RWKV_HEAD))
    o = o + jnp.sum(r * k * r_k, axis=-1, keepdims=True) * v
    return (o.reshape(bsz, seq, D_MIX) * g).astype(z.dtype)


def chunk_attention(q, k, v, rel_bias):
    bsz, seq, _ = q.shape
    n_chunks = seq // CHUNK

    def heads(t):
        return t.reshape(bsz, seq, ATT_HEADS, ATT_HEAD).transpose(0, 2, 1, 3)

    q = heads(q) * (ATT_HEAD ** -0.5)
    pad = ((0, 0), (0, 0), (BAND - CHUNK, 0), (0, 0))
    k = jnp.pad(heads(k), pad)
    v = jnp.pad(heads(v), pad)
    rel = (BAND - CHUNK) + np.arange(CHUNK)[:, None] - np.arange(BAND)[None, :]
    bias = rel_bias[:, np.clip(rel, -REL_CLIP, REL_CLIP) + REL_CLIP].astype(jnp.float32)
    band_offsets = jnp.arange(BAND)

    def one_chunk(c):
        start = c * CHUNK
        qc = lax.dynamic_slice_in_dim(q, start, CHUNK, axis=2)
        kc = lax.dynamic_slice_in_dim(k, start, BAND, axis=2)
        vc = lax.dynamic_slice_in_dim(v, start, BAND, axis=2)
        s = jnp.einsum('bhqd,bhkd->bhqk', qc, kc).astype(jnp.float32) + bias
        valid = (start - (BAND - CHUNK) + band_offsets) >= 0
        s = jnp.where(valid, s, NEG_INF)
        pr = jax.nn.softmax(s, axis=-1).astype(vc.dtype)
        return jnp.einsum('bhqk,bhkd->bhqd', pr, vc)

    o = lax.map(one_chunk, jnp.arange(n_chunks))
    return o.transpose(1, 0, 3, 2, 4).reshape(bsz, seq, D_MIX)


def setup_inputs(seed: int = 0) -> dict:
    key = jax.random.key(seed)
    keys = iter(jax.random.split(key, 48))
    f32 = jnp.float32
    L = DEPTH

    def nrm(shape, scale):
        return jax.random.normal(next(keys), shape, f32) * scale

    x = nrm((BATCH, SEQ, D_MODEL), 1.0)
    p = nrm((DEPTH, BATCH, SEQ, D_PLE), 1.0)
    w_in = nrm((L, D_MODEL, IN_COLS), D_MODEL ** -0.5)
    lru_conv_w = nrm((L, LRU_CONV, D_MIX), LRU_CONV ** -0.5)
    lru_conv_b = nrm((L, D_MIX), 0.01)
    lru_wr = nrm((L, LRU_BLOCKS, LRU_BLOCK, LRU_BLOCK), LRU_BLOCK ** -0.5)
    lru_br = nrm((L, D_MIX), 0.01)
    lru_wi = nrm((L, LRU_BLOCKS, LRU_BLOCK, LRU_BLOCK), LRU_BLOCK ** -0.5)
    lru_bi = nrm((L, D_MIX), 0.01)
    a_pow = jax.random.uniform(next(keys), (L, D_MIX), f32, 0.9, 0.999)
    s_lam = a_pow ** (1.0 / LRU_C)
    lru_lambda = jnp.log(s_lam) - jnp.log1p(-s_lam)
    sconv_w = nrm((L, SCONV_WIDTH, D_MIX), SCONV_WIDTH ** -0.5)
    rwkv_mu = jax.random.uniform(next(keys), (L, COLS_C), f32)
    rwkv_w0 = jax.random.uniform(next(keys), (L, D_MIX), f32, -6.0, -1.0)
    rwkv_w2 = nrm((L, DECAY_LORA, D_MIX), 0.1)
    rwkv_a0 = nrm((L, D_MIX), 0.1)
    rwkv_a2 = nrm((L, ICLR_LORA, D_MIX), ICLR_LORA ** -0.5)
    rwkv_g2 = nrm((L, GATE_LORA, D_MIX), GATE_LORA ** -0.5)
    rwkv_k_k = 0.85 + nrm((L, D_MIX), 0.02)
    rwkv_k_a = 1.0 + nrm((L, D_MIX), 0.02)
    rwkv_r_k = nrm((L, RWKV_HEADS, RWKV_HEAD), 0.1)
    rwkv_gn_g = 1.0 + nrm((L, D_MIX), 0.02)
    rwkv_gn_b = nrm((L, D_MIX), 0.01)
    rel_bias = nrm((ATT_HEADS, 2 * REL_CLIP + 1), 0.5)
    w_branch = nrm((L, N_BRANCH, D_MIX, D_MODEL), D_MIX ** -0.5 * BETA)
    w_gate = nrm((L, N_BRANCH, D_MODEL, D_MODEL), D_MODEL ** -0.5)
    b_gate = nrm((L, N_BRANCH, D_MODEL), 0.01)
    w_out = nrm((L, D_MODEL, D_MODEL), D_MODEL ** -0.5 * BETA)
    ln1_g = 1.0 + nrm((L, D_MODEL), 0.02)
    ln1_b = nrm((L, D_MODEL), 0.01)
    w_ff1 = nrm((L, D_MODEL, D_FF), D_MODEL ** -0.5)
    w_ff2 = nrm((L, D_FF, D_MODEL), D_FF ** -0.5 * BETA)
    w_ple = nrm((L, D_PLE, D_MODEL), D_PLE ** -0.5)
    w_ple_gate = nrm((L, D_MODEL, D_MODEL), D_MODEL ** -0.5)
    b_ple_gate = nrm((L, D_MODEL), 0.01)
    ln2_g = 1.0 + nrm((L, D_MODEL), 0.02)
    ln2_b = nrm((L, D_MODEL), 0.01)
    return {'x': x, 'p': p, 'w_in': w_in,
            'lru_conv_w': lru_conv_w, 'lru_conv_b': lru_conv_b, 'lru_wr': lru_wr, 'lru_br': lru_br,
            'lru_wi': lru_wi, 'lru_bi': lru_bi, 'lru_lambda': lru_lambda,
            'sconv_w': sconv_w,
            'rwkv_mu': rwkv_mu, 'rwkv_w0': rwkv_w0, 'rwkv_w2': rwkv_w2, 'rwkv_a0': rwkv_a0,
            'rwkv_a2': rwkv_a2, 'rwkv_g2': rwkv_g2, 'rwkv_k_k': rwkv_k_k, 'rwkv_k_a': rwkv_k_a,
            'rwkv_r_k': rwkv_r_k, 'rwkv_gn_g': rwkv_gn_g, 'rwkv_gn_b': rwkv_gn_b,
            'rel_bias': rel_bias, 'w_branch': w_branch, 'w_gate': w_gate, 'b_gate': b_gate,
            'w_out': w_out, 'ln1_g': ln1_g, 'ln1_b': ln1_b, 'w_ff1': w_ff1, 'w_ff2': w_ff2,
            'w_ple': w_ple, 'w_ple_gate': w_ple_gate, 'b_ple_gate': b_ple_gate,
            'ln2_g': ln2_g, 'ln2_b': ln2_b}


def reference(x, p, w_in, lru_conv_w, lru_conv_b, lru_wr, lru_br, lru_wi, lru_bi, lru_lambda,
              sconv_w, rwkv_mu, rwkv_w0, rwkv_w2, rwkv_a0, rwkv_a2, rwkv_g2, rwkv_k_k, rwkv_k_a,
              rwkv_r_k, rwkv_gn_g, rwkv_gn_b, rel_bias, w_branch, w_gate, b_gate, w_out, ln1_g, ln1_b,
              w_ff1, w_ff2, w_ple, w_ple_gate, b_ple_gate, ln2_g, ln2_b):
    for l in range(DEPTH):
        h = x @ w_in[l]
        h_a, h_b, h_c, h_d = jnp.split(h, IN_SPLITS, axis=-1)
        xa, ya = jnp.split(h_a, 2, axis=-1)
        y_a = rglru_branch(xa, ya, lru_conv_w[l], lru_conv_b[l], lru_wr[l], lru_br[l],
                           lru_wi[l], lru_bi[l], lru_lambda[l])
        b_g, c_g, xh = jnp.split(h_b, 3, axis=-1)
        y_b = short_conv_branch(b_g, c_g, xh, sconv_w[l])
        y_c = rwkv7_branch(h_c, rwkv_mu[l], rwkv_w0[l], rwkv_w2[l], rwkv_a0[l], rwkv_a2[l], rwkv_g2[l],
                           rwkv_k_k[l], rwkv_k_a[l], rwkv_r_k[l], rwkv_gn_g[l], rwkv_gn_b[l])
        q, k, v = jnp.split(h_d, 3, axis=-1)
        y_d = chunk_attention(q, k, v, rel_bias)
        branches = (y_a, y_b, y_c, y_d)
        merged = jax.nn.sigmoid(x @ w_gate[l, 0] + b_gate[l, 0]) * (branches[0] @ w_branch[l, 0])
        for n in range(1, N_BRANCH):
            merged = merged + jax.nn.sigmoid(x @ w_gate[l, n] + b_gate[l, n]) * (branches[n] @ w_branch[l, n])
        x = layer_norm(ALPHA * x + merged @ w_out[l], ln1_g[l], ln1_b[l])
        ff = jnp.square(jax.nn.relu(x @ w_ff1[l])) @ w_ff2[l]
        ple = (p[l] @ w_ple[l]) * jax.nn.sigmoid(x @ w_ple_gate[l] + b_ple_gate[l])
        x = layer_norm(ALPHA * x + ff + ple, ln2_g[l], ln2_b[l])
    return x
```

```cpp
#include <hip/hip_runtime.h>
#include <hip/hip_cooperative_groups.h>
#include <cstdio>
#include <cstdint>
namespace cg = cooperative_groups;

#ifndef REPK
#define REPK -1
#endif
#ifndef REPN
#define REPN 1
#endif
#ifndef REP_LRU
#define REP_LRU 1
#endif
#ifndef REP_RWKV
#define REP_RWKV 1
#endif
#ifndef REP_SV
#define REP_SV 1
#endif
#ifndef ONE_LAUNCH
#define ONE_LAUNCH 1
#endif

#define LAS __attribute__((address_space(3)))
typedef unsigned short bf16_t;
typedef short bf16x8 __attribute__((ext_vector_type(8)));
typedef short bf16x4 __attribute__((ext_vector_type(4)));
typedef float f32x4 __attribute__((ext_vector_type(4)));
typedef float f32x2 __attribute__((ext_vector_type(2)));
typedef unsigned u32x4 __attribute__((ext_vector_type(4)));
typedef unsigned u32x2 __attribute__((ext_vector_type(2)));

constexpr int D = 1024, BATCH = 32, SEQ = 2048, DEPTH = 2, MTOK = BATCH * SEQ;
constexpr int DMIX = 512, INC = 5888, DFF = 4096, DPLE = 256;
constexpr int COL_A = 0, COL_B = 1024, COL_C = 2560, COL_D = 4352;
constexpr float ALPHA = 1.4142135623730951f;
constexpr float LN_EPS = 1e-5f, GN_EPS = 64e-5f;

constexpr size_t MiB = 1ull << 20;
constexpr size_t WS_XB = 0, WS_WT = 128 * MiB, WS_PB = 180 * MiB, WS_H = 212 * MiB, WS_VT = 948 * MiB;
constexpr size_t WO_IN = 0, WO_G = 6029312, WO_B = WO_G + 4194304, WO_OUT4 = WO_B + 2097152, WO_FF1 = WO_OUT4 + 4194304,
                 WO_FF2 = WO_FF1 + 4194304, WO_PLE = WO_FF2 + 4194304, WO_PLEG = WO_PLE + 262144;
constexpr int LDS_BYTES = 131072 + 16 + 8256;
constexpr size_t WS_BAR = 1012 * MiB;

struct Params {
    const float* in[36];
    float* out;
    unsigned char* ws;
};

__device__ __forceinline__ float bf2f(unsigned v) { return __uint_as_float(v << 16); }
typedef __bf16 bf16x2_t __attribute__((ext_vector_type(2)));
__device__ __forceinline__ unsigned cvt_pk_bf16(float lo, float hi) { f32x2 v = {lo, hi}; bf16x2_t b = __builtin_convertvector(v, bf16x2_t); unsigned r; __builtin_memcpy(&r, &b, 4); return r; }
__device__ __forceinline__ bf16_t f2bf(float f) { return (bf16_t)(cvt_pk_bf16(f, 0.f) & 0xffffu); }
__device__ __forceinline__ float fexp(float x) { return __builtin_amdgcn_exp2f(x * 1.4426950408889634f); }
__device__ __forceinline__ float flog(float x) { return __builtin_amdgcn_logf(x) * 0.6931471805599453f; }
__device__ __forceinline__ float ftanh(float x) { return 1.0f - 2.0f * __builtin_amdgcn_rcpf(1.0f + fexp(2.0f * x)); }
__device__ __forceinline__ float flog1p_small(float x) { return flog(1.0f + x); }
__device__ __forceinline__ float fneg_expm1(float t) { return 1.0f - fexp(t); }
__device__ __forceinline__ float sigmoidf_(float x) { return __builtin_amdgcn_rcpf(1.0f + fexp(-x)); }
__device__ __forceinline__ float wave_sum(float v) {
    v += __int_as_float(__builtin_amdgcn_update_dpp(0, __float_as_int(v), 0xB1, 0xF, 0xF, true));
    v += __int_as_float(__builtin_amdgcn_update_dpp(0, __float_as_int(v), 0x4E, 0xF, 0xF, true));
    v += __int_as_float(__builtin_amdgcn_update_dpp(0, __float_as_int(v), 0x141, 0xF, 0xF, true));
    v += __int_as_float(__builtin_amdgcn_update_dpp(0, __float_as_int(v), 0x140, 0xF, 0xF, true));
    const float s0 = __int_as_float(__builtin_amdgcn_readlane(__float_as_int(v), 0)), s1 = __int_as_float(__builtin_amdgcn_readlane(__float_as_int(v), 16));
    const float s2 = __int_as_float(__builtin_amdgcn_readlane(__float_as_int(v), 32)), s3 = __int_as_float(__builtin_amdgcn_readlane(__float_as_int(v), 48));
    return (s0 + s1) + (s2 + s3);
}
template <int N> __device__ __forceinline__ void wave_sum_n(float (&v)[N]) {
#pragma unroll
    for (int i = 0; i < N; ++i) v[i] += __int_as_float(__builtin_amdgcn_update_dpp(0, __float_as_int(v[i]), 0xB1, 0xF, 0xF, true));
#pragma unroll
    for (int i = 0; i < N; ++i) v[i] += __int_as_float(__builtin_amdgcn_update_dpp(0, __float_as_int(v[i]), 0x4E, 0xF, 0xF, true));
#pragma unroll
    for (int i = 0; i < N; ++i) v[i] += __int_as_float(__builtin_amdgcn_update_dpp(0, __float_as_int(v[i]), 0x141, 0xF, 0xF, true));
#pragma unroll
    for (int i = 0; i < N; ++i) v[i] += __int_as_float(__builtin_amdgcn_update_dpp(0, __float_as_int(v[i]), 0x140, 0xF, 0xF, true));
#pragma unroll
    for (int i = 0; i < N; ++i) v[i] += __int_as_float(__builtin_amdgcn_update_dpp(0, __float_as_int(v[i]), 0x142, 0xA, 0xF, false));
#pragma unroll
    for (int i = 0; i < N; ++i) v[i] += __int_as_float(__builtin_amdgcn_update_dpp(0, __float_as_int(v[i]), 0x143, 0xC, 0xF, false));
#pragma unroll
    for (int i = 0; i < N; ++i) v[i] = __int_as_float(__builtin_amdgcn_readlane(__float_as_int(v[i]), 63));
}
__device__ __forceinline__ float shflx(float v, int lane, int m) { return __int_as_float(__builtin_amdgcn_ds_bpermute((lane ^ m) << 2, __float_as_int(v))); }
__device__ __forceinline__ void unpack8(u32x4 u, float* f) {
#pragma unroll
    for (int i = 0; i < 4; ++i) { f[2 * i] = __uint_as_float(u[i] << 16); f[2 * i + 1] = __uint_as_float(u[i] & 0xffff0000u); }
}
__device__ __forceinline__ u32x4 pack8(const float* f) {
    u32x4 u;
#pragma unroll
    for (int i = 0; i < 4; ++i) u[i] = cvt_pk_bf16(f[2 * i], f[2 * i + 1]);
    return u;
}

namespace pg8 {
constexpr int BM = 256, BK = 64, HALF = 128, HTB = HALF * BK * 2, STAGE_BYTES = 8 * HTB, NXCD = 8, WGM = 8;
__host__ __device__ __forceinline__ int lds_byte(int r, int c) { const int st = (r >> 4) * 2 + (c >> 5), rr = r & 15, cc = c & 31, ob = rr * 64 + cc * 2; return st * 1024 + (ob ^ (((ob >> 9) & 1) << 5)); }
__host__ __device__ __forceinline__ void stage_rc(int b, int& R, int& C) { const int st = b / 1024, sb = b % 1024, swz = sb ^ (((sb >> 9) & 1) << 5); R = (st >> 1) * 16 + swz / 64; C = (st & 1) * 32 + (swz % 64) / 2; }
__host__ __device__ __forceinline__ int perm32(int rho) { const int n = rho >> 4, i = rho & 15; return 8 * (i >> 2) + 4 * n + (i & 3); }
struct Unit { int pm, pn; };
struct Gemm { const bf16_t* A; const bf16_t* Bt; int M, N, K, lda, ldb; };
struct StaticOrder {
    int nM, nN, nwg, G, c, merge;
    __device__ void init(int M, int N, int G_, int c_, int merge_) { merge = merge_; nM = M / BM; nN = (merge_ ? N / 4 : N) / BM; nwg = nM * nN; G = G_; c = c_; }
    __device__ bool next(int i, Unit& u) const {
        int n = 0; if (merge) { n = i & 3; i >>= 2; }
        const long L = (long)i * G + c; if (L >= nwg) return false;
        int wgid = (int)L; { const int q = nwg / NXCD, r = nwg % NXCD, xcd = wgid % NXCD, off = wgid / NXCD; wgid = (xcd < r ? xcd * (q + 1) : r * (q + 1) + (xcd - r) * q) + off; }
        const int nig = WGM * nN, gid = wgid / nig, fm = gid * WGM, gsz = (nM - fm) < WGM ? (nM - fm) : WGM;
        u.pm = fm + ((wgid % nig) % gsz); u.pn = (wgid % nig) / gsz + n * nN; return true;
    }
};

struct Epi {
    int mode;
    int act;
    bf16_t* ob; int ldo;
    const float* bias;
    bf16_t* io2;
    const float* resf;
    const bf16_t* aux;
    __device__ __forceinline__ void operator()(const f32x4 (&acc)[2][2][4][2], const Unit& u, int wr, int wc, int fr, int fq, LAS unsigned char* dump) const {
        int row0 = u.pm * BM + wr * 64 + fr, col0 = u.pn * BM + wc * 32 + 8 * fq;
        asm volatile("" : "+v"(row0), "+v"(col0));
        float bv[2][8];
        if (mode == 1 || mode == 3) {
#pragma unroll
            for (int bj = 0; bj < 2; ++bj) { const f32x4 b0 = *(const f32x4*)(bias + col0 + bj * HALF), b1 = *(const f32x4*)(bias + col0 + bj * HALF + 4);
#pragma unroll
                for (int j = 0; j < 4; ++j) { bv[bj][j] = b0[j]; bv[bj][4 + j] = b1[j]; } }
        }
        if (mode != 0) {
#pragma unroll
            for (int ai = 0; ai < 2; ++ai)
#pragma unroll
                for (int m = 0; m < 4; ++m)
#pragma unroll
                    for (int bj = 0; bj < 2; ++bj) {
                        const size_t row = (size_t)(row0 + ai * HALF + m * 16); const int col = col0 + bj * HALF;
                        const void* p0 = (mode == 2) ? (resf ? (const void*)(resf + row * D + col) : (const void*)(io2 + row * D + col)) : (const void*)(ob + row * ldo + col);
                        __builtin_amdgcn_global_load_lds((const unsigned*)p0, (LAS unsigned*)dump, 16, 0, 0);
                        if (mode == 2 && aux) __builtin_amdgcn_global_load_lds((const unsigned*)(aux + row * D + col), (LAS unsigned*)dump, 16, 0, 0);
                    }
        }
#pragma unroll
        for (int aim = 0; aim < 4; ++aim) {
            const int ai = aim >> 1, mh = aim & 1;
            u32x4 L0[4], L1[4];
            if (mode != 0) {
#pragma unroll
                for (int m2 = 0; m2 < 2; ++m2)
#pragma unroll
                    for (int bj = 0; bj < 2; ++bj) {
                        const int m = mh * 2 + m2;
                        const size_t row = (size_t)(row0 + ai * HALF + m * 16); const int col = col0 + bj * HALF, e = m2 * 2 + bj;
                        if (mode == 1) L0[e] = *(const u32x4*)(ob + row * ldo + col);
                        else if (mode == 3) { L0[e] = *(const u32x4*)(ob + row * ldo + col);
                            if (col >= D) L1[e] = *(const u32x4*)(io2 + row * D + (col & (D - 1))); }
                        else { if (resf) { L0[e] = *(const u32x4*)(resf + row * D + col); L1[e] = *(const u32x4*)(resf + row * D + col + 4); }
                               else { L0[e] = *(const u32x4*)(io2 + row * D + col); if (aux) L1[e] = *(const u32x4*)(aux + row * D + col); } }
                    }
            }
#pragma unroll
            for (int m2 = 0; m2 < 2; ++m2)
#pragma unroll
                for (int bj = 0; bj < 2; ++bj) {
                    const int m = mh * 2 + m2;
                    const size_t row = (size_t)(row0 + ai * HALF + m * 16); const int col = col0 + bj * HALF, e = m2 * 2 + bj;
                    float v[8];
#pragma unroll
                    for (int j = 0; j < 4; ++j) { v[j] = acc[ai][bj][m][0][j]; v[4 + j] = acc[ai][bj][m][1][j]; }
                    if (mode == 0) {
                        if (act == 1) {
#pragma unroll
                            for (int j = 0; j < 8; ++j) { const float t = fmaxf(v[j], 0.f); v[j] = t * t; }
                        }
                        *(u32x4*)(ob + row * ldo + col) = pack8(v);
                    } else if (mode == 1) {
                        float a[8]; unpack8(L0[e], a);
#pragma unroll
                        for (int j = 0; j < 8; ++j) v[j] = sigmoidf_(v[j] + bv[bj][j]) * a[j];
                        *(u32x4*)(ob + row * ldo + col) = pack8(v);
                    } else if (mode == 3) {
                        float a[8]; unpack8(L0[e], a);
#pragma unroll
                        for (int j = 0; j < 8; ++j) v[j] = sigmoidf_(v[j] + bv[bj][j]) * a[j];
                        if (col >= D) { float q[8]; unpack8(L1[e], q);
#pragma unroll
                            for (int j = 0; j < 8; ++j) v[j] += q[j]; }
                        *(u32x4*)(io2 + row * D + (col & (D - 1))) = pack8(v);
                    } else {
                        float r[8];
                        if (resf) {
#pragma unroll
                            for (int j = 0; j < 4; ++j) { r[j] = __uint_as_float(L0[e][j]); r[4 + j] = __uint_as_float(L1[e][j]); } }
                        else unpack8(L0[e], r);
#pragma unroll
                        for (int j = 0; j < 8; ++j) v[j] += ALPHA * r[j];
                        if (aux) { float a[8]; unpack8(L1[e], a);
#pragma unroll
                            for (int j = 0; j < 8; ++j) v[j] += a[j]; }
                        *(u32x4*)(io2 + row * D + col) = pack8(v);
                    }
                }
        }
    }
};

__device__ __forceinline__ void gemm_phase(const int tid, LAS unsigned char* lds, const Gemm g, const StaticOrder& S, const Epi& E) {
    const int wid = __builtin_amdgcn_readfirstlane(tid >> 6), lane = tid & 63, wr = wid >> 2, wc = wid & 3, fr = lane & 15, fq = lane >> 4;
    const int K = g.K, nt = K / BK;
    unsigned voffA[2], voffB[2];
#pragma unroll
    for (int i = 0; i < 2; ++i) { int R, C; stage_rc(tid * 16 + i * 8192, R, C); const int Rb = (R & ~31) + perm32(R & 31);
        voffA[i] = (unsigned)(R * g.lda + C) * 2u; voffB[i] = (unsigned)(Rb * g.ldb + C) * 2u; }
    const size_t kstep = (size_t)(BK * 2);
    const size_t hstepA = (size_t)HALF * g.lda * 2, hstepB = (size_t)HALF * g.ldb * 2;
    const size_t tstepA = 2 * hstepA, tstepB = 2 * hstepB;
    const unsigned ldsw = (unsigned)wid * 1024u;
    const int aoff = lds_byte(wr * 64 + fr, fq * 8), boff = lds_byte(wc * 32 + fr, fq * 8);
#define PG8_SA(b, h) (((b) * 2 + (h)) * HTB)
#define PG8_SB(b, h) ((4 + (b) * 2 + (h)) * HTB)
#define PG8_STAGE(bufoff, gbase, voff) do { _Pragma("unroll") for (int _i = 0; _i < 2; ++_i) \
        __builtin_amdgcn_global_load_lds((const unsigned*)((const char*)(gbase) + (voff)[_i]), (LAS unsigned*)(lds + (bufoff) + ldsw + _i * 8192), 16, 0, 0); } while (0)
#define PG8_LDA(dst, b, h) do { _Pragma("unroll") for (int m = 0; m < 4; ++m) _Pragma("unroll") for (int k = 0; k < 2; ++k) dst[m][k] = *(const LAS bf16x8*)(lds + PG8_SA(b, h) + aoff + m * 2048 + k * 1024); } while (0)
#define PG8_LDB(dst, b, h) do { _Pragma("unroll") for (int n = 0; n < 2; ++n) _Pragma("unroll") for (int k = 0; k < 2; ++k) dst[n][k] = *(const LAS bf16x8*)(lds + PG8_SB(b, h) + boff + n * 2048 + k * 1024); } while (0)
#define PG8_MMA(ai, bj, At, Bt) do { __builtin_amdgcn_s_setprio(1); _Pragma("unroll") for (int m = 0; m < 4; ++m) _Pragma("unroll") for (int n = 0; n < 2; ++n) _Pragma("unroll") for (int k = 0; k < 2; ++k) \
        acc[ai][bj][m][n] = __builtin_amdgcn_mfma_f32_16x16x32_bf16(Bt[n][k], At[m][k], acc[ai][bj][m][n], 0, 0, 0); __builtin_amdgcn_s_setprio(0); } while (0)
#define PG8_WAIT_V(n) asm volatile("s_waitcnt vmcnt(" #n ")" ::: "memory")
#define PG8_WAIT_L(n) asm volatile("s_waitcnt lgkmcnt(" #n ")" ::: "memory")
#define PG8_BAR __builtin_amdgcn_s_barrier()
#define PG8_SCHED __builtin_amdgcn_sched_barrier(0)
    Unit cur, nxt; int ui = 0;
    if (!S.next(0, cur)) return;
    f32x4 acc[2][2][4][2];
#pragma unroll
    for (int a = 0; a < 2; ++a)
#pragma unroll
        for (int b = 0; b < 2; ++b)
#pragma unroll
            for (int m = 0; m < 4; ++m)
#pragma unroll
                for (int n = 0; n < 2; ++n) acc[a][b][m][n] = (f32x4){0.f, 0.f, 0.f, 0.f};
    bf16x8 At[4][2], B0[2][2], B1[2][2];
    const char* cA = (const char*)g.A + (size_t)cur.pm * tstepA; const char* cB = (const char*)g.Bt + (size_t)cur.pn * tstepB;
    PG8_STAGE(PG8_SB(0, 0), cB, voffB); PG8_STAGE(PG8_SA(0, 0), cA, voffA); PG8_STAGE(PG8_SB(0, 1), cB + hstepB, voffB); PG8_STAGE(PG8_SA(0, 1), cA + hstepA, voffA);
    if (wr == 1) PG8_BAR;
    PG8_WAIT_V(4); PG8_BAR;
    PG8_STAGE(PG8_SB(1, 0), cB + kstep, voffB); PG8_STAGE(PG8_SA(1, 0), cA + kstep, voffA); PG8_STAGE(PG8_SB(1, 1), cB + hstepB + kstep, voffB);
    PG8_WAIT_V(6); PG8_BAR;
    for (;;) {
        const bool has_next = S.next(ui + 1, nxt);
        const char* nA = has_next ? (const char*)g.A + (size_t)nxt.pm * tstepA : cA; const char* nB = has_next ? (const char*)g.Bt + (size_t)nxt.pn * tstepB : cB;
        for (int t = 0; t < nt; t += 2) {
            const bool last = (t == nt - 2);
            const char* a1 = cA + (size_t)(t + 1) * kstep;
            const char* a2 = last ? nA : cA + (size_t)(t + 2) * kstep; const char* b2 = last ? nB : cB + (size_t)(t + 2) * kstep;
            const char* a3 = a2 + kstep; const char* b3 = b2 + kstep;
            PG8_LDB(B0, 0, 0); PG8_SCHED; PG8_LDA(At, 0, 0); PG8_STAGE(PG8_SA(1, 1), a1 + hstepA, voffA);
            PG8_WAIT_L(8); PG8_BAR; PG8_WAIT_L(0); PG8_MMA(0, 0, At, B0); PG8_BAR; PG8_SCHED;
            PG8_LDB(B1, 0, 1); PG8_STAGE(PG8_SB(0, 0), b2, voffB);
            PG8_BAR; PG8_WAIT_L(0); PG8_MMA(0, 1, At, B1); PG8_BAR;
            PG8_LDA(At, 0, 1); PG8_STAGE(PG8_SA(0, 0), a2, voffA);
            PG8_BAR; PG8_WAIT_L(0); PG8_MMA(1, 0, At, B0); PG8_BAR; PG8_SCHED;
            PG8_STAGE(PG8_SB(0, 1), b2 + hstepB, voffB);
            PG8_WAIT_V(6); PG8_BAR; PG8_MMA(1, 1, At, B1); PG8_BAR;
            PG8_LDB(B0, 1, 0); PG8_SCHED; PG8_LDA(At, 1, 0); PG8_STAGE(PG8_SA(0, 1), a2 + hstepA, voffA);
            PG8_WAIT_L(8); PG8_BAR; PG8_WAIT_L(0); PG8_MMA(0, 0, At, B0); PG8_BAR; PG8_SCHED;
            PG8_LDB(B1, 1, 1); PG8_STAGE(PG8_SB(1, 0), b3, voffB);
            PG8_BAR; PG8_WAIT_L(0); PG8_MMA(0, 1, At, B1); PG8_BAR;
            PG8_LDA(At, 1, 1); PG8_STAGE(PG8_SA(1, 0), a3, voffA);
            PG8_BAR; PG8_WAIT_L(0); PG8_MMA(1, 0, At, B0); PG8_BAR; PG8_SCHED;
            PG8_STAGE(PG8_SB(1, 1), b3 + hstepB, voffB);
            PG8_WAIT_V(6); PG8_BAR; PG8_MMA(1, 1, At, B1); PG8_BAR;
        }
        E(acc, cur, wr, wc, fr, fq, lds + 131088 + ldsw);
        if (!has_next) break;
#pragma unroll
        for (int a = 0; a < 2; ++a)
#pragma unroll
            for (int b = 0; b < 2; ++b)
#pragma unroll
                for (int m = 0; m < 4; ++m)
#pragma unroll
                    for (int n = 0; n < 2; ++n) acc[a][b][m][n] = (f32x4){0.f, 0.f, 0.f, 0.f};
        cur = nxt; cA = nA; cB = nB; ++ui;
    }
    PG8_WAIT_V(0);
    if (wr == 0) PG8_BAR;
    PG8_BAR;
#undef PG8_SA
#undef PG8_SB
#undef PG8_STAGE
#undef PG8_LDA
#undef PG8_LDB
#undef PG8_MMA
#undef PG8_WAIT_V
#undef PG8_WAIT_L
#undef PG8_BAR
#undef PG8_SCHED
}
}

#define LDS_BARRIER() do { asm volatile("s_waitcnt lgkmcnt(0)" ::: "memory"); __builtin_amdgcn_s_barrier(); asm volatile("" ::: "memory"); } while (0)

__device__ __forceinline__ void tconv(const int tid_, const int bid_, const int gdim_, float* tile, const float* __restrict__ src, int K, int N, bf16_t* __restrict__ dst, int ldd) {
    const int tn = N / 64, nt = (K / 64) * tn;
    const int r = tid_ >> 3, c = (tid_ & 7) * 8;
    int t = bid_;
    f32x4 a, b;
    if (t < nt) { const f32x4* s = (const f32x4*)(src + (size_t)((t / tn) * 64 + r) * N + (t % tn) * 64 + c); a = s[0]; b = s[1]; }
    for (; t < nt; t += gdim_) {
        const int k0 = (t / tn) * 64, n0 = (t % tn) * 64;
#pragma unroll
        for (int j = 0; j < 4; ++j) { tile[r * 65 + c + j] = a[j]; tile[r * 65 + c + 4 + j] = b[j]; }
        const int t2 = t + gdim_;
        if (t2 < nt) { const f32x4* s = (const f32x4*)(src + (size_t)((t2 / tn) * 64 + r) * N + (t2 % tn) * 64 + c); a = s[0]; b = s[1]; }
        LDS_BARRIER();
        float v[8];
#pragma unroll
        for (int j = 0; j < 8; ++j) v[j] = tile[(c + j) * 65 + r];
        *(u32x4*)(dst + (size_t)(n0 + r) * ldd + k0 + c) = pack8(v);
        LDS_BARRIER();
    }
}
__device__ __forceinline__ void econv(const int tid_, const int bid_, const int gdim_, const float* __restrict__ src, bf16_t* __restrict__ dst, size_t n) {
    const size_t nth = (size_t)gdim_ * 512;
    for (size_t i = ((size_t)bid_ * 512 + tid_) * 8; i < n; i += nth * 8) {
        const f32x4 a = *(const f32x4*)(src + i), b = *(const f32x4*)(src + i + 4);
        float v[8] = {a[0], a[1], a[2], a[3], b[0], b[1], b[2], b[3]};
        *(u32x4*)(dst + i) = pack8(v);
    }
}

__device__ __forceinline__ void ln_phase(const int tid_, const int bid_, const int gdim_, bf16_t* xio, const float* __restrict__ g, const float* __restrict__ b, float* outf) {
    const int lane = tid_ & 63, wid = tid_ >> 6;
    const int nw = gdim_ * 8;
    float gg[16], bb[16];
#pragma unroll
    for (int i = 0; i < 2; ++i)
#pragma unroll
        for (int j = 0; j < 8; ++j) { gg[i * 8 + j] = g[i * 512 + lane * 8 + j]; bb[i * 8 + j] = b[i * 512 + lane * 8 + j]; }
    for (int row = bid_ * 8 + wid; row < MTOK; row += nw) {
        bf16_t* p = xio + (size_t)row * D + lane * 8;
        float v[16]; unpack8(*(const u32x4*)p, v); unpack8(*(const u32x4*)(p + 512), v + 8);
        float s = 0.f;
#pragma unroll
        for (int j = 0; j < 16; ++j) s += v[j];
        const float mean = wave_sum(s) * (1.0f / D);
        float q = 0.f;
#pragma unroll
        for (int j = 0; j < 16; ++j) { const float d = v[j] - mean; q += d * d; }
        const float rstd = __builtin_amdgcn_rsqf(wave_sum(q) * (1.0f / D) + LN_EPS);
#pragma unroll
        for (int j = 0; j < 16; ++j) v[j] = (v[j] - mean) * rstd * gg[j] + bb[j];
        if (!outf) { *(u32x4*)p = pack8(v); *(u32x4*)(p + 512) = pack8(v + 8); }
        else { float* o = outf + (size_t)row * D + lane * 8;
            *(f32x4*)o = (f32x4){v[0], v[1], v[2], v[3]}; *(f32x4*)(o + 4) = (f32x4){v[4], v[5], v[6], v[7]};
            *(f32x4*)(o + 512) = (f32x4){v[8], v[9], v[10], v[11]}; *(f32x4*)(o + 516) = (f32x4){v[12], v[13], v[14], v[15]}; }
    }
}

__device__ __forceinline__ void sconv_phase(const int tid_, const int bid_, const int gdim_, const bf16_t* __restrict__ h, const float* __restrict__ w  , bf16_t* __restrict__ yb) {
    const size_t nth = (size_t)gdim_ * 512;
    for (size_t idx = (size_t)bid_ * 512 + tid_; idx < (size_t)MTOK * 64; idx += nth) {
        const int tok = (int)(idx >> 6), c8 = (int)(idx & 63) * 8, t = tok & (SEQ - 1);
        float acc[8];
#pragma unroll
        for (int j = 0; j < 8; ++j) acc[j] = 0.f;
#pragma unroll
        for (int k = 0; k < 3; ++k) {
            const int tt = t - 2 + k;
            if (tt >= 0) {
                const bf16_t* row = h + (size_t)(tok - 2 + k) * INC + COL_B;
                float cgv[8], xh[8]; unpack8(*(const u32x4*)(row + 512 + c8), cgv); unpack8(*(const u32x4*)(row + 1024 + c8), xh);
                const f32x4 w0 = *(const f32x4*)(w + k * 512 + c8), w1 = *(const f32x4*)(w + k * 512 + c8 + 4);
#pragma unroll
                for (int j = 0; j < 4; ++j) { acc[j] += w0[j] * (cgv[j] * xh[j]); acc[4 + j] += w1[j] * (cgv[4 + j] * xh[4 + j]); }
            }
        }
        float bg[8]; unpack8(*(const u32x4*)(h + (size_t)tok * INC + COL_B + c8), bg);
#pragma unroll
        for (int j = 0; j < 8; ++j) acc[j] *= bg[j];
        *(u32x4*)(yb + (size_t)tok * DMIX + c8) = pack8(acc);
    }
}

__device__ __forceinline__ void vtrans_phase(const int tid_, const int bid_, const int gdim_, bf16_t* tile  , const bf16_t* __restrict__ h, bf16_t* __restrict__ vt) {
    const int r = tid_ >> 3, c = (tid_ & 7) * 8;
    int it = bid_;
    u32x4 u;
    if (it < BATCH * 8 * 32) { const int bh = it >> 5, tc = it & 31; u = *(const u32x4*)(h + (size_t)((bh >> 3) * SEQ + tc * 64 + r) * INC + COL_D + 1024 + (bh & 7) * 64 + c); }
    for (; it < BATCH * 8 * 32; it += gdim_) {
        const int bh = it >> 5, tc = it & 31;
#pragma unroll
        for (int j = 0; j < 4; ++j) { tile[(c + 2 * j) * 72 + r] = (bf16_t)(u[j] & 0xffffu); tile[(c + 2 * j + 1) * 72 + r] = (bf16_t)(u[j] >> 16); }
        const int i2 = it + gdim_;
        if (i2 < BATCH * 8 * 32) { const int bh2 = i2 >> 5, tc2 = i2 & 31; u = *(const u32x4*)(h + (size_t)((bh2 >> 3) * SEQ + tc2 * 64 + r) * INC + COL_D + 1024 + (bh2 & 7) * 64 + c); }
        LDS_BARRIER();
        *(u32x4*)(vt + (size_t)(bh * 64 + r) * SEQ + tc * 64 + c) = *(const u32x4*)(tile + r * 72 + c);
        LDS_BARRIER();
    }
}

__device__ __forceinline__ void attn_phase(const int tid_, const int bid_, const int gdim_, unsigned char* ldsb, const bf16_t* __restrict__ h, const bf16_t* __restrict__ vt, const float* __restrict__ rel_bias, bf16_t* __restrict__ yd) {
    constexpr float L2E = 1.4426950408889634f;
    float* rb = (float*)(ldsb + 131088);
    for (int i = tid_; i < 8 * 257; i += 512) rb[i] = rel_bias[i] * L2E;
    __syncthreads();
    const int lane = tid_ & 63, wid = __builtin_amdgcn_readfirstlane(tid_ >> 6), lr = lane & 15, quad = lane >> 4;
    const int nw = gdim_ * 8;
    unsigned char* wl = ldsb + wid * 16384;
    const int krow = lane >> 3, kchunk = (lane & 7) ^ (krow & 7);
    const int vrow = lane >> 2, vchunk = (lane & 3) ^ ((vrow >> 2) & 3);
    int koff[2][2], voff[4];
#pragma unroll
    for (int tt = 0; tt < 2; ++tt)
#pragma unroll
        for (int dh = 0; dh < 2; ++dh) { const int row = (lr >> 2) * 8 + tt * 4 + (lr & 3); koff[tt][dh] = row * 128 + (((dh * 4 + quad) ^ (row & 7)) * 16); }
#pragma unroll
    for (int dt = 0; dt < 4; ++dt) { const int d = dt * 16 + lr; voff[dt] = 4096 + d * 64 + ((quad ^ ((d >> 2) & 3)) * 16); }
    int it = 0;
    for (int item0 = bid_ * 8 + wid; item0 < BATCH * 8 * 32; item0 += nw, ++it) {
        const int c = ((item0 & 31) + 8 * it) & 31, hh = (item0 >> 5) & 7, b = item0 >> 8;
        const int q0 = c * 64;
        const bf16_t* hb = h + (size_t)b * SEQ * INC + COL_D + hh * 64;
        bf16x8 qf[4][2];
        asm volatile("s_waitcnt lgkmcnt(0)" ::: "memory");
        {
            const bf16_t* qg = hb + (size_t)(q0 + krow) * INC + kchunk * 8;
#pragma unroll
            for (int i = 0; i < 8; ++i) __builtin_amdgcn_global_load_lds((const unsigned*)(qg + (size_t)i * 8 * INC), (LAS unsigned*)(wl + 8192 + i * 1024), 16, 0, 0);
        }
        const bf16_t* vb = vt + (size_t)((b * 8 + hh) * 64) * SEQ;
        const float* rbh = rb + hh * 257;
        const float cb2 = rbh[256];
        f32x4 oacc[4][4];
#pragma unroll
        for (int qi = 0; qi < 4; ++qi)
#pragma unroll
            for (int dt = 0; dt < 4; ++dt) oacc[qi][dt] = (f32x4){0.f, 0.f, 0.f, 0.f};
        float mrun[4] = {-1e30f, -1e30f, -1e30f, -1e30f}, lsum[4] = {0.f, 0.f, 0.f, 0.f};
        const int kstart = (c > 8 ? c - 8 : 0) * 64, kend = c * 64 + 64;
        const bf16_t* kg = hb + 512 + (size_t)krow * INC + kchunk * 8;
        const bf16_t* vg = vb + (size_t)vrow * SEQ + vchunk * 8;
#define AT_LOAD(buf, kt) do { _Pragma("unroll") for (int i = 0; i < 4; ++i) \
                __builtin_amdgcn_global_load_lds((const unsigned*)(kg + (size_t)((kt) + i * 8) * INC), (LAS unsigned*)(wl + (buf) * 8192 + i * 1024), 16, 0, 0); \
            _Pragma("unroll") for (int i = 0; i < 4; ++i) \
                __builtin_amdgcn_global_load_lds((const unsigned*)(vg + (size_t)i * 16 * SEQ + (kt)), (LAS unsigned*)(wl + (buf) * 8192 + 4096 + i * 1024), 16, 0, 0); } while (0)
#define AT_COMPUTE(buf, kt) do { \
            const bool far_ = ((kt) + 31 + 128 <= q0); \
            const unsigned char* bb_ = wl + (buf) * 8192; \
            bf16x8 kf[2][2], vf[4]; \
            _Pragma("unroll") for (int tt = 0; tt < 2; ++tt) _Pragma("unroll") for (int dh = 0; dh < 2; ++dh) kf[tt][dh] = *(const bf16x8*)(bb_ + koff[tt][dh]); \
            _Pragma("unroll") for (int dt = 0; dt < 4; ++dt) vf[dt] = *(const bf16x8*)(bb_ + voff[dt]); \
            _Pragma("unroll") for (int qi = 0; qi < 4; ++qi) { \
                f32x4 s[2]; \
                _Pragma("unroll") for (int tt = 0; tt < 2; ++tt) { f32x4 a = (f32x4){0.f, 0.f, 0.f, 0.f}; \
                    a = __builtin_amdgcn_mfma_f32_16x16x32_bf16(kf[tt][0], qf[qi][0], a, 0, 0, 0); \
                    a = __builtin_amdgcn_mfma_f32_16x16x32_bf16(kf[tt][1], qf[qi][1], a, 0, 0, 0); s[tt] = a; } \
                float mx = -1e30f; \
                if (far_) { _Pragma("unroll") for (int tt = 0; tt < 2; ++tt) _Pragma("unroll") for (int j = 0; j < 4; ++j) { const float v = s[tt][j] * (0.125f * L2E) + cb2; s[tt][j] = v; mx = fmaxf(mx, v); } } \
                else { const int qpos = q0 + qi * 16 + lr; float bz[8]; \
                    _Pragma("unroll") for (int tt = 0; tt < 2; ++tt) _Pragma("unroll") for (int j = 0; j < 4; ++j) { \
                        int rel = qpos - ((kt) + quad * 8 + tt * 4 + j); rel = rel > 128 ? 128 : (rel < -128 ? -128 : rel); bz[tt * 4 + j] = rbh[rel + 128]; } \
                    _Pragma("unroll") for (int tt = 0; tt < 2; ++tt) _Pragma("unroll") for (int j = 0; j < 4; ++j) { \
                        const float v = s[tt][j] * (0.125f * L2E) + bz[tt * 4 + j]; s[tt][j] = v; mx = fmaxf(mx, v); } } \
                mx = fmaxf(mx, shflx(mx, lane, 16)); mx = fmaxf(mx, shflx(mx, lane, 32)); \
                const float mnew = fmaxf(mrun[qi], mx), sc = __builtin_amdgcn_exp2f(mrun[qi] - mnew); \
                mrun[qi] = mnew; \
                float ps = 0.f; float pv[8]; \
                _Pragma("unroll") for (int tt = 0; tt < 2; ++tt) _Pragma("unroll") for (int j = 0; j < 4; ++j) { const float p = __builtin_amdgcn_exp2f(s[tt][j] - mnew); pv[tt * 4 + j] = p; ps += p; } \
                lsum[qi] = lsum[qi] * sc + ps; \
                const u32x4 pu = pack8(pv); bf16x8 pf; __builtin_memcpy(&pf, &pu, 16); \
                _Pragma("unroll") for (int dt = 0; dt < 4; ++dt) { \
                    f32x4 o = oacc[qi][dt]; \
                    _Pragma("unroll") for (int j = 0; j < 4; ++j) o[j] *= sc; \
                    oacc[qi][dt] = __builtin_amdgcn_mfma_f32_16x16x32_bf16(vf[dt], pf, o, 0, 0, 0); } \
            } } while (0)
        AT_LOAD(0, kstart);
        asm volatile("s_waitcnt vmcnt(8)" ::: "memory");
#pragma unroll
        for (int qi = 0; qi < 4; ++qi)
#pragma unroll
            for (int dh = 0; dh < 2; ++dh) { const int row = qi * 16 + lr; qf[qi][dh] = *(const bf16x8*)(wl + 8192 + row * 128 + (((dh * 4 + quad) ^ (row & 7)) * 16)); }
        asm volatile("s_waitcnt lgkmcnt(0)" ::: "memory");
        for (int kt0 = kstart; kt0 < kend; kt0 += 64) {
            AT_LOAD(1, kt0 + 32);
            asm volatile("s_waitcnt vmcnt(8)" ::: "memory");
            AT_COMPUTE(0, kt0);
            if (kt0 + 64 < kend) { AT_LOAD(0, kt0 + 64); asm volatile("s_waitcnt vmcnt(8)" ::: "memory"); }
            else asm volatile("s_waitcnt vmcnt(0)" ::: "memory");
            AT_COMPUTE(1, kt0 + 32);
        }
#undef AT_LOAD
#undef AT_COMPUTE
#pragma unroll
        for (int qi = 0; qi < 4; ++qi) {
            float l = lsum[qi]; l += shflx(l, lane, 16); l += shflx(l, lane, 32);
            const float inv = __builtin_amdgcn_rcpf(l);
#pragma unroll
            for (int dt = 0; dt < 4; ++dt) {
                u32x2 pk; pk[0] = cvt_pk_bf16(oacc[qi][dt][0] * inv, oacc[qi][dt][1] * inv); pk[1] = cvt_pk_bf16(oacc[qi][dt][2] * inv, oacc[qi][dt][3] * inv);
                *(u32x2*)(wl + (qi * 16 + lr) * 136 + (dt * 16 + quad * 4) * 2) = pk;
            }
        }
        asm volatile("" ::: "memory");
#pragma unroll
        for (int i = 0; i < 8; ++i) {
            const int row = i * 8 + krow;
            *(u32x4*)(yd + (size_t)(b * SEQ + q0 + row) * DMIX + hh * 64 + (lane & 7) * 8) = *(const u32x4*)(wl + row * 136 + (lane & 7) * 16);
        }
    }
    __syncthreads();
}

__device__ __forceinline__ void lru_phase(const int tid_, const int bid_, const int gdim_, unsigned char* lds, const bf16_t* __restrict__ h, const float* __restrict__ conv_w, const float* __restrict__ conv_b,
                          const float* __restrict__ wrp, const float* __restrict__ brp, const float* __restrict__ wip, const float* __restrict__ bip,
                          const float* __restrict__ lam, bf16_t* __restrict__ ya_out, const float* __restrict__ scw  , bf16_t* __restrict__ yb_out) {
    bf16_t* WrT = (bf16_t*)lds;
    bf16_t* WiT = WrT + 64 * 72;
    bf16_t* xcb = WiT + 64 * 72;
    bf16_t* xraw = xcb + 64 * 72;
    bf16_t* yraw = xraw + 67 * 64 + 64;
    float* xcf = (float*)(yraw + 64 * 64);
    float* abuf = xcf + 4096;
    float* ubuf = abuf + 4096;
    float* ibuf = ubuf + 4096;
    float* hbuf = ibuf + 4096;
    float* gbuf = xcf;
    const int tid = tid_, lane = tid & 63, wid = tid >> 6, lr = lane & 15, quad = lane >> 4;
    const int sc_nth = gdim_ * 512; int sc_idx = bid_ * 512 + tid;
    for (int item = bid_; item < BATCH * 8; item += gdim_) {
        const int b = item >> 3, g = item & 7;
        __syncthreads();
        for (int e = tid; e < 4096; e += 512) { const int i = e >> 6, j = e & 63;
            WrT[j * 72 + i] = f2bf(wrp[(size_t)g * 4096 + e]); WiT[j * 72 + i] = f2bf(wip[(size_t)g * 4096 + e]); }
        const int ch = tid & 63, trow = tid >> 6;
        const int cg_ = g * 64 + ch;
        const float cw0 = conv_w[cg_], cw1 = conv_w[512 + cg_], cw2 = conv_w[1024 + cg_], cw3 = conv_w[1536 + cg_], cb = conv_b[cg_];
        const int r8 = tid >> 3, pc = (tid & 7) * 8;
        const bf16_t* hrow = h + (size_t)(b * SEQ + r8) * INC + COL_A + g * 64 + pc;
        u32x4 xa16 = *(const u32x4*)hrow, ya16 = *(const u32x4*)(hrow + 512), prev16 = (u32x4){0u, 0u, 0u, 0u};
        float hstate = 0.f;
        for (int tc = 0; tc < SEQ / 64; ++tc) {
            const int t0 = tc * 64;
            *(u32x4*)(xraw + (3 + r8) * 64 + pc) = xa16; *(u32x4*)(yraw + r8 * 64 + pc) = ya16;
            if (r8 >= 61) *(u32x4*)(xraw + (r8 - 61) * 64 + pc) = prev16;
            prev16 = xa16;
            if (tc + 1 < SEQ / 64) { const bf16_t* nx = hrow + (size_t)(t0 + 64) * INC; xa16 = *(const u32x4*)nx; ya16 = *(const u32x4*)(nx + 512); }
            const bool sc_ok = sc_idx < MTOK * 64;
            const int sc_tok = sc_idx >> 6, sc_c8 = (sc_idx & 63) * 8, sc_t = sc_tok & (SEQ - 1);
            u32x4 sc_bg, sc_c[3], sc_x[3];
            if (sc_ok) {
                sc_bg = *(const u32x4*)(h + (size_t)sc_tok * INC + COL_B + sc_c8);
#pragma unroll
                for (int k = 0; k < 3; ++k) { const bf16_t* row = h + (size_t)(sc_tok - (sc_t - 2 + k >= 0 ? 2 - k : 0)) * INC + COL_B; sc_c[k] = *(const u32x4*)(row + 512 + sc_c8); sc_x[k] = *(const u32x4*)(row + 1024 + sc_c8); }
            }
            LDS_BARRIER();
#pragma unroll
            for (int i = 0; i < 8; ++i) {
                const int tl = trow + 8 * i;
                const float x3 = bf2f(xraw[tl * 64 + ch]), x2 = bf2f(xraw[(tl + 1) * 64 + ch]), x1 = bf2f(xraw[(tl + 2) * 64 + ch]), x0 = bf2f(xraw[(tl + 3) * 64 + ch]);
                const float xc = cw3 * x0 + cw2 * x1 + cw1 * x2 + cw0 * x3 + cb;
                xcf[tl * 64 + ch] = xc; xcb[tl * 72 + ch] = f2bf(xc);
            }
            LDS_BARRIER();
            {
                const int tt = wid & 3, which = wid >> 2;
                const bf16_t* WT = which ? WiT : WrT;
                const bf16x8 a0 = *(const bf16x8*)(xcb + (tt * 16 + lr) * 72 + quad * 8), a1 = *(const bf16x8*)(xcb + (tt * 16 + lr) * 72 + 32 + quad * 8);
#pragma unroll
                for (int jt = 0; jt < 4; ++jt) {
                    const bf16x8 b0 = *(const bf16x8*)(WT + (jt * 16 + lr) * 72 + quad * 8), b1 = *(const bf16x8*)(WT + (jt * 16 + lr) * 72 + 32 + quad * 8);
                    f32x4 cacc = (f32x4){0.f, 0.f, 0.f, 0.f};
                    cacc = __builtin_amdgcn_mfma_f32_16x16x32_bf16(a0, b0, cacc, 0, 0, 0);
                    cacc = __builtin_amdgcn_mfma_f32_16x16x32_bf16(a1, b1, cacc, 0, 0, 0);
                    const int j = jt * 16 + lr, cj = g * 64 + j;
                    if (which == 0) {
                        const float bias = brp[cj], lm = lam[cj];
                        const float sp = fmaxf(-lm, 0.f) + flog1p_small(fexp(-fabsf(lm)));
#pragma unroll
                        for (int jj = 0; jj < 4; ++jj) {
                            const int tl = tt * 16 + quad * 4 + jj;
                            const float r = sigmoidf_(cacc[jj] + bias);
                            const float la = -8.0f * r * sp;
                            abuf[tl * 64 + j] = fexp(la);
                            ubuf[tl * 64 + j] = __builtin_amdgcn_sqrtf(fneg_expm1(2.0f * la)) * xcf[tl * 64 + j];
                        }
                    } else {
                        const float bias = bip[cj];
#pragma unroll
                        for (int jj = 0; jj < 4; ++jj) { const int tl = tt * 16 + quad * 4 + jj; ibuf[tl * 64 + j] = sigmoidf_(cacc[jj] + bias); }
                    }
                }
            }
            LDS_BARRIER();
            if (wid == 0) {
#pragma unroll 8
                for (int tl = 0; tl < 64; ++tl) { hstate = abuf[tl * 64 + lane] * hstate + ubuf[tl * 64 + lane] * ibuf[tl * 64 + lane]; hbuf[tl * 64 + lane] = hstate; }
            } else {
                for (int e = tid - 64; e < 4096; e += 448) {
                    const float y = bf2f(yraw[e]);
                    gbuf[e] = 0.5f * y * (1.0f + ftanh(0.7978845608028654f * (y + 0.044715f * y * y * y)));
                }
            }
            LDS_BARRIER();
            {
                float o[8];
                const f32x4 h0 = *(const f32x4*)(hbuf + r8 * 64 + pc), h1 = *(const f32x4*)(hbuf + r8 * 64 + pc + 4);
                const f32x4 g0 = *(const f32x4*)(gbuf + r8 * 64 + pc), g1 = *(const f32x4*)(gbuf + r8 * 64 + pc + 4);
#pragma unroll
                for (int j = 0; j < 4; ++j) { o[j] = h0[j] * g0[j]; o[4 + j] = h1[j] * g1[j]; }
                *(u32x4*)(ya_out + (size_t)(b * SEQ + t0 + r8) * DMIX + g * 64 + pc) = pack8(o);
            }
            if (sc_ok) {
                float acc[8], bg[8];
#pragma unroll
                for (int j = 0; j < 8; ++j) acc[j] = 0.f;
#pragma unroll
                for (int k = 0; k < 3; ++k) {
                    const float mk = (sc_t - 2 + k >= 0) ? 1.f : 0.f;
                    float cgv[8], xh[8]; unpack8(sc_c[k], cgv); unpack8(sc_x[k], xh);
                    const f32x4 w0 = *(const f32x4*)(scw + k * 512 + sc_c8), w1 = *(const f32x4*)(scw + k * 512 + sc_c8 + 4);
#pragma unroll
                    for (int j = 0; j < 4; ++j) { acc[j] += (mk * w0[j]) * (cgv[j] * xh[j]); acc[4 + j] += (mk * w1[j]) * (cgv[4 + j] * xh[4 + j]); }
                }
                unpack8(sc_bg, bg);
#pragma unroll
                for (int j = 0; j < 8; ++j) acc[j] *= bg[j];
                *(u32x4*)(yb_out + (size_t)sc_tok * DMIX + sc_c8) = pack8(acc);
            }
            sc_idx += sc_nth;
        }
    }
    for (; sc_idx < MTOK * 64; sc_idx += sc_nth) {
        const int tok = sc_idx >> 6, c8 = (sc_idx & 63) * 8, t = tok & (SEQ - 1);
        float acc[8], bg[8];
#pragma unroll
        for (int j = 0; j < 8; ++j) acc[j] = 0.f;
#pragma unroll
        for (int k = 0; k < 3; ++k) {
            if (t - 2 + k >= 0) {
                const bf16_t* row = h + (size_t)(tok - 2 + k) * INC + COL_B;
                float cgv[8], xh[8]; unpack8(*(const u32x4*)(row + 512 + c8), cgv); unpack8(*(const u32x4*)(row + 1024 + c8), xh);
                const f32x4 w0 = *(const f32x4*)(scw + k * 512 + c8), w1 = *(const f32x4*)(scw + k * 512 + c8 + 4);
#pragma unroll
                for (int j = 0; j < 4; ++j) { acc[j] += w0[j] * (cgv[j] * xh[j]); acc[4 + j] += w1[j] * (cgv[4 + j] * xh[4 + j]); }
            }
        }
        unpack8(*(const u32x4*)(h + (size_t)tok * INC + COL_B + c8), bg);
#pragma unroll
        for (int j = 0; j < 8; ++j) acc[j] *= bg[j];
        *(u32x4*)(yb_out + (size_t)tok * DMIX + c8) = pack8(acc);
    }
    __syncthreads();
}

constexpr int RT = 16, REC = 456;
__device__ __forceinline__ float dpp_x1(float v) { return __int_as_float(__builtin_amdgcn_update_dpp(0, __float_as_int(v), 0xB1, 0xF, 0xF, true)); }
__device__ __forceinline__ float dpp_x2(float v) { return __int_as_float(__builtin_amdgcn_update_dpp(0, __float_as_int(v), 0x4E, 0xF, 0xF, true)); }
__device__ __forceinline__ void rwkv_phase(const int tid_, const int bid_, const int gdim_, unsigned char* lds, const bf16_t* __restrict__ h, const float* __restrict__ mu, const float* __restrict__ w0p, const float* __restrict__ w2p,
                           const float* __restrict__ a0p, const float* __restrict__ a2p, const float* __restrict__ g2p, const float* __restrict__ kkp, const float* __restrict__ kap,
                           const float* __restrict__ rkp, const float* __restrict__ gng, const float* __restrict__ gnb, bf16_t* __restrict__ yc) {
    bf16_t* W2T = (bf16_t*)lds;
    bf16_t* A2T = W2T + 64 * 72;
    bf16_t* G2T = A2T + 64 * 72;
    bf16_t* linb = G2T + 64 * 136;
    float* lo = (float*)(linb + 4 * 4 * 264);
    float* rec = lo + 4 * 4 * 192;
    float* obuf = rec + 2 * RT * REC;
    const int tid = tid_, lane = tid & 63, wid = __builtin_amdgcn_readfirstlane(tid >> 6);
    constexpr int NC = SEQ / RT;
    for (int item = bid_; item < BATCH * 8; item += gdim_) {
        const int b = item >> 3, hh = item & 7, hj = hh * 64 + lane;
        __syncthreads();
        for (int e = tid; e < 4096; e += 512) { const int i = e >> 6, j = e & 63; W2T[j * 72 + i] = f2bf(w2p[i * 512 + hh * 64 + j]); A2T[j * 72 + i] = f2bf(a2p[i * 512 + hh * 64 + j]); }
        for (int e = tid; e < 8192; e += 512) { const int i = e >> 6, j = e & 63; G2T[j * 136 + i] = f2bf(g2p[i * 512 + hh * 64 + j]); }
        __syncthreads();
        if (wid < 4) {
            const int r = lane >> 2, kq = lane & 3, row = wid * 16 + r;
            f32x2 S[8];
#pragma unroll
            for (int i = 0; i < 8; ++i) S[i] = (f32x2){0.f, 0.f};
            LDS_BARRIER();
            for (int c = 0; c < NC; ++c) {
                const float* R0 = rec + (c & 1) * RT * REC + kq * 16;
                float* ob = obuf + (c & 1) * RT * 64 + row;
                f32x4 dt[2][8], up[2][12]; float vv[2]; f32x2 scs[2];
#define RW_LOAD(buf, t) do { const float* Rk = R0 + (t) * REC; _Pragma("unroll") for (int i = 0; i < 4; ++i) { dt[buf][i] = *(const f32x4*)(Rk + 4 * i); dt[buf][4 + i] = *(const f32x4*)(Rk + 64 + 4 * i); } \
                    vv[buf] = Rk[320 - kq * 16 + row]; scs[buf] = *(const f32x2*)(Rk + 448 - kq * 16); \
                    _Pragma("unroll") for (int q = 0; q < 3; ++q) _Pragma("unroll") for (int i = 0; i < 4; ++i) up[buf][q * 4 + i] = *(const f32x4*)(Rk + 128 + q * 64 + 4 * i); } while (0)
                RW_LOAD(0, 0);
#pragma unroll
                for (int t = 0; t < RT; ++t) {
                    const int cb = t & 1;
                    if (t + 1 < RT) RW_LOAD(cb ^ 1, t + 1);
                    const float vval = vv[cb];
                    f32x2 sa0 = (f32x2){0.f, 0.f}, sa1 = (f32x2){0.f, 0.f}, yp0 = (f32x2){0.f, 0.f}, yp1 = (f32x2){0.f, 0.f};
#pragma unroll
                    for (int i = 0; i < 4; ++i) {
                        const f32x4 ah = dt[cb][i], wr = dt[cb][4 + i];
                        sa0 += S[2 * i] * (f32x2){ah[0], ah[1]}; sa1 += S[2 * i + 1] * (f32x2){ah[2], ah[3]};
                        yp0 += S[2 * i] * (f32x2){wr[0], wr[1]}; yp1 += S[2 * i + 1] * (f32x2){wr[2], wr[3]};
                    }
                    sa0 += sa1; yp0 += yp1;
                    float sa = sa0[0] + sa0[1], yp = yp0[0] + yp0[1];
                    sa += dpp_x1(sa); yp += dpp_x1(yp);
                    sa += dpp_x2(sa); yp += dpp_x2(yp);
                    if (kq == 0) ob[t * 64] = yp + sa * scs[cb][0] + vval * scs[cb][1];
                    const f32x2 sav = (f32x2){sa, sa}, vvv = (f32x2){vval, vval};
#pragma unroll
                    for (int i = 0; i < 4; ++i) {
                        const f32x4 dc = up[cb][i], bb = up[cb][4 + i], kp = up[cb][8 + i];
                        S[2 * i] = S[2 * i] * (f32x2){dc[0], dc[1]} + sav * (f32x2){bb[0], bb[1]} + vvv * (f32x2){kp[0], kp[1]};
                        S[2 * i + 1] = S[2 * i + 1] * (f32x2){dc[2], dc[3]} + sav * (f32x2){bb[2], bb[3]} + vvv * (f32x2){kp[2], kp[3]};
                    }
                }
#undef RW_LOAD
                LDS_BARRIER();
            }
        } else {
            const int p = wid - 4, lr = lane & 15, quad = lane >> 4;
            bf16_t* lb = linb + p * 4 * 264;
            float* lop = lo + p * 4 * 192;
            const float mu_r = mu[hj], mu_k = mu[512 + hj], mu_v = mu[1024 + hj];
            float mu_l[4];
#pragma unroll
            for (int q = 0; q < 4; ++q) mu_l[q] = mu[1536 + lane + 64 * q];
            const float w0 = w0p[hj], a0 = a0p[hj], k_k = kkp[hj], k_a = kap[hj], r_k = rkp[hj], gn_g = gng[hj], gn_b = gnb[hj];
            const bf16_t* hC = h + (size_t)b * SEQ * INC + COL_C;
            unsigned zraw[5][7];
#define RW_GLOAD(cn) do { _Pragma("unroll") for (int rw = 0; rw < 5; ++rw) { const int t = (cn) * RT + p * 4 + rw - 1; \
                    const bf16_t* ptr = hC + (size_t)(t < 0 ? 0 : t) * INC; \
                    zraw[rw][0] = ptr[hj]; zraw[rw][1] = ptr[512 + hj]; zraw[rw][2] = ptr[1024 + hj]; \
                    _Pragma("unroll") for (int q = 0; q < 4; ++q) zraw[rw][3 + q] = ptr[1536 + lane + 64 * q]; } } while (0)
            RW_GLOAD(0);
            for (int c = -1; c < NC; ++c) {
                const bool do_prep = (c + 1 < NC), do_post = (c >= 1);
                float cr[5], ck[5], cv[5], cl[5][4];
#pragma unroll
                for (int rw = 0; rw < 5; ++rw) { cr[rw] = bf2f(zraw[rw][0]); ck[rw] = bf2f(zraw[rw][1]); cv[rw] = bf2f(zraw[rw][2]);
#pragma unroll
                    for (int q = 0; q < 4; ++q) cl[rw][q] = bf2f(zraw[rw][3 + q]); }
                if (c == -1 && p == 0) { cr[0] = 0.f; ck[0] = 0.f; cv[0] = 0.f; cl[0][0] = 0.f; cl[0][1] = 0.f; cl[0][2] = 0.f; cl[0][3] = 0.f; }
                if (c + 2 < NC) RW_GLOAD(c + 2);
                if (do_post) {
                    const float* Rb = rec + ((c - 1) & 1) * RT * REC;
                    const float* ob = obuf + ((c - 1) & 1) * RT * 64;
                    float ov[4], sm[8];
#pragma unroll
                    for (int u = 0; u < 4; ++u) { ov[u] = ob[(p * 4 + u) * 64 + lane]; sm[2 * u] = ov[u]; sm[2 * u + 1] = ov[u] * ov[u]; }
                    wave_sum_n<8>(sm);
#pragma unroll
                    for (int u = 0; u < 4; ++u) {
                        const int tt = p * 4 + u, t = (c - 1) * RT + tt;
                        const float* R = Rb + tt * REC;
                        const float mean = sm[2 * u] * (1.0f / 64.0f), var = fmaxf(sm[2 * u + 1] * (1.0f / 64.0f) - mean * mean, 0.f);
                        float o = (ov[u] - mean) * __builtin_amdgcn_rsqf(var + GN_EPS) * gn_g + gn_b;
                        o += R[450] * R[320 + lane];
                        yc[(size_t)(b * SEQ + t) * DMIX + hj] = f2bf(o * R[384 + lane]);
                    }
                }
                if (do_prep) {
                    float rr[4], kx[4], vx[4];
#pragma unroll
                    for (int u = 0; u < 4; ++u) {
                        rr[u] = cr[u + 1] + (cr[u] - cr[u + 1]) * mu_r; kx[u] = ck[u + 1] + (ck[u] - ck[u + 1]) * mu_k; vx[u] = cv[u + 1] + (cv[u] - cv[u + 1]) * mu_v;
#pragma unroll
                        for (int q = 0; q < 4; ++q) {
                            const float z = cl[u + 1][q] + (cl[u][q] - cl[u + 1][q]) * mu_l[q];
                            const float val = (q == 0) ? ftanh(z) : (q == 1 ? z : sigmoidf_(z));
                            lb[u * 264 + lane + 64 * q] = f2bf(val);
                        }
                    }
                    asm volatile("s_waitcnt lgkmcnt(0)" ::: "memory");
                    bf16x8 af[8];
#pragma unroll
                    for (int k8 = 0; k8 < 8; ++k8) af[k8] = *(const bf16x8*)(lb + (lane & 3) * 264 + k8 * 32 + quad * 8);
#pragma unroll
                    for (int jt = 0; jt < 4; ++jt) {
                        f32x4 cw = (f32x4){0.f, 0.f, 0.f, 0.f}, ca = cw, cgm = cw;
#pragma unroll
                        for (int kh = 0; kh < 2; ++kh) {
                            cw = __builtin_amdgcn_mfma_f32_16x16x32_bf16(af[kh], *(const bf16x8*)(W2T + (jt * 16 + lr) * 72 + kh * 32 + quad * 8), cw, 0, 0, 0);
                            ca = __builtin_amdgcn_mfma_f32_16x16x32_bf16(af[2 + kh], *(const bf16x8*)(A2T + (jt * 16 + lr) * 72 + kh * 32 + quad * 8), ca, 0, 0, 0);
                        }
#pragma unroll
                        for (int kh = 0; kh < 4; ++kh)
                            cgm = __builtin_amdgcn_mfma_f32_16x16x32_bf16(af[4 + kh], *(const bf16x8*)(G2T + (jt * 16 + lr) * 136 + kh * 32 + quad * 8), cgm, 0, 0, 0);
                        if (quad == 0) {
#pragma unroll
                            for (int jj = 0; jj < 4; ++jj) { lop[jj * 192 + jt * 16 + lr] = cw[jj]; lop[jj * 192 + 64 + jt * 16 + lr] = ca[jj]; lop[jj * 192 + 128 + jt * 16 + lr] = cgm[jj]; }
                        }
                    }
                    asm volatile("s_waitcnt lgkmcnt(0)" ::: "memory");
                    float* Rb = rec + ((c + 1) & 1) * RT * REC;
                    float dcy[4], av[4], kqv[4], kpv[4], ggv[4], red[16];
#pragma unroll
                    for (int u = 0; u < 4; ++u) {
                        const float wl = w0 + lop[u * 192 + lane], ap = a0 + lop[u * 192 + 64 + lane]; ggv[u] = lop[u * 192 + 128 + lane];
                        const float z = -wl;
                        const float sp = fmaxf(z, 0.f) + flog(1.0f + fexp(-fabsf(z)));
                        dcy[u] = fexp(-fexp(-sp - 0.5f));
                        av[u] = sigmoidf_(ap);
                        kqv[u] = kx[u] * k_k;
                        kpv[u] = kx[u] * (1.0f + (av[u] - 1.0f) * k_a);
                        red[4 * u] = kqv[u] * kqv[u]; red[4 * u + 1] = kqv[u] * av[u] * rr[u]; red[4 * u + 2] = kpv[u] * rr[u]; red[4 * u + 3] = rr[u] * kpv[u] * r_k;
                    }
                    wave_sum_n<16>(red);
#pragma unroll
                    for (int u = 0; u < 4; ++u) {
                        const int tt = p * 4 + u;
                        const float inv = __builtin_amdgcn_rcpf(fmaxf(__builtin_amdgcn_sqrtf(red[4 * u]), 1e-12f));
                        const float kkn = kqv[u] * inv;
                        float* R = Rb + tt * REC;
                        R[lane] = -kkn; R[64 + lane] = dcy[u] * rr[u]; R[128 + lane] = dcy[u]; R[192 + lane] = kkn * av[u]; R[256 + lane] = kpv[u]; R[320 + lane] = vx[u]; R[384 + lane] = ggv[u];
                        if (lane == 0) { R[448] = red[4 * u + 1] * inv; R[449] = red[4 * u + 2]; R[450] = red[4 * u + 3]; }
                    }
                }
                LDS_BARRIER();
            }
#undef RW_GLOAD
            {
                const float* Rb = rec + ((NC - 1) & 1) * RT * REC;
                const float* ob = obuf + ((NC - 1) & 1) * RT * 64;
                float ov[4], sm[8];
#pragma unroll
                for (int u = 0; u < 4; ++u) { ov[u] = ob[(p * 4 + u) * 64 + lane]; sm[2 * u] = ov[u]; sm[2 * u + 1] = ov[u] * ov[u]; }
                wave_sum_n<8>(sm);
#pragma unroll
                for (int u = 0; u < 4; ++u) {
                    const int tt = p * 4 + u, t = (NC - 1) * RT + tt;
                    const float* R = Rb + tt * REC;
                    const float mean = sm[2 * u] * (1.0f / 64.0f), var = fmaxf(sm[2 * u + 1] * (1.0f / 64.0f) - mean * mean, 0.f);
                    float o = (ov[u] - mean) * __builtin_amdgcn_rsqf(var + GN_EPS) * gn_g + gn_b;
                    o += R[450] * R[320 + lane];
                    yc[(size_t)(b * SEQ + t) * DMIX + hj] = f2bf(o * R[384 + lane]);
                }
            }
        }
    }
    __syncthreads();
}

#define XB_TMO      128
#define XB_XCNT(j)  (256  + 64 * (j))
#define XB_XSUB(j)  (1280 + 64 * (j))
#define XB_XGEN(j)  (2304 + 64 * (j))
#define XB_TOP      3328
#define XB_TOPGEN   3392
#define XCD_BAR_WORDS 3456
#define XB_SPIN_CAP (1u << 18)
__device__ __forceinline__ unsigned xb_ld(unsigned* p)              { return __hip_atomic_load(p, __ATOMIC_RELAXED, __HIP_MEMORY_SCOPE_AGENT); }
__device__ __forceinline__ unsigned xb_add(unsigned* p, unsigned v) { return __hip_atomic_fetch_add(p, v, __ATOMIC_RELAXED, __HIP_MEMORY_SCOPE_AGENT); }
__device__ __forceinline__ unsigned xb_xcc_id() { return (unsigned)__builtin_amdgcn_s_getreg((3 << 11) | 20) & 0xFu; }
#define XB_SPIN(cond, bar) do { unsigned _sp = 0; while (cond) { __builtin_amdgcn_s_sleep(1); \
    if ((++_sp & 255u) == 0u) { if (xb_ld(&(bar)[XB_TMO])) break; if (_sp > XB_SPIN_CAP) { atomicAdd(&(bar)[XB_TMO], 1u); break; } } } } while (0)
struct XcdBarrier { unsigned* bar; unsigned x; volatile LAS unsigned* st; };
__device__ __forceinline__ XcdBarrier xcd_barrier_post(unsigned* bar, volatile LAS unsigned* st) {
    XcdBarrier b; b.bar = bar; b.x = xb_xcc_id(); b.st = st;
    if (threadIdx.x == 0) (void)xb_add(&bar[XB_XCNT(b.x)], 1u);
    return b;
}
__device__ __forceinline__ void xcd_barrier_complete(unsigned* bar, unsigned x, unsigned& nloc, unsigned& nx) {
    const unsigned G = gridDim.x;
    unsigned sum, cnt, mine, sp = 0u;
    for (;;) {
        sum = 0u; cnt = 0u; mine = 0u;
#pragma unroll
        for (unsigned j = 0; j < 16; ++j) { const unsigned c = xb_ld(&bar[XB_XCNT(j)]); sum += c; cnt += (c > 0u) ? 1u : 0u; mine = (j == x) ? c : mine; }
        if (sum == G) break;
        __builtin_amdgcn_s_sleep(1);
        if ((++sp & 255u) == 0u) { if (xb_ld(&bar[XB_TMO])) break; if (sp > XB_SPIN_CAP) { atomicAdd(&bar[XB_TMO], 1u); break; } }
    }
    nloc = mine > 0u ? mine : 1u; nx = cnt > 0u ? cnt : 1u;
}
__device__ __forceinline__ void xcd_barrier(const XcdBarrier& b, const int tid) {
    asm volatile("s_waitcnt vmcnt(0)" ::: "memory");
    __syncthreads();
    if (tid == 0) {
        unsigned* bar = b.bar;
        __builtin_amdgcn_s_waitcnt(0);
        unsigned nloc = b.st[0], nx = b.st[1];
        if (nloc == 0u) { xcd_barrier_complete(bar, b.x, nloc, nx); b.st[0] = nloc; b.st[1] = nx; }
        const unsigned old = xb_add(&bar[XB_XSUB(b.x)], 1u);
        const unsigned gen = old / nloc;
        if (old + 1u == (gen + 1u) * nloc) {
            __builtin_amdgcn_fence(__ATOMIC_RELEASE, "agent");
            asm volatile("s_waitcnt vmcnt(0)" ::: "memory");
            const unsigned og = xb_add(&bar[XB_TOP], 1u);
            const unsigned tg = og / nx;
            if (og + 1u == (tg + 1u) * nx) xb_add(&bar[XB_TOPGEN], 1u);
            else XB_SPIN(xb_ld(&bar[XB_TOPGEN]) == tg, bar);
            __builtin_amdgcn_fence(__ATOMIC_ACQUIRE, "agent");
            xb_add(&bar[XB_XGEN(b.x)], 1u);
            asm volatile("s_waitcnt vmcnt(0)" ::: "memory");
        } else {
            XB_SPIN(xb_ld(&bar[XB_XGEN(b.x)]) == gen, bar);
            __builtin_amdgcn_fence(__ATOMIC_ACQUIRE, "agent");
            asm volatile("s_waitcnt vmcnt(0)" ::: "memory");
        }
    }
    __syncthreads();
}

constexpr int NPH = 12;
__global__ void __launch_bounds__(512, 2) mega(Params P, int ph_lo, int ph_hi) {
    extern __shared__ __attribute__((aligned(16))) unsigned char shm[];
    LAS unsigned char* lds = (LAS unsigned char*)shm;
    cg::grid_group grid = cg::this_grid();
    const int swid = __builtin_amdgcn_readfirstlane((int)threadIdx.x >> 6);
    volatile LAS unsigned* xst = (volatile LAS unsigned*)(lds + 131072);
    if (threadIdx.x < 2) xst[threadIdx.x] = 0u;
    __syncthreads();
    const XcdBarrier xbar = xcd_barrier_post((unsigned*)(P.ws + WS_BAR), xst);
    unsigned char* ws = P.ws;
    bf16_t* xb = (bf16_t*)(ws + WS_XB);
    bf16_t* wt = (bf16_t*)(ws + WS_WT);
    bf16_t* pb = (bf16_t*)(ws + WS_PB);
    bf16_t* hbuf = (bf16_t*)(ws + WS_H);
    bf16_t* vt = (bf16_t*)(ws + WS_VT);
    bf16_t* pq = hbuf;
    bf16_t* ubuf = hbuf;
    bf16_t* plb = (bf16_t*)(ws + WS_H + 512 * MiB);
    bf16_t* ybase = (bf16_t*)P.out;
    bf16_t* mb = plb;
    for (int ph = ph_lo; ph < ph_hi; ++ph) {
        const int l = ph / NPH, k = ph % NPH;
        const int njobs = (k == 1 || k == 5 || k == 6 || k == 9 || k == 10) ? 1 : (k == 4 ? 4 : (k == 8 ? 2 : 0));
        for (int rep = 0; rep < ((k == REPK) ? REPN : 1); ++rep) {
        int bid_ = blockIdx.x, gdim_ = gridDim.x; asm volatile("" : "+s"(bid_)); asm volatile("" : "+s"(gdim_)); int z_ = 0; asm volatile("" : "+s"(z_));
        int tid_ = (swid << 6) + (int)__builtin_amdgcn_mbcnt_hi(~0u, __builtin_amdgcn_mbcnt_lo(~0u, (unsigned)z_)); asm volatile("" : "+v"(tid_));
        if (njobs) {
            for (int n = 0; n < njobs; ++n) {
                pg8::Epi E; E.mode = 0; E.act = 0; E.ob = nullptr; E.ldo = 0; E.bias = nullptr; E.io2 = nullptr; E.resf = nullptr; E.aux = nullptr;
                pg8::Gemm g; g.M = MTOK; g.A = xb; g.lda = D; g.K = D; g.Bt = wt; g.ldb = D; g.N = D;
                int merge = 0;
                if (k == 1) { E.ob = hbuf; E.ldo = INC; g.Bt = wt + WO_IN; g.N = INC; }
                else if (k == 4) { E.ob = pq + (size_t)n * D; E.ldo = 4 * D; g.A = ybase + (size_t)n * MTOK * DMIX; g.lda = DMIX; g.K = DMIX; g.Bt = wt + WO_B + (size_t)n * D * DMIX; g.ldb = DMIX; }
                else if (k == 5) { E.mode = 3; E.ob = pq; E.ldo = 4 * D; E.bias = P.in[25 + z_] + (size_t)l * 4 * D; E.io2 = mb; g.Bt = wt + WO_G; g.N = 4 * D; merge = 1; }
                else if (k == 6) { E.mode = 2; E.io2 = xb; if (l == 0) E.resf = P.in[0 + z_]; g.A = mb; g.Bt = wt + WO_OUT4; }
                else if (k == 8 && n == 0) { E.act = 1; E.ob = ubuf; E.ldo = DFF; g.Bt = wt + WO_FF1; g.N = DFF; }
                else if (k == 8) { E.ob = plb; E.ldo = D; g.A = pb; g.lda = DPLE; g.K = DPLE; g.Bt = wt + WO_PLE; g.ldb = DPLE; }
                else if (k == 9) { E.mode = 1; E.ob = plb; E.ldo = D; E.bias = P.in[33 + z_] + (size_t)l * D; g.Bt = wt + WO_PLEG; }
                else { E.mode = 2; E.io2 = xb; E.aux = plb; g.A = ubuf; g.lda = DFF; g.K = DFF; g.Bt = wt + WO_FF2; g.ldb = DFF; }
                pg8::StaticOrder S; S.init(g.M, g.N, gdim_, bid_, merge);
                pg8::gemm_phase(tid_, lds, g, S, E);
                __syncthreads();
            }
        } else if (k == 0) {
            float* tile = (float*)shm;
            tconv(tid_, bid_, gdim_, tile, P.in[2 + z_] + (size_t)l * D * INC, D, INC, wt + WO_IN, D);
            for (int n = 0; n < 4; ++n) tconv(tid_, bid_, gdim_, tile, P.in[24 + z_] + ((size_t)l * 4 + n) * D * D, D, D, wt + WO_G + (size_t)n * D * D, D);
            for (int n = 0; n < 4; ++n) tconv(tid_, bid_, gdim_, tile, P.in[23 + z_] + ((size_t)l * 4 + n) * DMIX * D, DMIX, D, wt + WO_B + (size_t)n * D * DMIX, DMIX);
            tconv(tid_, bid_, gdim_, tile, P.in[26 + z_] + (size_t)l * D * D, D, D, wt + WO_OUT4, D);
            tconv(tid_, bid_, gdim_, tile, P.in[29 + z_] + (size_t)l * D * DFF, D, DFF, wt + WO_FF1, D);
            tconv(tid_, bid_, gdim_, tile, P.in[30 + z_] + (size_t)l * DFF * D, DFF, D, wt + WO_FF2, DFF);
            tconv(tid_, bid_, gdim_, tile, P.in[31 + z_] + (size_t)l * DPLE * D, DPLE, D, wt + WO_PLE, DPLE);
            tconv(tid_, bid_, gdim_, tile, P.in[32 + z_] + (size_t)l * D * D, D, D, wt + WO_PLEG, D);
            econv(tid_, bid_, gdim_, P.in[1 + z_] + (size_t)l * MTOK * DPLE, pb, (size_t)MTOK * DPLE);
            if (l == 0) econv(tid_, bid_, gdim_, P.in[0 + z_], xb, (size_t)MTOK * D);
        } else if (k == 2) {
            for (int r2 = 0; r2 < REP_LRU; ++r2) { int t2_ = tid_, b2_ = bid_; asm volatile("" : "+v"(t2_)); asm volatile("" : "+s"(b2_));
            lru_phase(t2_, b2_, gdim_, shm, hbuf, P.in[3 + z_] + (size_t)l * 4 * DMIX, P.in[4 + z_] + (size_t)l * DMIX, P.in[5 + z_] + (size_t)l * 8 * 4096, P.in[6 + z_] + (size_t)l * DMIX,
                      P.in[7 + z_] + (size_t)l * 8 * 4096, P.in[8 + z_] + (size_t)l * DMIX, P.in[9 + z_] + (size_t)l * DMIX, ybase, P.in[10 + z_] + (size_t)l * 3 * DMIX, ybase + (size_t)1 * MTOK * DMIX);
            }
            for (int r2 = 0; r2 < REP_RWKV; ++r2) { int t2_ = tid_, b2_ = bid_; asm volatile("" : "+v"(t2_)); asm volatile("" : "+s"(b2_));
            rwkv_phase(t2_, b2_, gdim_, shm, hbuf, P.in[11 + z_] + (size_t)l * 1792, P.in[12 + z_] + (size_t)l * DMIX, P.in[13 + z_] + (size_t)l * 64 * DMIX, P.in[14 + z_] + (size_t)l * DMIX,
                       P.in[15 + z_] + (size_t)l * 64 * DMIX, P.in[16 + z_] + (size_t)l * 128 * DMIX, P.in[17 + z_] + (size_t)l * DMIX, P.in[18 + z_] + (size_t)l * DMIX,
                       P.in[19 + z_] + (size_t)l * DMIX, P.in[20 + z_] + (size_t)l * DMIX, P.in[21 + z_] + (size_t)l * DMIX, ybase + (size_t)2 * MTOK * DMIX);
            }
            for (int r2 = 0; r2 < REP_SV; ++r2) { int t2_ = tid_, b2_ = bid_; asm volatile("" : "+v"(t2_)); asm volatile("" : "+s"(b2_));
            vtrans_phase(t2_, b2_, gdim_, (bf16_t*)shm, hbuf, vt);
            }
        } else if (k == 3) {
            attn_phase(tid_, bid_, gdim_, shm, hbuf, vt, P.in[22 + z_], ybase + (size_t)3 * MTOK * DMIX);
        } else if (k == 7) {
            ln_phase(tid_, bid_, gdim_, xb, P.in[27 + z_] + (size_t)l * D, P.in[28 + z_] + (size_t)l * D, nullptr);
        } else {
            ln_phase(tid_, bid_, gdim_, xb, P.in[34 + z_] + (size_t)l * D, P.in[35 + z_] + (size_t)l * D, l == DEPTH - 1 ? P.out : nullptr);
        }
        }
        if (ph + 1 < ph_hi) { if (ph == ph_lo) { asm volatile("s_waitcnt vmcnt(0) lgkmcnt(0)" ::: "memory"); grid.sync(); } else { int zb_ = 0; asm volatile("" : "+s"(zb_)); const int tb_ = (swid << 6) + (int)__builtin_amdgcn_mbcnt_hi(~0u, __builtin_amdgcn_mbcnt_lo(~0u, (unsigned)zb_)); xcd_barrier(xbar, tb_); } }
    }
}

extern "C" void kernel_launch(void* const* d_in, const int* in_sizes, int n_in, void* d_out, int out_size, void* d_ws, size_t ws_size, hipStream_t stream) {
    static int grid = 0;
    if (grid == 0) {
        int dev = 0, cus = 0, per_cu = 0;
        hipGetDevice(&dev);
        hipDeviceGetAttribute(&cus, hipDeviceAttributeMultiprocessorCount, dev);
        hipFuncSetAttribute((const void*)mega, hipFuncAttributeMaxDynamicSharedMemorySize, LDS_BYTES);
        hipOccupancyMaxActiveBlocksPerMultiprocessor(&per_cu, (const void*)mega, 512, LDS_BYTES);
        if (per_cu < 1) { fprintf(stderr, "kernel_launch: occupancy query says %d blocks/CU\n", per_cu); per_cu = 1; }
        (void)hipGetLastError();
        grid = cus * 1;
        if (n_in != 36 || ws_size < 1013 * MiB) fprintf(stderr, "kernel_launch: unexpected n_in %d / ws_size %zu\n", n_in, ws_size);
    }
    (void)hipMemsetAsync((char*)d_ws + WS_BAR, 0, XCD_BAR_WORDS * sizeof(unsigned), stream);
    Params p{};
    for (int i = 0; i < 36; ++i) p.in[i] = (const float*)d_in[i];
    p.out = (float*)d_out; p.ws = (unsigned char*)d_ws;
#if ONE_LAUNCH
    int lo = 0, hi = DEPTH * NPH;
    void* args[] = {&p, &lo, &hi};
    hipError_t e = hipLaunchCooperativeKernel((const void*)mega, dim3(grid), dim3(512), args, LDS_BYTES, stream);
    if (e != hipSuccess) fprintf(stderr, "cooperative launch failed: %s (grid %d)\n", hipGetErrorString(e), grid);
#else
    for (int ph = 0; ph < DEPTH * NPH; ++ph) hipLaunchKernelGGL(mega, dim3(grid), dim3(512), LDS_BYTES, stream, p, ph, ph + 1);
#endif
}
```

```cpp
#include <hip/hip_runtime.h>
#include <hip/hip_cooperative_groups.h>
#include <cstdio>
#include <cstdint>
namespace cg = cooperative_groups;

#ifndef REPK
#define REPK -1
#endif
#ifndef REPN
#define REPN 1
#endif
#ifndef REP_LRU
#define REP_LRU 1
#endif
#ifndef REP_RWKV
#define REP_RWKV 1
#endif
#ifndef REP_SV
#define REP_SV 1
#endif
#ifndef ONE_LAUNCH
#define ONE_LAUNCH 1
#endif

#define LAS __attribute__((address_space(3)))
typedef unsigned short bf16_t;
typedef short bf16x8 __attribute__((ext_vector_type(8)));
typedef short bf16x4 __attribute__((ext_vector_type(4)));
typedef float f32x4 __attribute__((ext_vector_type(4)));
typedef float f32x2 __attribute__((ext_vector_type(2)));
typedef unsigned u32x4 __attribute__((ext_vector_type(4)));
typedef unsigned u32x2 __attribute__((ext_vector_type(2)));

constexpr int D = 1024, BATCH = 32, SEQ = 2048, DEPTH = 2, MTOK = BATCH * SEQ;
constexpr int DMIX = 512, INC = 5888, DFF = 4096, DPLE = 256;
constexpr int COL_A = 0, COL_B = 1024, COL_C = 2560, COL_D = 4352;
constexpr float ALPHA = 1.4142135623730951f;
constexpr float LN_EPS = 1e-5f, GN_EPS = 64e-5f;

constexpr size_t MiB = 1ull << 20;
constexpr size_t WS_XB = 0, WS_WT = 128 * MiB, WS_PB = 180 * MiB, WS_H = 212 * MiB, WS_VT = 948 * MiB;
constexpr size_t WO_IN = 0, WO_G = 6029312, WO_B = WO_G + 4194304, WO_OUT4 = WO_B + 2097152, WO_FF1 = WO_OUT4 + 4194304,
                 WO_FF2 = WO_FF1 + 4194304, WO_PLE = WO_FF2 + 4194304, WO_PLEG = WO_PLE + 262144;
constexpr int LDS_BYTES = 131072 + 16 + 8256;
constexpr size_t WS_BAR = 1012 * MiB;

struct Params {
    const float* in[36];
    float* out;
    unsigned char* ws;
};

__device__ __forceinline__ float bf2f(unsigned v) { return __uint_as_float(v << 16); }
typedef __bf16 bf16x2_t __attribute__((ext_vector_type(2)));
__device__ __forceinline__ unsigned cvt_pk_bf16(float lo, float hi) { f32x2 v = {lo, hi}; bf16x2_t b = __builtin_convertvector(v, bf16x2_t); unsigned r; __builtin_memcpy(&r, &b, 4); return r; }
__device__ __forceinline__ bf16_t f2bf(float f) { return (bf16_t)(cvt_pk_bf16(f, 0.f) & 0xffffu); }
__device__ __forceinline__ float fexp(float x) { return __builtin_amdgcn_exp2f(x * 1.4426950408889634f); }
__device__ __forceinline__ float flog(float x) { return __builtin_amdgcn_logf(x) * 0.6931471805599453f; }
__device__ __forceinline__ float ftanh(float x) { return 1.0f - 2.0f * __builtin_amdgcn_rcpf(1.0f + fexp(2.0f * x)); }
__device__ __forceinline__ float flog1p_small(float x) { return flog(1.0f + x); }
__device__ __forceinline__ float fneg_expm1(float t) { return 1.0f - fexp(t); }
__device__ __forceinline__ float sigmoidf_(float x) { return __builtin_amdgcn_rcpf(1.0f + fexp(-x)); }
__device__ __forceinline__ float wave_sum(float v) {
    v += __int_as_float(__builtin_amdgcn_update_dpp(0, __float_as_int(v), 0xB1, 0xF, 0xF, true));
    v += __int_as_float(__builtin_amdgcn_update_dpp(0, __float_as_int(v), 0x4E, 0xF, 0xF, true));
    v += __int_as_float(__builtin_amdgcn_update_dpp(0, __float_as_int(v), 0x141, 0xF, 0xF, true));
    v += __int_as_float(__builtin_amdgcn_update_dpp(0, __float_as_int(v), 0x140, 0xF, 0xF, true));
    const float s0 = __int_as_float(__builtin_amdgcn_readlane(__float_as_int(v), 0)), s1 = __int_as_float(__builtin_amdgcn_readlane(__float_as_int(v), 16));
    const float s2 = __int_as_float(__builtin_amdgcn_readlane(__float_as_int(v), 32)), s3 = __int_as_float(__builtin_amdgcn_readlane(__float_as_int(v), 48));
    return (s0 + s1) + (s2 + s3);
}
template <int N> __device__ __forceinline__ void wave_sum_n(float (&v)[N]) {
#pragma unroll
    for (int i = 0; i < N; ++i) v[i] += __int_as_float(__builtin_amdgcn_update_dpp(0, __float_as_int(v[i]), 0xB1, 0xF, 0xF, true));
#pragma unroll
    for (int i = 0; i < N; ++i) v[i] += __int_as_float(__builtin_amdgcn_update_dpp(0, __float_as_int(v[i]), 0x4E, 0xF, 0xF, true));
#pragma unroll
    for (int i = 0; i < N; ++i) v[i] += __int_as_float(__builtin_amdgcn_update_dpp(0, __float_as_int(v[i]), 0x141, 0xF, 0xF, true));
#pragma unroll
    for (int i = 0; i < N; ++i) v[i] += __int_as_float(__builtin_amdgcn_update_dpp(0, __float_as_int(v[i]), 0x140, 0xF, 0xF, true));
#pragma unroll
    for (int i = 0; i < N; ++i) v[i] += __int_as_float(__builtin_amdgcn_update_dpp(0, __float_as_int(v[i]), 0x142, 0xA, 0xF, false));
#pragma unroll
    for (int i = 0; i < N; ++i) v[i] += __int_as_float(__builtin_amdgcn_update_dpp(0, __float_as_int(v[i]), 0x143, 0xC, 0xF, false));
#pragma unroll
    for (int i = 0; i < N; ++i) v[i] = __int_as_float(__builtin_amdgcn_readlane(__float_as_int(v[i]), 63));
}
__device__ __forceinline__ float shflx(float v, int lane, int m) { return __int_as_float(__builtin_amdgcn_ds_bpermute((lane ^ m) << 2, __float_as_int(v))); }
__device__ __forceinline__ void unpack8(u32x4 u, float* f) {
#pragma unroll
    for (int i = 0; i < 4; ++i) { f[2 * i] = __uint_as_float(u[i] << 16); f[2 * i + 1] = __uint_as_float(u[i] & 0xffff0000u); }
}
__device__ __forceinline__ u32x4 pack8(const float* f) {
    u32x4 u;
#pragma unroll
    for (int i = 0; i < 4; ++i) u[i] = cvt_pk_bf16(f[2 * i], f[2 * i + 1]);
    return u;
}

namespace pg8 {
constexpr int BM = 256, BK = 64, HALF = 128, HTB = HALF * BK * 2, STAGE_BYTES = 8 * HTB, NXCD = 8, WGM = 8;
__host__ __device__ __forceinline__ int lds_byte(int r, int c) { const int st = (r >> 4) * 2 + (c >> 5), rr = r & 15, cc = c & 31, ob = rr * 64 + cc * 2; return st * 1024 + (ob ^ (((ob >> 9) & 1) << 5)); }
__host__ __device__ __forceinline__ void stage_rc(int b, int& R, int& C) { const int st = b / 1024, sb = b % 1024, swz = sb ^ (((sb >> 9) & 1) << 5); R = (st >> 1) * 16 + swz / 64; C = (st & 1) * 32 + (swz % 64) / 2; }
__host__ __device__ __forceinline__ int perm32(int rho) { const int n = rho >> 4, i = rho & 15; return 8 * (i >> 2) + 4 * n + (i & 3); }
struct Unit { int pm, pn; };
struct Gemm { const bf16_t* A; const bf16_t* Bt; int M, N, K, lda, ldb; };
struct StaticOrder {
    int nM, nN, nwg, G, c, merge;
    __device__ void init(int M, int N, int G_, int c_, int merge_) { merge = merge_; nM = M / BM; nN = (merge_ ? N / 4 : N) / BM; nwg = nM * nN; G = G_; c = c_; }
    __device__ bool next(int i, Unit& u) const {
        int n = 0; if (merge) { n = i & 3; i >>= 2; }
        const long L = (long)i * G + c; if (L >= nwg) return false;
        int wgid = (int)L; { const int q = nwg / NXCD, r = nwg % NXCD, xcd = wgid % NXCD, off = wgid / NXCD; wgid = (xcd < r ? xcd * (q + 1) : r * (q + 1) + (xcd - r) * q) + off; }
        const int nig = WGM * nN, gid = wgid / nig, fm = gid * WGM, gsz = (nM - fm) < WGM ? (nM - fm) : WGM;
        u.pm = fm + ((wgid % nig) % gsz); u.pn = (wgid % nig) / gsz + n * nN; return true;
    }
};

struct Epi {
    int mode;
    int act;
    bf16_t* ob; int ldo;
    const float* bias;
    bf16_t* io2;
    const float* resf;
    const bf16_t* aux;
    __device__ __forceinline__ void operator()(const f32x4 (&acc)[2][2][4][2], const Unit& u, int wr, int wc, int fr, int fq, LAS unsigned char* dump) const {
        int row0 = u.pm * BM + wr * 64 + fr, col0 = u.pn * BM + wc * 32 + 8 * fq;
        asm volatile("" : "+v"(row0), "+v"(col0));
        float bv[2][8];
        if (mode == 1 || mode == 3) {
#pragma unroll
            for (int bj = 0; bj < 2; ++bj) { const f32x4 b0 = *(const f32x4*)(bias + col0 + bj * HALF), b1 = *(const f32x4*)(bias + col0 + bj * HALF + 4);
#pragma unroll
                for (int j = 0; j < 4; ++j) { bv[bj][j] = b0[j]; bv[bj][4 + j] = b1[j]; } }
        }
        if (mode != 0) {
#pragma unroll
            for (int ai = 0; ai < 2; ++ai)
#pragma unroll
                for (int m = 0; m < 4; ++m)
#pragma unroll
                    for (int bj = 0; bj < 2; ++bj) {
                        const size_t row = (size_t)(row0 + ai * HALF + m * 16); const int col = col0 + bj * HALF;
                        const void* p0 = (mode == 2) ? (resf ? (const void*)(resf + row * D + col) : (const void*)(io2 + row * D + col)) : (const void*)(ob + row * ldo + col);
                        __builtin_amdgcn_global_load_lds((const unsigned*)p0, (LAS unsigned*)dump, 16, 0, 0);
                        if (mode == 2 && aux) __builtin_amdgcn_global_load_lds((const unsigned*)(aux + row * D + col), (LAS unsigned*)dump, 16, 0, 0);
                    }
        }
#pragma unroll
        for (int aim = 0; aim < 4; ++aim) {
            const int ai = aim >> 1, mh = aim & 1;
            u32x4 L0[4], L1[4];
            if (mode != 0) {
#pragma unroll
                for (int m2 = 0; m2 < 2; ++m2)
#pragma unroll
                    for (int bj = 0; bj < 2; ++bj) {
                        const int m = mh * 2 + m2;
                        const size_t row = (size_t)(row0 + ai * HALF + m * 16); const int col = col0 + bj * HALF, e = m2 * 2 + bj;
                        if (mode == 1) L0[e] = *(const u32x4*)(ob + row * ldo + col);
                        else if (mode == 3) { L0[e] = *(const u32x4*)(ob + row * ldo + col);
                            if (col >= D) L1[e] = *(const u32x4*)(io2 + row * D + (col & (D - 1))); }
                        else { if (resf) { L0[e] = *(const u32x4*)(resf + row * D + col); L1[e] = *(const u32x4*)(resf + row * D + col + 4); }
                               else { L0[e] = *(const u32x4*)(io2 + row * D + col); if (aux) L1[e] = *(const u32x4*)(aux + row * D + col); } }
                    }
            }
#pragma unroll
            for (int m2 = 0; m2 < 2; ++m2)
#pragma unroll
                for (int bj = 0; bj < 2; ++bj) {
                    const int m = mh * 2 + m2;
                    const size_t row = (size_t)(row0 + ai * HALF + m * 16); const int col = col0 + bj * HALF, e = m2 * 2 + bj;
                    float v[8];
#pragma unroll
                    for (int j = 0; j < 4; ++j) { v[j] = acc[ai][bj][m][0][j]; v[4 + j] = acc[ai][bj][m][1][j]; }
                    if (mode == 0) {
                        if (act == 1) {
#pragma unroll
                            for (int j = 0; j < 8; ++j) { const float t = fmaxf(v[j], 0.f); v[j] = t * t; }
                        }
                        *(u32x4*)(ob + row * ldo + col) = pack8(v);
                    } else if (mode == 1) {
                        float a[8]; unpack8(L0[e], a);
#pragma unroll
                        for (int j = 0; j < 8; ++j) v[j] = sigmoidf_(v[j] + bv[bj][j]) * a[j];
                        *(u32x4*)(ob + row * ldo + col) = pack8(v);
                    } else if (mode == 3) {
                        float a[8]; unpack8(L0[e], a);
#pragma unroll
                        for (int j = 0; j < 8; ++j) v[j] = sigmoidf_(v[j] + bv[bj][j]) * a[j];
                        if (col >= D) { float q[8]; unpack8(L1[e], q);
#pragma unroll
                            for (int j = 0; j < 8; ++j) v[j] += q[j]; }
                        *(u32x4*)(io2 + row * D + (col & (D - 1))) = pack8(v);
                    } else {
                        float r[8];
                        if (resf) {
#pragma unroll
                            for (int j = 0; j < 4; ++j) { r[j] = __uint_as_float(L0[e][j]); r[4 + j] = __uint_as_float(L1[e][j]); } }
                        else unpack8(L0[e], r);
#pragma unroll
                        for (int j = 0; j < 8; ++j) v[j] += ALPHA * r[j];
                        if (aux) { float a[8]; unpack8(L1[e], a);
#pragma unroll
                            for (int j = 0; j < 8; ++j) v[j] += a[j]; }
                        *(u32x4*)(io2 + row * D + col) = pack8(v);
                    }
                }
        }
    }
};

__device__ __forceinline__ void gemm_phase(const int tid, LAS unsigned char* lds, const Gemm g, const StaticOrder& S, const Epi& E) {
    const int wid = __builtin_amdgcn_readfirstlane(tid >> 6), lane = tid & 63, wr = wid >> 2, wc = wid & 3, fr = lane & 15, fq = lane >> 4;
    const int K = g.K, nt = K / BK;
    unsigned voffA[2], voffB[2];
#pragma unroll
    for (int i = 0; i < 2; ++i) { int R, C; stage_rc(tid * 16 + i * 8192, R, C); const int Rb = (R & ~31) + perm32(R & 31);
        voffA[i] = (unsigned)(R * g.lda + C) * 2u; voffB[i] = (unsigned)(Rb * g.ldb + C) * 2u; }
    const size_t kstep = (size_t)(BK * 2);
    const size_t hstepA = (size_t)HALF * g.lda * 2, hstepB = (size_t)HALF * g.ldb * 2;
    const size_t tstepA = 2 * hstepA, tstepB = 2 * hstepB;
    const unsigned ldsw = (unsigned)wid * 1024u;
    const int aoff = lds_byte(wr * 64 + fr, fq * 8), boff = lds_byte(wc * 32 + fr, fq * 8);
#define PG8_SA(b, h) (((b) * 2 + (h)) * HTB)
#define PG8_SB(b, h) ((4 + (b) * 2 + (h)) * HTB)
#define PG8_STAGE(bufoff, gbase, voff) do { _Pragma("unroll") for (int _i = 0; _i < 2; ++_i) \
        __builtin_amdgcn_global_load_lds((const unsigned*)((const char*)(gbase) + (voff)[_i]), (LAS unsigned*)(lds + (bufoff) + ldsw + _i * 8192), 16, 0, 0); } while (0)
#define PG8_LDA(dst, b, h) do { _Pragma("unroll") for (int m = 0; m < 4; ++m) _Pragma("unroll") for (int k = 0; k < 2; ++k) dst[m][k] = *(const LAS bf16x8*)(lds + PG8_SA(b, h) + aoff + m * 2048 + k * 1024); } while (0)
#define PG8_LDB(dst, b, h) do { _Pragma("unroll") for (int n = 0; n < 2; ++n) _Pragma("unroll") for (int k = 0; k < 2; ++k) dst[n][k] = *(const LAS bf16x8*)(lds + PG8_SB(b, h) + boff + n * 2048 + k * 1024); } while (0)
#define PG8_MMA(ai, bj, At, Bt) do { __builtin_amdgcn_s_setprio(1); _Pragma("unroll") for (int m = 0; m < 4; ++m) _Pragma("unroll") for (int n = 0; n < 2; ++n) _Pragma("unroll") for (int k = 0; k < 2; ++k) \
        acc[ai][bj][m][n] = __builtin_amdgcn_mfma_f32_16x16x32_bf16(Bt[n][k], At[m][k], acc[ai][bj][m][n], 0, 0, 0); __builtin_amdgcn_s_setprio(0); } while (0)
#define PG8_WAIT_V(n) asm volatile("s_waitcnt vmcnt(" #n ")" ::: "memory")
#define PG8_WAIT_L(n) asm volatile("s_waitcnt lgkmcnt(" #n ")" ::: "memory")
#define PG8_BAR __builtin_amdgcn_s_barrier()
#define PG8_SCHED __builtin_amdgcn_sched_barrier(0)
    Unit cur, nxt; int ui = 0;
    if (!S.next(0, cur)) return;
    f32x4 acc[2][2][4][2];
#pragma unroll
    for (int a = 0; a < 2; ++a)
#pragma unroll
        for (int b = 0; b < 2; ++b)
#pragma unroll
            for (int m = 0; m < 4; ++m)
#pragma unroll
                for (int n = 0; n < 2; ++n) acc[a][b][m][n] = (f32x4){0.f, 0.f, 0.f, 0.f};
    bf16x8 At[4][2], B0[2][2], B1[2][2];
    const char* cA = (const char*)g.A + (size_t)cur.pm * tstepA; const char* cB = (const char*)g.Bt + (size_t)cur.pn * tstepB;
    PG8_STAGE(PG8_SB(0, 0), cB, voffB); PG8_STAGE(PG8_SA(0, 0), cA, voffA); PG8_STAGE(PG8_SB(0, 1), cB + hstepB, voffB); PG8_STAGE(PG8_SA(0, 1), cA + hstepA, voffA);
    if (wr == 1) PG8_BAR;
    PG8_WAIT_V(4); PG8_BAR;
    PG8_STAGE(PG8_SB(1, 0), cB + kstep, voffB); PG8_STAGE(PG8_SA(1, 0), cA + kstep, voffA); PG8_STAGE(PG8_SB(1, 1), cB + hstepB + kstep, voffB);
    PG8_WAIT_V(6); PG8_BAR;
    for (;;) {
        const bool has_next = S.next(ui + 1, nxt);
        const char* nA = has_next ? (const char*)g.A + (size_t)nxt.pm * tstepA : cA; const char* nB = has_next ? (const char*)g.Bt + (size_t)nxt.pn * tstepB : cB;
        for (int t = 0; t < nt; t += 2) {
            const bool last = (t == nt - 2);
            const char* a1 = cA + (size_t)(t + 1) * kstep;
            const char* a2 = last ? nA : cA + (size_t)(t + 2) * kstep; const char* b2 = last ? nB : cB + (size_t)(t + 2) * kstep;
            const char* a3 = a2 + kstep; const char* b3 = b2 + kstep;
            PG8_LDB(B0, 0, 0); PG8_SCHED; PG8_LDA(At, 0, 0); PG8_STAGE(PG8_SA(1, 1), a1 + hstepA, voffA);
            PG8_WAIT_L(8); PG8_BAR; PG8_WAIT_L(0); PG8_MMA(0, 0, At, B0); PG8_BAR; PG8_SCHED;
            PG8_LDB(B1, 0, 1); PG8_STAGE(PG8_SB(0, 0), b2, voffB);
            PG8_BAR; PG8_WAIT_L(0); PG8_MMA(0, 1, At, B1); PG8_BAR;
            PG8_LDA(At, 0, 1); PG8_STAGE(PG8_SA(0, 0), a2, voffA);
            PG8_BAR; PG8_WAIT_L(0); PG8_MMA(1, 0, At, B0); PG8_BAR; PG8_SCHED;
            PG8_STAGE(PG8_SB(0, 1), b2 + hstepB, voffB);
            PG8_WAIT_V(6); PG8_BAR; PG8_MMA(1, 1, At, B1); PG8_BAR;
            PG8_LDB(B0, 1, 0); PG8_SCHED; PG8_LDA(At, 1, 0); PG8_STAGE(PG8_SA(0, 1), a2 + hstepA, voffA);
            PG8_WAIT_L(8); PG8_BAR; PG8_WAIT_L(0); PG8_MMA(0, 0, At, B0); PG8_BAR; PG8_SCHED;
            PG8_LDB(B1, 1, 1); PG8_STAGE(PG8_SB(1, 0), b3, voffB);
            PG8_BAR; PG8_WAIT_L(0); PG8_MMA(0, 1, At, B1); PG8_BAR;
            PG8_LDA(At, 1, 1); PG8_STAGE(PG8_SA(1, 0), a3, voffA);
            PG8_BAR; PG8_WAIT_L(0); PG8_MMA(1, 0, At, B0); PG8_BAR; PG8_SCHED;
            PG8_STAGE(PG8_SB(1, 1), b3 + hstepB, voffB);
            PG8_WAIT_V(6); PG8_BAR; PG8_MMA(1, 1, At, B1); PG8_BAR;
        }
        if (wr == 0) PG8_BAR;
        E(acc, cur, wr, wc, fr, fq, lds + 131088 + ldsw);
        if (!has_next) break;
#pragma unroll
        for (int a = 0; a < 2; ++a)
#pragma unroll
            for (int b = 0; b < 2; ++b)
#pragma unroll
                for (int m = 0; m < 4; ++m)
#pragma unroll
                    for (int n = 0; n < 2; ++n) acc[a][b][m][n] = (f32x4){0.f, 0.f, 0.f, 0.f};
        cur = nxt; cA = nA; cB = nB; ++ui;
        if (wr == 1) PG8_BAR;
    }
    PG8_WAIT_V(0);
    PG8_BAR;
#undef PG8_SA
#undef PG8_SB
#undef PG8_STAGE
#undef PG8_LDA
#undef PG8_LDB
#undef PG8_MMA
#undef PG8_WAIT_V
#undef PG8_WAIT_L
#undef PG8_BAR
#undef PG8_SCHED
}
}

#define LDS_BARRIER() do { asm volatile("s_waitcnt lgkmcnt(0)" ::: "memory"); __builtin_amdgcn_s_barrier(); asm volatile("" ::: "memory"); } while (0)

__device__ __forceinline__ void tconv(const int tid_, const int bid_, const int gdim_, float* tile, const float* __restrict__ src, int K, int N, bf16_t* __restrict__ dst, int ldd) {
    const int tn = N / 64, nt = (K / 64) * tn;
    const int r = tid_ >> 3, c = (tid_ & 7) * 8;
    int t = bid_;
    f32x4 a, b;
    if (t < nt) { const f32x4* s = (const f32x4*)(src + (size_t)((t / tn) * 64 + r) * N + (t % tn) * 64 + c); a = s[0]; b = s[1]; }
    for (; t < nt; t += gdim_) {
        const int k0 = (t / tn) * 64, n0 = (t % tn) * 64;
#pragma unroll
        for (int j = 0; j < 4; ++j) { tile[r * 65 + c + j] = a[j]; tile[r * 65 + c + 4 + j] = b[j]; }
        const int t2 = t + gdim_;
        if (t2 < nt) { const f32x4* s = (const f32x4*)(src + (size_t)((t2 / tn) * 64 + r) * N + (t2 % tn) * 64 + c); a = s[0]; b = s[1]; }
        LDS_BARRIER();
        float v[8];
#pragma unroll
        for (int j = 0; j < 8; ++j) v[j] = tile[(c + j) * 65 + r];
        *(u32x4*)(dst + (size_t)(n0 + r) * ldd + k0 + c) = pack8(v);
        LDS_BARRIER();
    }
}
__device__ __forceinline__ void econv(const int tid_, const int bid_, const int gdim_, const float* __restrict__ src, bf16_t* __restrict__ dst, size_t n) {
    const size_t nth = (size_t)gdim_ * 512;
    for (size_t i = ((size_t)bid_ * 512 + tid_) * 8; i < n; i += nth * 8) {
        const f32x4 a = *(const f32x4*)(src + i), b = *(const f32x4*)(src + i + 4);
        float v[8] = {a[0], a[1], a[2], a[3], b[0], b[1], b[2], b[3]};
        *(u32x4*)(dst + i) = pack8(v);
    }
}

__device__ __forceinline__ void ln_phase(const int tid_, const int bid_, const int gdim_, bf16_t* xio, const float* __restrict__ g, const float* __restrict__ b, float* outf) {
    const int lane = tid_ & 63, wid = tid_ >> 6;
    const int nw = gdim_ * 8;
    float gg[16], bb[16];
#pragma unroll
    for (int i = 0; i < 2; ++i)
#pragma unroll
        for (int j = 0; j < 8; ++j) { gg[i * 8 + j] = g[i * 512 + lane * 8 + j]; bb[i * 8 + j] = b[i * 512 + lane * 8 + j]; }
    for (int row = bid_ * 8 + wid; row < MTOK; row += nw) {
        bf16_t* p = xio + (size_t)row * D + lane * 8;
        float v[16]; unpack8(*(const u32x4*)p, v); unpack8(*(const u32x4*)(p + 512), v + 8);
        float s = 0.f;
#pragma unroll
        for (int j = 0; j < 16; ++j) s += v[j];
        const float mean = wave_sum(s) * (1.0f / D);
        float q = 0.f;
#pragma unroll
        for (int j = 0; j < 16; ++j) { const float d = v[j] - mean; q += d * d; }
        const float rstd = __builtin_amdgcn_rsqf(wave_sum(q) * (1.0f / D) + LN_EPS);
#pragma unroll
        for (int j = 0; j < 16; ++j) v[j] = (v[j] - mean) * rstd * gg[j] + bb[j];
        if (!outf) { *(u32x4*)p = pack8(v); *(u32x4*)(p + 512) = pack8(v + 8); }
        else { float* o = outf + (size_t)row * D + lane * 8;
            *(f32x4*)o = (f32x4){v[0], v[1], v[2], v[3]}; *(f32x4*)(o + 4) = (f32x4){v[4], v[5], v[6], v[7]};
            *(f32x4*)(o + 512) = (f32x4){v[8], v[9], v[10], v[11]}; *(f32x4*)(o + 516) = (f32x4){v[12], v[13], v[14], v[15]}; }
    }
}

__device__ __forceinline__ void sconv_phase(const int tid_, const int bid_, const int gdim_, const bf16_t* __restrict__ h, const float* __restrict__ w  , bf16_t* __restrict__ yb) {
    const size_t nth = (size_t)gdim_ * 512;
    for (size_t idx = (size_t)bid_ * 512 + tid_; idx < (size_t)MTOK * 64; idx += nth) {
        const int tok = (int)(idx >> 6), c8 = (int)(idx & 63) * 8, t = tok & (SEQ - 1);
        float acc[8];
#pragma unroll
        for (int j = 0; j < 8; ++j) acc[j] = 0.f;
#pragma unroll
        for (int k = 0; k < 3; ++k) {
            const int tt = t - 2 + k;
            if (tt >= 0) {
                const bf16_t* row = h + (size_t)(tok - 2 + k) * INC + COL_B;
                float cgv[8], xh[8]; unpack8(*(const u32x4*)(row + 512 + c8), cgv); unpack8(*(const u32x4*)(row + 1024 + c8), xh);
                const f32x4 w0 = *(const f32x4*)(w + k * 512 + c8), w1 = *(const f32x4*)(w + k * 512 + c8 + 4);
#pragma unroll
                for (int j = 0; j < 4; ++j) { acc[j] += w0[j] * (cgv[j] * xh[j]); acc[4 + j] += w1[j] * (cgv[4 + j] * xh[4 + j]); }
            }
        }
        float bg[8]; unpack8(*(const u32x4*)(h + (size_t)tok * INC + COL_B + c8), bg);
#pragma unroll
        for (int j = 0; j < 8; ++j) acc[j] *= bg[j];
        *(u32x4*)(yb + (size_t)tok * DMIX + c8) = pack8(acc);
    }
}

__device__ __forceinline__ void vtrans_phase(const int tid_, const int bid_, const int gdim_, bf16_t* tile  , const bf16_t* __restrict__ h, bf16_t* __restrict__ vt) {
    const int r = tid_ >> 3, c = (tid_ & 7) * 8;
    int it = bid_;
    u32x4 u;
    if (it < BATCH * 8 * 32) { const int bh = it >> 5, tc = it & 31; u = *(const u32x4*)(h + (size_t)((bh >> 3) * SEQ + tc * 64 + r) * INC + COL_D + 1024 + (bh & 7) * 64 + c); }
    for (; it < BATCH * 8 * 32; it += gdim_) {
        const int bh = it >> 5, tc = it & 31;
#pragma unroll
        for (int j = 0; j < 4; ++j) { tile[(c + 2 * j) * 72 + r] = (bf16_t)(u[j] & 0xffffu); tile[(c + 2 * j + 1) * 72 + r] = (bf16_t)(u[j] >> 16); }
        const int i2 = it + gdim_;
        if (i2 < BATCH * 8 * 32) { const int bh2 = i2 >> 5, tc2 = i2 & 31; u = *(const u32x4*)(h + (size_t)((bh2 >> 3) * SEQ + tc2 * 64 + r) * INC + COL_D + 1024 + (bh2 & 7) * 64 + c); }
        LDS_BARRIER();
        *(u32x4*)(vt + (size_t)(bh * 64 + r) * SEQ + tc * 64 + c) = *(const u32x4*)(tile + r * 72 + c);
        LDS_BARRIER();
    }
}

__device__ __forceinline__ void attn_phase(const int tid_, const int bid_, const int gdim_, unsigned char* ldsb, const bf16_t* __restrict__ h, const bf16_t* __restrict__ vt, const float* __restrict__ rel_bias, bf16_t* __restrict__ yd) {
    constexpr float L2E = 1.4426950408889634f;
    float* rb = (float*)(ldsb + 131088);
    for (int i = tid_; i < 8 * 257; i += 512) rb[i] = rel_bias[i] * L2E;
    __syncthreads();
    const int lane = tid_ & 63, wid = __builtin_amdgcn_readfirstlane(tid_ >> 6), lr = lane & 15, quad = lane >> 4;
    const int nw = gdim_ * 8;
    unsigned char* wl = ldsb + wid * 16384;
    const int krow = lane >> 3, kchunk = (lane & 7) ^ (krow & 7);
    const int vrow = lane >> 2, vchunk = (lane & 3) ^ ((vrow >> 2) & 3);
    int koff[2][2], voff[4];
#pragma unroll
    for (int tt = 0; tt < 2; ++tt)
#pragma unroll
        for (int dh = 0; dh < 2; ++dh) { const int row = (lr >> 2) * 8 + tt * 4 + (lr & 3); koff[tt][dh] = row * 128 + (((dh * 4 + quad) ^ (row & 7)) * 16); }
#pragma unroll
    for (int dt = 0; dt < 4; ++dt) { const int d = dt * 16 + lr; voff[dt] = 4096 + d * 64 + ((quad ^ ((d >> 2) & 3)) * 16); }
    int it = 0;
    for (int item0 = bid_ * 8 + wid; item0 < BATCH * 8 * 32; item0 += nw, ++it) {
        const int c = ((item0 & 31) + 8 * it) & 31, hh = (item0 >> 5) & 7, b = item0 >> 8;
        const int q0 = c * 64;
        const bf16_t* hb = h + (size_t)b * SEQ * INC + COL_D + hh * 64;
        bf16x8 qf[4][2];
        asm volatile("s_waitcnt lgkmcnt(0)" ::: "memory");
        {
            const bf16_t* qg = hb + (size_t)(q0 + krow) * INC + kchunk * 8;
#pragma unroll
            for (int i = 0; i < 8; ++i) __builtin_amdgcn_global_load_lds((const unsigned*)(qg + (size_t)i * 8 * INC), (LAS unsigned*)(wl + 8192 + i * 1024), 16, 0, 0);
        }
        const bf16_t* vb = vt + (size_t)((b * 8 + hh) * 64) * SEQ;
        const float* rbh = rb + hh * 257;
        const float cb2 = rbh[256];
        f32x4 oacc[4][4];
#pragma unroll
        for (int qi = 0; qi < 4; ++qi)
#pragma unroll
            for (int dt = 0; dt < 4; ++dt) oacc[qi][dt] = (f32x4){0.f, 0.f, 0.f, 0.f};
        float mrun[4] = {-1e30f, -1e30f, -1e30f, -1e30f}, lsum[4] = {0.f, 0.f, 0.f, 0.f};
        const int kstart = (c > 8 ? c - 8 : 0) * 64, kend = c * 64 + 64;
        const bf16_t* kg = hb + 512 + (size_t)krow * INC + kchunk * 8;
        const bf16_t* vg = vb + (size_t)vrow * SEQ + vchunk * 8;
#define AT_LOAD(buf, kt) do { _Pragma("unroll") for (int i = 0; i < 4; ++i) \
                __builtin_amdgcn_global_load_lds((const unsigned*)(kg + (size_t)((kt) + i * 8) * INC), (LAS unsigned*)(wl + (buf) * 8192 + i * 1024), 16, 0, 0); \
            _Pragma("unroll") for (int i = 0; i < 4; ++i) \
                __builtin_amdgcn_global_load_lds((const unsigned*)(vg + (size_t)i * 16 * SEQ + (kt)), (LAS unsigned*)(wl + (buf) * 8192 + 4096 + i * 1024), 16, 0, 0); } while (0)
#define AT_COMPUTE(buf, kt) do { \
            const bool far_ = ((kt) + 31 + 128 <= q0); \
            const unsigned char* bb_ = wl + (buf) * 8192; \
            bf16x8 kf[2][2], vf[4]; \
            _Pragma("unroll") for (int tt = 0; tt < 2; ++tt) _Pragma("unroll") for (int dh = 0; dh < 2; ++dh) kf[tt][dh] = *(const bf16x8*)(bb_ + koff[tt][dh]); \
            _Pragma("unroll") for (int dt = 0; dt < 4; ++dt) vf[dt] = *(const bf16x8*)(bb_ + voff[dt]); \
            _Pragma("unroll") for (int qi = 0; qi < 4; ++qi) { \
                f32x4 s[2]; \
                _Pragma("unroll") for (int tt = 0; tt < 2; ++tt) { f32x4 a = (f32x4){0.f, 0.f, 0.f, 0.f}; \
                    a = __builtin_amdgcn_mfma_f32_16x16x32_bf16(kf[tt][0], qf[qi][0], a, 0, 0, 0); \
                    a = __builtin_amdgcn_mfma_f32_16x16x32_bf16(kf[tt][1], qf[qi][1], a, 0, 0, 0); s[tt] = a; } \
                float mx = -1e30f; \
                if (far_) { _Pragma("unroll") for (int tt = 0; tt < 2; ++tt) _Pragma("unroll") for (int j = 0; j < 4; ++j) { const float v = s[tt][j] * (0.125f * L2E) + cb2; s[tt][j] = v; mx = fmaxf(mx, v); } } \
                else { const int qpos = q0 + qi * 16 + lr; float bz[8]; \
                    _Pragma("unroll") for (int tt = 0; tt < 2; ++tt) _Pragma("unroll") for (int j = 0; j < 4; ++j) { \
                        int rel = qpos - ((kt) + quad * 8 + tt * 4 + j); rel = rel > 128 ? 128 : (rel < -128 ? -128 : rel); bz[tt * 4 + j] = rbh[rel + 128]; } \
                    _Pragma("unroll") for (int tt = 0; tt < 2; ++tt) _Pragma("unroll") for (int j = 0; j < 4; ++j) { \
                        const float v = s[tt][j] * (0.125f * L2E) + bz[tt * 4 + j]; s[tt][j] = v; mx = fmaxf(mx, v); } } \
                mx = fmaxf(mx, shflx(mx, lane, 16)); mx = fmaxf(mx, shflx(mx, lane, 32)); \
                const float mnew = fmaxf(mrun[qi], mx), sc = __builtin_amdgcn_exp2f(mrun[qi] - mnew); \
                mrun[qi] = mnew; \
                float ps = 0.f; float pv[8]; \
                _Pragma("unroll") for (int tt = 0; tt < 2; ++tt) _Pragma("unroll") for (int j = 0; j < 4; ++j) { const float p = __builtin_amdgcn_exp2f(s[tt][j] - mnew); pv[tt * 4 + j] = p; ps += p; } \
                lsum[qi] = lsum[qi] * sc + ps; \
                const u32x4 pu = pack8(pv); bf16x8 pf; __builtin_memcpy(&pf, &pu, 16); \
                _Pragma("unroll") for (int dt = 0; dt < 4; ++dt) { \
                    f32x4 o = oacc[qi][dt]; \
                    _Pragma("unroll") for (int j = 0; j < 4; ++j) o[j] *= sc; \
                    oacc[qi][dt] = __builtin_amdgcn_mfma_f32_16x16x32_bf16(vf[dt], pf, o, 0, 0, 0); } \
            } } while (0)
        AT_LOAD(0, kstart);
        asm volatile("s_waitcnt vmcnt(8)" ::: "memory");
#pragma unroll
        for (int qi = 0; qi < 4; ++qi)
#pragma unroll
            for (int dh = 0; dh < 2; ++dh) { const int row = qi * 16 + lr; qf[qi][dh] = *(const bf16x8*)(wl + 8192 + row * 128 + (((dh * 4 + quad) ^ (row & 7)) * 16)); }
        asm volatile("s_waitcnt lgkmcnt(0)" ::: "memory");
        for (int kt0 = kstart; kt0 < kend; kt0 += 64) {
            AT_LOAD(1, kt0 + 32);
            asm volatile("s_waitcnt vmcnt(8)" ::: "memory");
            AT_COMPUTE(0, kt0);
            if (kt0 + 64 < kend) { AT_LOAD(0, kt0 + 64); asm volatile("s_waitcnt vmcnt(8)" ::: "memory"); }
            else asm volatile("s_waitcnt vmcnt(0)" ::: "memory");
            AT_COMPUTE(1, kt0 + 32);
        }
#undef AT_LOAD
#undef AT_COMPUTE
#pragma unroll
        for (int qi = 0; qi < 4; ++qi) {
            float l = lsum[qi]; l += shflx(l, lane, 16); l += shflx(l, lane, 32);
            const float inv = __builtin_amdgcn_rcpf(l);
#pragma unroll
            for (int dt = 0; dt < 4; ++dt) {
                u32x2 pk; pk[0] = cvt_pk_bf16(oacc[qi][dt][0] * inv, oacc[qi][dt][1] * inv); pk[1] = cvt_pk_bf16(oacc[qi][dt][2] * inv, oacc[qi][dt][3] * inv);
                *(u32x2*)(wl + (qi * 16 + lr) * 136 + (dt * 16 + quad * 4) * 2) = pk;
            }
        }
        asm volatile("" ::: "memory");
#pragma unroll
        for (int i = 0; i < 8; ++i) {
            const int row = i * 8 + krow;
            *(u32x4*)(yd + (size_t)(b * SEQ + q0 + row) * DMIX + hh * 64 + (lane & 7) * 8) = *(const u32x4*)(wl + row * 136 + (lane & 7) * 16);
        }
    }
    __syncthreads();
}

__device__ __forceinline__ void lru_phase(const int tid_, const int bid_, const int gdim_, unsigned char* lds, const bf16_t* __restrict__ h, const float* __restrict__ conv_w, const float* __restrict__ conv_b,
                          const float* __restrict__ wrp, const float* __restrict__ brp, const float* __restrict__ wip, const float* __restrict__ bip,
                          const float* __restrict__ lam, bf16_t* __restrict__ ya_out) {
    bf16_t* WrT = (bf16_t*)lds;
    bf16_t* WiT = WrT + 64 * 72;
    bf16_t* xcb = WiT + 64 * 72;
    bf16_t* xraw = xcb + 64 * 72;
    bf16_t* yraw = xraw + 67 * 64 + 64;
    float* xcf = (float*)(yraw + 64 * 64);
    float* abuf = xcf + 4096;
    float* ubuf = abuf + 4096;
    float* ibuf = ubuf + 4096;
    float* hbuf = ibuf + 4096;
    float* gbuf = xcf;
    const int tid = tid_, lane = tid & 63, wid = tid >> 6, lr = lane & 15, quad = lane >> 4;
    for (int item = bid_; item < BATCH * 8; item += gdim_) {
        const int b = item >> 3, g = item & 7;
        __syncthreads();
        for (int e = tid; e < 4096; e += 512) { const int i = e >> 6, j = e & 63;
            WrT[j * 72 + i] = f2bf(wrp[(size_t)g * 4096 + e]); WiT[j * 72 + i] = f2bf(wip[(size_t)g * 4096 + e]); }
        const int ch = tid & 63, trow = tid >> 6;
        const int cg_ = g * 64 + ch;
        const float cw0 = conv_w[cg_], cw1 = conv_w[512 + cg_], cw2 = conv_w[1024 + cg_], cw3 = conv_w[1536 + cg_], cb = conv_b[cg_];
        const int r8 = tid >> 3, pc = (tid & 7) * 8;
        const bf16_t* hrow = h + (size_t)(b * SEQ + r8) * INC + COL_A + g * 64 + pc;
        u32x4 xa16 = *(const u32x4*)hrow, ya16 = *(const u32x4*)(hrow + 512), prev16 = (u32x4){0u, 0u, 0u, 0u};
        float hstate = 0.f;
        for (int tc = 0; tc < SEQ / 64; ++tc) {
            const int t0 = tc * 64;
            *(u32x4*)(xraw + (3 + r8) * 64 + pc) = xa16; *(u32x4*)(yraw + r8 * 64 + pc) = ya16;
            if (r8 >= 61) *(u32x4*)(xraw + (r8 - 61) * 64 + pc) = prev16;
            prev16 = xa16;
            if (tc + 1 < SEQ / 64) { const bf16_t* nx = hrow + (size_t)(t0 + 64) * INC; xa16 = *(const u32x4*)nx; ya16 = *(const u32x4*)(nx + 512); }
            LDS_BARRIER();
#pragma unroll
            for (int i = 0; i < 8; ++i) {
                const int tl = trow + 8 * i;
                const float x3 = bf2f(xraw[tl * 64 + ch]), x2 = bf2f(xraw[(tl + 1) * 64 + ch]), x1 = bf2f(xraw[(tl + 2) * 64 + ch]), x0 = bf2f(xraw[(tl + 3) * 64 + ch]);
                const float xc = cw3 * x0 + cw2 * x1 + cw1 * x2 + cw0 * x3 + cb;
                xcf[tl * 64 + ch] = xc; xcb[tl * 72 + ch] = f2bf(xc);
            }
            LDS_BARRIER();
            {
                const int tt = wid & 3, which = wid >> 2;
                const bf16_t* WT = which ? WiT : WrT;
                const bf16x8 a0 = *(const bf16x8*)(xcb + (tt * 16 + lr) * 72 + quad * 8), a1 = *(const bf16x8*)(xcb + (tt * 16 + lr) * 72 + 32 + quad * 8);
#pragma unroll
                for (int jt = 0; jt < 4; ++jt) {
                    const bf16x8 b0 = *(const bf16x8*)(WT + (jt * 16 + lr) * 72 + quad * 8), b1 = *(const bf16x8*)(WT + (jt * 16 + lr) * 72 + 32 + quad * 8);
                    f32x4 cacc = (f32x4){0.f, 0.f, 0.f, 0.f};
                    cacc = __builtin_amdgcn_mfma_f32_16x16x32_bf16(a0, b0, cacc, 0, 0, 0);
                    cacc = __builtin_amdgcn_mfma_f32_16x16x32_bf16(a1, b1, cacc, 0, 0, 0);
                    const int j = jt * 16 + lr, cj = g * 64 + j;
                    if (which == 0) {
                        const float bias = brp[cj], lm = lam[cj];
                        const float sp = fmaxf(-lm, 0.f) + flog1p_small(fexp(-fabsf(lm)));
#pragma unroll
                        for (int jj = 0; jj < 4; ++jj) {
                            const int tl = tt * 16 + quad * 4 + jj;
                            const float r = sigmoidf_(cacc[jj] + bias);
                            const float la = -8.0f * r * sp;
                            abuf[tl * 64 + j] = fexp(la);
                            ubuf[tl * 64 + j] = __builtin_amdgcn_sqrtf(fneg_expm1(2.0f * la)) * xcf[tl * 64 + j];
                        }
                    } else {
                        const float bias = bip[cj];
#pragma unroll
                        for (int jj = 0; jj < 4; ++jj) { const int tl = tt * 16 + quad * 4 + jj; ibuf[tl * 64 + j] = sigmoidf_(cacc[jj] + bias); }
                    }
                }
            }
            LDS_BARRIER();
            if (wid == 0) {
#pragma unroll 8
                for (int tl = 0; tl < 64; ++tl) { hstate = abuf[tl * 64 + lane] * hstate + ubuf[tl * 64 + lane] * ibuf[tl * 64 + lane]; hbuf[tl * 64 + lane] = hstate; }
            } else {
                for (int e = tid - 64; e < 4096; e += 448) {
                    const float y = bf2f(yraw[e]);
                    gbuf[e] = 0.5f * y * (1.0f + ftanh(0.7978845608028654f * (y + 0.044715f * y * y * y)));
                }
            }
            LDS_BARRIER();
            {
                float o[8];
                const f32x4 h0 = *(const f32x4*)(hbuf + r8 * 64 + pc), h1 = *(const f32x4*)(hbuf + r8 * 64 + pc + 4);
                const f32x4 g0 = *(const f32x4*)(gbuf + r8 * 64 + pc), g1 = *(const f32x4*)(gbuf + r8 * 64 + pc + 4);
#pragma unroll
                for (int j = 0; j < 4; ++j) { o[j] = h0[j] * g0[j]; o[4 + j] = h1[j] * g1[j]; }
                *(u32x4*)(ya_out + (size_t)(b * SEQ + t0 + r8) * DMIX + g * 64 + pc) = pack8(o);
            }
        }
    }
    __syncthreads();
}

constexpr int RT = 16, REC = 456;
__device__ __forceinline__ float dpp_x1(float v) { return __int_as_float(__builtin_amdgcn_update_dpp(0, __float_as_int(v), 0xB1, 0xF, 0xF, true)); }
__device__ __forceinline__ float dpp_x2(float v) { return __int_as_float(__builtin_amdgcn_update_dpp(0, __float_as_int(v), 0x4E, 0xF, 0xF, true)); }
__device__ __forceinline__ void rwkv_phase(const int tid_, const int bid_, const int gdim_, unsigned char* lds, const bf16_t* __restrict__ h, const float* __restrict__ mu, const float* __restrict__ w0p, const float* __restrict__ w2p,
                           const float* __restrict__ a0p, const float* __restrict__ a2p, const float* __restrict__ g2p, const float* __restrict__ kkp, const float* __restrict__ kap,
                           const float* __restrict__ rkp, const float* __restrict__ gng, const float* __restrict__ gnb, bf16_t* __restrict__ yc) {
    bf16_t* W2T = (bf16_t*)lds;
    bf16_t* A2T = W2T + 64 * 72;
    bf16_t* G2T = A2T + 64 * 72;
    bf16_t* linb = G2T + 64 * 136;
    float* lo = (float*)(linb + 4 * 4 * 264);
    float* rec = lo + 4 * 4 * 192;
    float* obuf = rec + 2 * RT * REC;
    const int tid = tid_, lane = tid & 63, wid = __builtin_amdgcn_readfirstlane(tid >> 6);
    constexpr int NC = SEQ / RT;
    for (int item = bid_; item < BATCH * 8; item += gdim_) {
        const int b = item >> 3, hh = item & 7, hj = hh * 64 + lane;
        __syncthreads();
        for (int e = tid; e < 4096; e += 512) { const int i = e >> 6, j = e & 63; W2T[j * 72 + i] = f2bf(w2p[i * 512 + hh * 64 + j]); A2T[j * 72 + i] = f2bf(a2p[i * 512 + hh * 64 + j]); }
        for (int e = tid; e < 8192; e += 512) { const int i = e >> 6, j = e & 63; G2T[j * 136 + i] = f2bf(g2p[i * 512 + hh * 64 + j]); }
        __syncthreads();
        if (wid < 4) {
            const int r = lane >> 2, kq = lane & 3, row = wid * 16 + r;
            f32x2 S[8];
#pragma unroll
            for (int i = 0; i < 8; ++i) S[i] = (f32x2){0.f, 0.f};
            LDS_BARRIER();
            for (int c = 0; c < NC; ++c) {
                const float* R0 = rec + (c & 1) * RT * REC + kq * 16;
                float* ob = obuf + (c & 1) * RT * 64 + row;
                f32x4 dt[2][8], up[2][12]; float vv[2]; f32x2 scs[2];
#define RW_LOAD(buf, t) do { const float* Rk = R0 + (t) * REC; _Pragma("unroll") for (int i = 0; i < 4; ++i) { dt[buf][i] = *(const f32x4*)(Rk + 4 * i); dt[buf][4 + i] = *(const f32x4*)(Rk + 64 + 4 * i); } \
                    vv[buf] = Rk[320 - kq * 16 + row]; scs[buf] = *(const f32x2*)(Rk + 448 - kq * 16); \
                    _Pragma("unroll") for (int q = 0; q < 3; ++q) _Pragma("unroll") for (int i = 0; i < 4; ++i) up[buf][q * 4 + i] = *(const f32x4*)(Rk + 128 + q * 64 + 4 * i); } while (0)
                RW_LOAD(0, 0);
#pragma unroll
                for (int t = 0; t < RT; ++t) {
                    const int cb = t & 1;
                    if (t + 1 < RT) RW_LOAD(cb ^ 1, t + 1);
                    const float vval = vv[cb];
                    f32x2 sa0 = (f32x2){0.f, 0.f}, sa1 = (f32x2){0.f, 0.f}, yp0 = (f32x2){0.f, 0.f}, yp1 = (f32x2){0.f, 0.f};
#pragma unroll
                    for (int i = 0; i < 4; ++i) {
                        const f32x4 ah = dt[cb][i], wr = dt[cb][4 + i];
                        sa0 += S[2 * i] * (f32x2){ah[0], ah[1]}; sa1 += S[2 * i + 1] * (f32x2){ah[2], ah[3]};
                        yp0 += S[2 * i] * (f32x2){wr[0], wr[1]}; yp1 += S[2 * i + 1] * (f32x2){wr[2], wr[3]};
                    }
                    sa0 += sa1; yp0 += yp1;
                    float sa = sa0[0] + sa0[1], yp = yp0[0] + yp0[1];
                    sa += dpp_x1(sa); yp += dpp_x1(yp);
                    sa += dpp_x2(sa); yp += dpp_x2(yp);
                    if (kq == 0) ob[t * 64] = yp + sa * scs[cb][0] + vval * scs[cb][1];
                    const f32x2 sav = (f32x2){sa, sa}, vvv = (f32x2){vval, vval};
#pragma unroll
                    for (int i = 0; i < 4; ++i) {
                        const f32x4 dc = up[cb][i], bb = up[cb][4 + i], kp = up[cb][8 + i];
                        S[2 * i] = S[2 * i] * (f32x2){dc[0], dc[1]} + sav * (f32x2){bb[0], bb[1]} + vvv * (f32x2){kp[0], kp[1]};
                        S[2 * i + 1] = S[2 * i + 1] * (f32x2){dc[2], dc[3]} + sav * (f32x2){bb[2], bb[3]} + vvv * (f32x2){kp[2], kp[3]};
                    }
                }
#undef RW_LOAD
                LDS_BARRIER();
            }
        } else {
            const int p = wid - 4, lr = lane & 15, quad = lane >> 4;
            bf16_t* lb = linb + p * 4 * 264;
            float* lop = lo + p * 4 * 192;
            const float mu_r = mu[hj], mu_k = mu[512 + hj], mu_v = mu[1024 + hj];
            float mu_l[4];
#pragma unroll
            for (int q = 0; q < 4; ++q) mu_l[q] = mu[1536 + lane + 64 * q];
            const float w0 = w0p[hj], a0 = a0p[hj], k_k = kkp[hj], k_a = kap[hj], r_k = rkp[hj], gn_g = gng[hj], gn_b = gnb[hj];
            const bf16_t* hC = h + (size_t)b * SEQ * INC + COL_C;
            unsigned zraw[5][7];
#define RW_GLOAD(cn) do { _Pragma("unroll") for (int rw = 0; rw < 5; ++rw) { const int t = (cn) * RT + p * 4 + rw - 1; \
                    const bf16_t* ptr = hC + (size_t)(t < 0 ? 0 : t) * INC; \
                    zraw[rw][0] = ptr[hj]; zraw[rw][1] = ptr[512 + hj]; zraw[rw][2] = ptr[1024 + hj]; \
                    _Pragma("unroll") for (int q = 0; q < 4; ++q) zraw[rw][3 + q] = ptr[1536 + lane + 64 * q]; } } while (0)
            RW_GLOAD(0);
            for (int c = -1; c < NC; ++c) {
                const bool do_prep = (c + 1 < NC), do_post = (c >= 1);
                float cr[5], ck[5], cv[5], cl[5][4];
#pragma unroll
                for (int rw = 0; rw < 5; ++rw) { cr[rw] = bf2f(zraw[rw][0]); ck[rw] = bf2f(zraw[rw][1]); cv[rw] = bf2f(zraw[rw][2]);
#pragma unroll
                    for (int q = 0; q < 4; ++q) cl[rw][q] = bf2f(zraw[rw][3 + q]); }
                if (c == -1 && p == 0) { cr[0] = 0.f; ck[0] = 0.f; cv[0] = 0.f; cl[0][0] = 0.f; cl[0][1] = 0.f; cl[0][2] = 0.f; cl[0][3] = 0.f; }
                if (c + 2 < NC) RW_GLOAD(c + 2);
                if (do_post) {
                    const float* Rb = rec + ((c - 1) & 1) * RT * REC;
                    const float* ob = obuf + ((c - 1) & 1) * RT * 64;
                    float ov[4], sm[8];
#pragma unroll
                    for (int u = 0; u < 4; ++u) { ov[u] = ob[(p * 4 + u) * 64 + lane]; sm[2 * u] = ov[u]; sm[2 * u + 1] = ov[u] * ov[u]; }
                    wave_sum_n<8>(sm);
#pragma unroll
                    for (int u = 0; u < 4; ++u) {
                        const int tt = p * 4 + u, t = (c - 1) * RT + tt;
                        const float* R = Rb + tt * REC;
                        const float mean = sm[2 * u] * (1.0f / 64.0f), var = fmaxf(sm[2 * u + 1] * (1.0f / 64.0f) - mean * mean, 0.f);
                        float o = (ov[u] - mean) * __builtin_amdgcn_rsqf(var + GN_EPS) * gn_g + gn_b;
                        o += R[450] * R[320 + lane];
                        yc[(size_t)(b * SEQ + t) * DMIX + hj] = f2bf(o * R[384 + lane]);
                    }
                }
                if (do_prep) {
                    float rr[4], kx[4], vx[4];
#pragma unroll
                    for (int u = 0; u < 4; ++u) {
                        rr[u] = cr[u + 1] + (cr[u] - cr[u + 1]) * mu_r; kx[u] = ck[u + 1] + (ck[u] - ck[u + 1]) * mu_k; vx[u] = cv[u + 1] + (cv[u] - cv[u + 1]) * mu_v;
#pragma unroll
                        for (int q = 0; q < 4; ++q) {
                            const float z = cl[u + 1][q] + (cl[u][q] - cl[u + 1][q]) * mu_l[q];
                            const float val = (q == 0) ? ftanh(z) : (q == 1 ? z : sigmoidf_(z));
                            lb[u * 264 + lane + 64 * q] = f2bf(val);
                        }
                    }
                    asm volatile("s_waitcnt lgkmcnt(0)" ::: "memory");
                    bf16x8 af[8];
#pragma unroll
                    for (int k8 = 0; k8 < 8; ++k8) af[k8] = *(const bf16x8*)(lb + (lane & 3) * 264 + k8 * 32 + quad * 8);
#pragma unroll
                    for (int jt = 0; jt < 4; ++jt) {
                        f32x4 cw = (f32x4){0.f, 0.f, 0.f, 0.f}, ca = cw, cgm = cw;
#pragma unroll
                        for (int kh = 0; kh < 2; ++kh) {
                            cw = __builtin_amdgcn_mfma_f32_16x16x32_bf16(af[kh], *(const bf16x8*)(W2T + (jt * 16 + lr) * 72 + kh * 32 + quad * 8), cw, 0, 0, 0);
                            ca = __builtin_amdgcn_mfma_f32_16x16x32_bf16(af[2 + kh], *(const bf16x8*)(A2T + (jt * 16 + lr) * 72 + kh * 32 + quad * 8), ca, 0, 0, 0);
                        }
#pragma unroll
                        for (int kh = 0; kh < 4; ++kh)
                            cgm = __builtin_amdgcn_mfma_f32_16x16x32_bf16(af[4 + kh], *(const bf16x8*)(G2T + (jt * 16 + lr) * 136 + kh * 32 + quad * 8), cgm, 0, 0, 0);
                        if (quad == 0) {
#pragma unroll
                            for (int jj = 0; jj < 4; ++jj) { lop[jj * 192 + jt * 16 + lr] = cw[jj]; lop[jj * 192 + 64 + jt * 16 + lr] = ca[jj]; lop[jj * 192 + 128 + jt * 16 + lr] = cgm[jj]; }
                        }
                    }
                    asm volatile("s_waitcnt lgkmcnt(0)" ::: "memory");
                    float* Rb = rec + ((c + 1) & 1) * RT * REC;
                    float dcy[4], av[4], kqv[4], kpv[4], ggv[4], red[16];
#pragma unroll
                    for (int u = 0; u < 4; ++u) {
                        const float wl = w0 + lop[u * 192 + lane], ap = a0 + lop[u * 192 + 64 + lane]; ggv[u] = lop[u * 192 + 128 + lane];
                        const float z = -wl;
                        const float sp = fmaxf(z, 0.f) + flog(1.0f + fexp(-fabsf(z)));
                        dcy[u] = fexp(-fexp(-sp - 0.5f));
                        av[u] = sigmoidf_(ap);
                        kqv[u] = kx[u] * k_k;
                        kpv[u] = kx[u] * (1.0f + (av[u] - 1.0f) * k_a);
                        red[4 * u] = kqv[u] * kqv[u]; red[4 * u + 1] = kqv[u] * av[u] * rr[u]; red[4 * u + 2] = kpv[u] * rr[u]; red[4 * u + 3] = rr[u] * kpv[u] * r_k;
                    }
                    wave_sum_n<16>(red);
#pragma unroll
                    for (int u = 0; u < 4; ++u) {
                        const int tt = p * 4 + u;
                        const float inv = __builtin_amdgcn_rcpf(fmaxf(__builtin_amdgcn_sqrtf(red[4 * u]), 1e-12f));
                        const float kkn = kqv[u] * inv;
                        float* R = Rb + tt * REC;
                        R[lane] = -kkn; R[64 + lane] = dcy[u] * rr[u]; R[128 + lane] = dcy[u]; R[192 + lane] = kkn * av[u]; R[256 + lane] = kpv[u]; R[320 + lane] = vx[u]; R[384 + lane] = ggv[u];
                        if (lane == 0) { R[448] = red[4 * u + 1] * inv; R[449] = red[4 * u + 2]; R[450] = red[4 * u + 3]; }
                    }
                }
                LDS_BARRIER();
            }
#undef RW_GLOAD
            {
                const float* Rb = rec + ((NC - 1) & 1) * RT * REC;
                const float* ob = obuf + ((NC - 1) & 1) * RT * 64;
                float ov[4], sm[8];
#pragma unroll
                for (int u = 0; u < 4; ++u) { ov[u] = ob[(p * 4 + u) * 64 + lane]; sm[2 * u] = ov[u]; sm[2 * u + 1] = ov[u] * ov[u]; }
                wave_sum_n<8>(sm);
#pragma unroll
                for (int u = 0; u < 4; ++u) {
                    const int tt = p * 4 + u, t = (NC - 1) * RT + tt;
                    const float* R = Rb + tt * REC;
                    const float mean = sm[2 * u] * (1.0f / 64.0f), var = fmaxf(sm[2 * u + 1] * (1.0f / 64.0f) - mean * mean, 0.f);
                    float o = (ov[u] - mean) * __builtin_amdgcn_rsqf(var + GN_EPS) * gn_g + gn_b;
                    o += R[450] * R[320 + lane];
                    yc[(size_t)(b * SEQ + t) * DMIX + hj] = f2bf(o * R[384 + lane]);
                }
            }
        }
    }
    __syncthreads();
}

#define XB_TMO      128
#define XB_XCNT(j)  (256  + 64 * (j))
#define XB_XSUB(j)  (1280 + 64 * (j))
#define XB_XGEN(j)  (2304 + 64 * (j))
#define XB_TOP      3328
#define XB_TOPGEN   3392
#define XCD_BAR_WORDS 3456
#define XB_SPIN_CAP (1u << 18)
__device__ __forceinline__ unsigned xb_ld(unsigned* p)              { return __hip_atomic_load(p, __ATOMIC_RELAXED, __HIP_MEMORY_SCOPE_AGENT); }
__device__ __forceinline__ unsigned xb_add(unsigned* p, unsigned v) { return __hip_atomic_fetch_add(p, v, __ATOMIC_RELAXED, __HIP_MEMORY_SCOPE_AGENT); }
__device__ __forceinline__ unsigned xb_xcc_id() { return (unsigned)__builtin_amdgcn_s_getreg((3 << 11) | 20) & 0xFu; }
#define XB_SPIN(cond, bar) do { unsigned _sp = 0; while (cond) { __builtin_amdgcn_s_sleep(1); \
    if ((++_sp & 255u) == 0u) { if (xb_ld(&(bar)[XB_TMO])) break; if (_sp > XB_SPIN_CAP) { atomicAdd(&(bar)[XB_TMO], 1u); break; } } } } while (0)
struct XcdBarrier { unsigned* bar; unsigned x; volatile LAS unsigned* st; };
__device__ __forceinline__ XcdBarrier xcd_barrier_post(unsigned* bar, volatile LAS unsigned* st) {
    XcdBarrier b; b.bar = bar; b.x = xb_xcc_id(); b.st = st;
    if (threadIdx.x == 0) (void)xb_add(&bar[XB_XCNT(b.x)], 1u);
    return b;
}
__device__ __forceinline__ void xcd_barrier_complete(unsigned* bar, unsigned x, unsigned& nloc, unsigned& nx) {
    const unsigned G = gridDim.x;
    unsigned sum, cnt, mine, sp = 0u;
    for (;;) {
        sum = 0u; cnt = 0u; mine = 0u;
#pragma unroll
        for (unsigned j = 0; j < 16; ++j) { const unsigned c = xb_ld(&bar[XB_XCNT(j)]); sum += c; cnt += (c > 0u) ? 1u : 0u; mine = (j == x) ? c : mine; }
        if (sum == G) break;
        __builtin_amdgcn_s_sleep(1);
        if ((++sp & 255u) == 0u) { if (xb_ld(&bar[XB_TMO])) break; if (sp > XB_SPIN_CAP) { atomicAdd(&bar[XB_TMO], 1u); break; } }
    }
    nloc = mine > 0u ? mine : 1u; nx = cnt > 0u ? cnt : 1u;
}
__device__ __forceinline__ void xcd_barrier(const XcdBarrier& b, const int tid) {
    asm volatile("s_waitcnt vmcnt(0)" ::: "memory");
    __syncthreads();
    if (tid == 0) {
        unsigned* bar = b.bar;
        __builtin_amdgcn_s_waitcnt(0);
        unsigned nloc = b.st[0], nx = b.st[1];
        if (nloc == 0u) { xcd_barrier_complete(bar, b.x, nloc, nx); b.st[0] = nloc; b.st[1] = nx; }
        const unsigned old = xb_add(&bar[XB_XSUB(b.x)], 1u);
        const unsigned gen = old / nloc;
        if (old + 1u == (gen + 1u) * nloc) {
            __builtin_amdgcn_fence(__ATOMIC_RELEASE, "agent");
            asm volatile("s_waitcnt vmcnt(0)" ::: "memory");
            const unsigned og = xb_add(&bar[XB_TOP], 1u);
            const unsigned tg = og / nx;
            if (og + 1u == (tg + 1u) * nx) xb_add(&bar[XB_TOPGEN], 1u);
            else XB_SPIN(xb_ld(&bar[XB_TOPGEN]) == tg, bar);
            __builtin_amdgcn_fence(__ATOMIC_ACQUIRE, "agent");
            xb_add(&bar[XB_XGEN(b.x)], 1u);
            asm volatile("s_waitcnt vmcnt(0)" ::: "memory");
        } else {
            XB_SPIN(xb_ld(&bar[XB_XGEN(b.x)]) == gen, bar);
            __builtin_amdgcn_fence(__ATOMIC_ACQUIRE, "agent");
            asm volatile("s_waitcnt vmcnt(0)" ::: "memory");
        }
    }
    __syncthreads();
}

constexpr int NPH = 12;
__global__ void __launch_bounds__(512, 2) mega(Params P, int ph_lo, int ph_hi) {
    extern __shared__ __attribute__((aligned(16))) unsigned char shm[];
    LAS unsigned char* lds = (LAS unsigned char*)shm;
    cg::grid_group grid = cg::this_grid();
    const int swid = __builtin_amdgcn_readfirstlane((int)threadIdx.x >> 6);
    volatile LAS unsigned* xst = (volatile LAS unsigned*)(lds + 131072);
    if (threadIdx.x < 2) xst[threadIdx.x] = 0u;
    __syncthreads();
    const XcdBarrier xbar = xcd_barrier_post((unsigned*)(P.ws + WS_BAR), xst);
    unsigned char* ws = P.ws;
    bf16_t* xb = (bf16_t*)(ws + WS_XB);
    bf16_t* wt = (bf16_t*)(ws + WS_WT);
    bf16_t* pb = (bf16_t*)(ws + WS_PB);
    bf16_t* hbuf = (bf16_t*)(ws + WS_H);
    bf16_t* vt = (bf16_t*)(ws + WS_VT);
    bf16_t* pq = hbuf;
    bf16_t* ubuf = hbuf;
    bf16_t* plb = (bf16_t*)(ws + WS_H + 512 * MiB);
    bf16_t* ybase = (bf16_t*)P.out;
    bf16_t* mb = plb;
    for (int ph = ph_lo; ph < ph_hi; ++ph) {
        const int l = ph / NPH, k = ph % NPH;
        const int njobs = (k == 1 || k == 5 || k == 6 || k == 9 || k == 10) ? 1 : (k == 4 ? 4 : (k == 8 ? 2 : 0));
        for (int rep = 0; rep < ((k == REPK) ? REPN : 1); ++rep) {
        int bid_ = blockIdx.x, gdim_ = gridDim.x; asm volatile("" : "+s"(bid_)); asm volatile("" : "+s"(gdim_)); int z_ = 0; asm volatile("" : "+s"(z_));
        int tid_ = (swid << 6) + (int)__builtin_amdgcn_mbcnt_hi(~0u, __builtin_amdgcn_mbcnt_lo(~0u, (unsigned)z_)); asm volatile("" : "+v"(tid_));
        if (njobs) {
            for (int n = 0; n < njobs; ++n) {
                pg8::Epi E; E.mode = 0; E.act = 0; E.ob = nullptr; E.ldo = 0; E.bias = nullptr; E.io2 = nullptr; E.resf = nullptr; E.aux = nullptr;
                pg8::Gemm g; g.M = MTOK; g.A = xb; g.lda = D; g.K = D; g.Bt = wt; g.ldb = D; g.N = D;
                int merge = 0;
                if (k == 1) { E.ob = hbuf; E.ldo = INC; g.Bt = wt + WO_IN; g.N = INC; }
                else if (k == 4) { E.ob = pq + (size_t)n * D; E.ldo = 4 * D; g.A = ybase + (size_t)n * MTOK * DMIX; g.lda = DMIX; g.K = DMIX; g.Bt = wt + WO_B + (size_t)n * D * DMIX; g.ldb = DMIX; }
                else if (k == 5) { E.mode = 3; E.ob = pq; E.ldo = 4 * D; E.bias = P.in[25 + z_] + (size_t)l * 4 * D; E.io2 = mb; g.Bt = wt + WO_G; g.N = 4 * D; merge = 1; }
                else if (k == 6) { E.mode = 2; E.io2 = xb; if (l == 0) E.resf = P.in[0 + z_]; g.A = mb; g.Bt = wt + WO_OUT4; }
                else if (k == 8 && n == 0) { E.act = 1; E.ob = ubuf; E.ldo = DFF; g.Bt = wt + WO_FF1; g.N = DFF; }
                else if (k == 8) { E.ob = plb; E.ldo = D; g.A = pb; g.lda = DPLE; g.K = DPLE; g.Bt = wt + WO_PLE; g.ldb = DPLE; }
                else if (k == 9) { E.mode = 1; E.ob = plb; E.ldo = D; E.bias = P.in[33 + z_] + (size_t)l * D; g.Bt = wt + WO_PLEG; }
                else { E.mode = 2; E.io2 = xb; E.aux = plb; g.A = ubuf; g.lda = DFF; g.K = DFF; g.Bt = wt + WO_FF2; g.ldb = DFF; }
                pg8::StaticOrder S; S.init(g.M, g.N, gdim_, bid_, merge);
                pg8::gemm_phase(tid_, lds, g, S, E);
                __syncthreads();
            }
        } else if (k == 0) {
            float* tile = (float*)shm;
            tconv(tid_, bid_, gdim_, tile, P.in[2 + z_] + (size_t)l * D * INC, D, INC, wt + WO_IN, D);
            for (int n = 0; n < 4; ++n) tconv(tid_, bid_, gdim_, tile, P.in[24 + z_] + ((size_t)l * 4 + n) * D * D, D, D, wt + WO_G + (size_t)n * D * D, D);
            for (int n = 0; n < 4; ++n) tconv(tid_, bid_, gdim_, tile, P.in[23 + z_] + ((size_t)l * 4 + n) * DMIX * D, DMIX, D, wt + WO_B + (size_t)n * D * DMIX, DMIX);
            tconv(tid_, bid_, gdim_, tile, P.in[26 + z_] + (size_t)l * D * D, D, D, wt + WO_OUT4, D);
            tconv(tid_, bid_, gdim_, tile, P.in[29 + z_] + (size_t)l * D * DFF, D, DFF, wt + WO_FF1, D);
            tconv(tid_, bid_, gdim_, tile, P.in[30 + z_] + (size_t)l * DFF * D, DFF, D, wt + WO_FF2, DFF);
            tconv(tid_, bid_, gdim_, tile, P.in[31 + z_] + (size_t)l * DPLE * D, DPLE, D, wt + WO_PLE, DPLE);
            tconv(tid_, bid_, gdim_, tile, P.in[32 + z_] + (size_t)l * D * D, D, D, wt + WO_PLEG, D);
            econv(tid_, bid_, gdim_, P.in[1 + z_] + (size_t)l * MTOK * DPLE, pb, (size_t)MTOK * DPLE);
            if (l == 0) econv(tid_, bid_, gdim_, P.in[0 + z_], xb, (size_t)MTOK * D);
        } else if (k == 2) {
            for (int r2 = 0; r2 < REP_LRU; ++r2) { int t2_ = tid_, b2_ = bid_; asm volatile("" : "+v"(t2_)); asm volatile("" : "+s"(b2_));
            lru_phase(t2_, b2_, gdim_, shm, hbuf, P.in[3 + z_] + (size_t)l * 4 * DMIX, P.in[4 + z_] + (size_t)l * DMIX, P.in[5 + z_] + (size_t)l * 8 * 4096, P.in[6 + z_] + (size_t)l * DMIX,
                      P.in[7 + z_] + (size_t)l * 8 * 4096, P.in[8 + z_] + (size_t)l * DMIX, P.in[9 + z_] + (size_t)l * DMIX, ybase);
            }
            for (int r2 = 0; r2 < REP_RWKV; ++r2) { int t2_ = tid_, b2_ = bid_; asm volatile("" : "+v"(t2_)); asm volatile("" : "+s"(b2_));
            rwkv_phase(t2_, b2_, gdim_, shm, hbuf, P.in[11 + z_] + (size_t)l * 1792, P.in[12 + z_] + (size_t)l * DMIX, P.in[13 + z_] + (size_t)l * 64 * DMIX, P.in[14 + z_] + (size_t)l * DMIX,
                       P.in[15 + z_] + (size_t)l * 64 * DMIX, P.in[16 + z_] + (size_t)l * 128 * DMIX, P.in[17 + z_] + (size_t)l * DMIX, P.in[18 + z_] + (size_t)l * DMIX,
                       P.in[19 + z_] + (size_t)l * DMIX, P.in[20 + z_] + (size_t)l * DMIX, P.in[21 + z_] + (size_t)l * DMIX, ybase + (size_t)2 * MTOK * DMIX);
            }
            for (int r2 = 0; r2 < REP_SV; ++r2) { int t2_ = tid_, b2_ = bid_; asm volatile("" : "+v"(t2_)); asm volatile("" : "+s"(b2_));
            sconv_phase(t2_, b2_, gdim_, hbuf, P.in[10 + z_] + (size_t)l * 3 * DMIX, ybase + (size_t)1 * MTOK * DMIX);
            vtrans_phase(t2_, b2_, gdim_, (bf16_t*)shm, hbuf, vt);
            }
        } else if (k == 3) {
            attn_phase(tid_, bid_, gdim_, shm, hbuf, vt, P.in[22 + z_], ybase + (size_t)3 * MTOK * DMIX);
        } else if (k == 7) {
            ln_phase(tid_, bid_, gdim_, xb, P.in[27 + z_] + (size_t)l * D, P.in[28 + z_] + (size_t)l * D, nullptr);
        } else {
            ln_phase(tid_, bid_, gdim_, xb, P.in[34 + z_] + (size_t)l * D, P.in[35 + z_] + (size_t)l * D, l == DEPTH - 1 ? P.out : nullptr);
        }
        }
        if (ph + 1 < ph_hi) { if (ph == ph_lo) { asm volatile("s_waitcnt vmcnt(0) lgkmcnt(0)" ::: "memory"); grid.sync(); } else { int zb_ = 0; asm volatile("" : "+s"(zb_)); const int tb_ = (swid << 6) + (int)__builtin_amdgcn_mbcnt_hi(~0u, __builtin_amdgcn_mbcnt_lo(~0u, (unsigned)zb_)); xcd_barrier(xbar, tb_); } }
    }
}

extern "C" void kernel_launch(void* const* d_in, const int* in_sizes, int n_in, void* d_out, int out_size, void* d_ws, size_t ws_size, hipStream_t stream) {
    static int grid = 0;
    if (grid == 0) {
        int dev = 0, cus = 0, per_cu = 0;
        hipGetDevice(&dev);
        hipDeviceGetAttribute(&cus, hipDeviceAttributeMultiprocessorCount, dev);
        hipFuncSetAttribute((const void*)mega, hipFuncAttributeMaxDynamicSharedMemorySize, LDS_BYTES);
        hipOccupancyMaxActiveBlocksPerMultiprocessor(&per_cu, (const void*)mega, 512, LDS_BYTES);
        if (per_cu < 1) { fprintf(stderr, "kernel_launch: occupancy query says %d blocks/CU\n", per_cu); per_cu = 1; }
        (void)hipGetLastError();
        grid = cus * 1;
        if (n_in != 36 || ws_size < 1013 * MiB) fprintf(stderr, "kernel_launch: unexpected n_in %d / ws_size %zu\n", n_in, ws_size);
    }
    (void)hipMemsetAsync((char*)d_ws + WS_BAR, 0, XCD_BAR_WORDS * sizeof(unsigned), stream);
    Params p{};
    for (int i = 0; i < 36; ++i) p.in[i] = (const float*)d_in[i];
    p.out = (float*)d_out; p.ws = (unsigned char*)d_ws;
#if ONE_LAUNCH
    int lo = 0, hi = DEPTH * NPH;
    void* args[] = {&p, &lo, &hi};
    hipError_t e = hipLaunchCooperativeKernel((const void*)mega, dim3(grid), dim3(512), args, LDS_BYTES, stream);
    if (e != hipSuccess) fprintf(stderr, "cooperative launch failed: %s (grid %d)\n", hipGetErrorString(e), grid);
#else
    for (int ph = 0; ph < DEPTH * NPH; ++ph) hipLaunchKernelGGL(mega, dim3(grid), dim3(512), LDS_BYTES, stream, p, ph, ph + 1);
#endif
}
```

```cpp
#include <hip/hip_runtime.h>
#include <hip/hip_cooperative_groups.h>
#include <cstdio>
#include <cstdint>
namespace cg = cooperative_groups;

#ifndef REPK
#define REPK -1
#endif
#ifndef REPN
#define REPN 1
#endif
#ifndef REP_LRU
#define REP_LRU 1
#endif
#ifndef REP_RWKV
#define REP_RWKV 1
#endif
#ifndef REP_SV
#define REP_SV 1
#endif
#ifndef ONE_LAUNCH
#define ONE_LAUNCH 1
#endif

#define LAS __attribute__((address_space(3)))
typedef unsigned short bf16_t;
typedef short bf16x8 __attribute__((ext_vector_type(8)));
typedef short bf16x4 __attribute__((ext_vector_type(4)));
typedef float f32x4 __attribute__((ext_vector_type(4)));
typedef float f32x2 __attribute__((ext_vector_type(2)));
typedef unsigned u32x4 __attribute__((ext_vector_type(4)));
typedef unsigned u32x2 __attribute__((ext_vector_type(2)));

constexpr int D = 1024, BATCH = 32, SEQ = 2048, DEPTH = 2, MTOK = BATCH * SEQ;
constexpr int DMIX = 512, INC = 5888, DFF = 4096, DPLE = 256;
constexpr int COL_A = 0, COL_B = 1024, COL_C = 2560, COL_D = 4352;
constexpr float ALPHA = 1.4142135623730951f;
constexpr float LN_EPS = 1e-5f, GN_EPS = 64e-5f;

constexpr size_t MiB = 1ull << 20;
constexpr size_t WS_XB = 0, WS_WT = 128 * MiB, WS_PB = 180 * MiB, WS_H = 212 * MiB, WS_VT = 948 * MiB;
constexpr size_t WO_IN = 0, WO_G = 6029312, WO_B = WO_G + 4194304, WO_OUT4 = WO_B + 2097152, WO_FF1 = WO_OUT4 + 4194304,
                 WO_FF2 = WO_FF1 + 4194304, WO_PLE = WO_FF2 + 4194304, WO_PLEG = WO_PLE + 262144;
constexpr int LDS_BYTES = 131072 + 16 + 8256;
constexpr size_t WS_BAR = 1012 * MiB;

struct Params {
    const float* in[36];
    float* out;
    unsigned char* ws;
};

__device__ __forceinline__ float bf2f(unsigned v) { return __uint_as_float(v << 16); }
typedef __bf16 bf16x2_t __attribute__((ext_vector_type(2)));
__device__ __forceinline__ unsigned cvt_pk_bf16(float lo, float hi) { f32x2 v = {lo, hi}; bf16x2_t b = __builtin_convertvector(v, bf16x2_t); unsigned r; __builtin_memcpy(&r, &b, 4); return r; }
__device__ __forceinline__ bf16_t f2bf(float f) { return (bf16_t)(cvt_pk_bf16(f, 0.f) & 0xffffu); }
__device__ __forceinline__ float fexp(float x) { return __builtin_amdgcn_exp2f(x * 1.4426950408889634f); }
__device__ __forceinline__ float flog(float x) { return __builtin_amdgcn_logf(x) * 0.6931471805599453f; }
__device__ __forceinline__ float ftanh(float x) { return 1.0f - 2.0f * __builtin_amdgcn_rcpf(1.0f + fexp(2.0f * x)); }
__device__ __forceinline__ float flog1p_small(float x) { return flog(1.0f + x); }
__device__ __forceinline__ float fneg_expm1(float t) { return 1.0f - fexp(t); }
__device__ __forceinline__ float sigmoidf_(float x) { return __builtin_amdgcn_rcpf(1.0f + fexp(-x)); }
__device__ __forceinline__ float wave_sum(float v) {
    v += __int_as_float(__builtin_amdgcn_update_dpp(0, __float_as_int(v), 0xB1, 0xF, 0xF, true));
    v += __int_as_float(__builtin_amdgcn_update_dpp(0, __float_as_int(v), 0x4E, 0xF, 0xF, true));
    v += __int_as_float(__builtin_amdgcn_update_dpp(0, __float_as_int(v), 0x141, 0xF, 0xF, true));
    v += __int_as_float(__builtin_amdgcn_update_dpp(0, __float_as_int(v), 0x140, 0xF, 0xF, true));
    const float s0 = __int_as_float(__builtin_amdgcn_readlane(__float_as_int(v), 0)), s1 = __int_as_float(__builtin_amdgcn_readlane(__float_as_int(v), 16));
    const float s2 = __int_as_float(__builtin_amdgcn_readlane(__float_as_int(v), 32)), s3 = __int_as_float(__builtin_amdgcn_readlane(__float_as_int(v), 48));
    return (s0 + s1) + (s2 + s3);
}
template <int N> __device__ __forceinline__ void wave_sum_n(float (&v)[N]) {
#pragma unroll
    for (int i = 0; i < N; ++i) v[i] += __int_as_float(__builtin_amdgcn_update_dpp(0, __float_as_int(v[i]), 0xB1, 0xF, 0xF, true));
#pragma unroll
    for (int i = 0; i < N; ++i) v[i] += __int_as_float(__builtin_amdgcn_update_dpp(0, __float_as_int(v[i]), 0x4E, 0xF, 0xF, true));
#pragma unroll
    for (int i = 0; i < N; ++i) v[i] += __int_as_float(__builtin_amdgcn_update_dpp(0, __float_as_int(v[i]), 0x141, 0xF, 0xF, true));
#pragma unroll
    for (int i = 0; i < N; ++i) v[i] += __int_as_float(__builtin_amdgcn_update_dpp(0, __float_as_int(v[i]), 0x140, 0xF, 0xF, true));
#pragma unroll
    for (int i = 0; i < N; ++i) v[i] += __int_as_float(__builtin_amdgcn_update_dpp(0, __float_as_int(v[i]), 0x142, 0xA, 0xF, false));
#pragma unroll
    for (int i = 0; i < N; ++i) v[i] += __int_as_float(__builtin_amdgcn_update_dpp(0, __float_as_int(v[i]), 0x143, 0xC, 0xF, false));
#pragma unroll
    for (int i = 0; i < N; ++i) v[i] = __int_as_float(__builtin_amdgcn_readlane(__float_as_int(v[i]), 63));
}
__device__ __forceinline__ float shflx(float v, int lane, int m) { return __int_as_float(__builtin_amdgcn_ds_bpermute((lane ^ m) << 2, __float_as_int(v))); }
__device__ __forceinline__ void unpack8(u32x4 u, float* f) {
#pragma unroll
    for (int i = 0; i < 4; ++i) { f[2 * i] = __uint_as_float(u[i] << 16); f[2 * i + 1] = __uint_as_float(u[i] & 0xffff0000u); }
}
__device__ __forceinline__ u32x4 pack8(const float* f) {
    u32x4 u;
#pragma unroll
    for (int i = 0; i < 4; ++i) u[i] = cvt_pk_bf16(f[2 * i], f[2 * i + 1]);
    return u;
}

namespace pg8 {
constexpr int BM = 256, BK = 64, HALF = 128, HTB = HALF * BK * 2, STAGE_BYTES = 8 * HTB, NXCD = 8, WGM = 8;
__host__ __device__ __forceinline__ int lds_byte(int r, int c) { const int st = (r >> 4) * 2 + (c >> 5), rr = r & 15, cc = c & 31, ob = rr * 64 + cc * 2; return st * 1024 + (ob ^ (((ob >> 9) & 1) << 5)); }
__host__ __device__ __forceinline__ void stage_rc(int b, int& R, int& C) { const int st = b / 1024, sb = b % 1024, swz = sb ^ (((sb >> 9) & 1) << 5); R = (st >> 1) * 16 + swz / 64; C = (st & 1) * 32 + (swz % 64) / 2; }
__host__ __device__ __forceinline__ int perm32(int rho) { const int n = rho >> 4, i = rho & 15; return 8 * (i >> 2) + 4 * n + (i & 3); }
struct Unit { int pm, pn; };
struct Gemm { const bf16_t* A; const bf16_t* Bt; int M, N, K, lda, ldb; };
struct StaticOrder {
    int nM, nN, nwg, G, c, merge;
    __device__ void init(int M, int N, int G_, int c_, int merge_) { merge = merge_; nM = M / BM; nN = (merge_ ? N / 4 : N) / BM; nwg = nM * nN; G = G_; c = c_; }
    __device__ bool next(int i, Unit& u) const {
        int n = 0; if (merge) { n = i & 3; i >>= 2; }
        const long L = (long)i * G + c; if (L >= nwg) return false;
        int wgid = (int)L; { const int q = nwg / NXCD, r = nwg % NXCD, xcd = wgid % NXCD, off = wgid / NXCD; wgid = (xcd < r ? xcd * (q + 1) : r * (q + 1) + (xcd - r) * q) + off; }
        const int nig = WGM * nN, gid = wgid / nig, fm = gid * WGM, gsz = (nM - fm) < WGM ? (nM - fm) : WGM;
        u.pm = fm + ((wgid % nig) % gsz); u.pn = (wgid % nig) / gsz + n * nN; return true;
    }
};

struct Epi {
    int mode;
    int act;
    bf16_t* ob; int ldo;
    const float* bias;
    bf16_t* io2;
    const float* resf;
    const bf16_t* aux;
    __device__ __forceinline__ void operator()(const f32x4 (&acc)[2][2][4][2], const Unit& u, int wr, int wc, int fr, int fq, LAS unsigned char* dump) const {
        int row0 = u.pm * BM + wr * 64 + fr, col0 = u.pn * BM + wc * 32 + 8 * fq;
        asm volatile("" : "+v"(row0), "+v"(col0));
        float bv[2][8];
        if (mode == 1 || mode == 3) {
#pragma unroll
            for (int bj = 0; bj < 2; ++bj) { const f32x4 b0 = *(const f32x4*)(bias + col0 + bj * HALF), b1 = *(const f32x4*)(bias + col0 + bj * HALF + 4);
#pragma unroll
                for (int j = 0; j < 4; ++j) { bv[bj][j] = b0[j]; bv[bj][4 + j] = b1[j]; } }
        }
        if (mode != 0) {
#pragma unroll
            for (int ai = 0; ai < 2; ++ai)
#pragma unroll
                for (int m = 0; m < 4; ++m)
#pragma unroll
                    for (int bj = 0; bj < 2; ++bj) {
                        const size_t row = (size_t)(row0 + ai * HALF + m * 16); const int col = col0 + bj * HALF;
                        const void* p0 = (mode == 2) ? (resf ? (const void*)(resf + row * D + col) : (const void*)(io2 + row * D + col)) : (const void*)(ob + row * ldo + col);
                        __builtin_amdgcn_global_load_lds((const unsigned*)p0, (LAS unsigned*)dump, 16, 0, 0);
                        if (mode == 2 && aux) __builtin_amdgcn_global_load_lds((const unsigned*)(aux + row * D + col), (LAS unsigned*)dump, 16, 0, 0);
                    }
        }
#pragma unroll
        for (int aim = 0; aim < 4; ++aim) {
            const int ai = aim >> 1, mh = aim & 1;
            u32x4 L0[4], L1[4];
            if (mode != 0) {
#pragma unroll
                for (int m2 = 0; m2 < 2; ++m2)
#pragma unroll
                    for (int bj = 0; bj < 2; ++bj) {
                        const int m = mh * 2 + m2;
                        const size_t row = (size_t)(row0 + ai * HALF + m * 16); const int col = col0 + bj * HALF, e = m2 * 2 + bj;
                        if (mode == 1) L0[e] = *(const u32x4*)(ob + row * ldo + col);
                        else if (mode == 3) { L0[e] = *(const u32x4*)(ob + row * ldo + col);
                            if (col >= D) L1[e] = *(const u32x4*)(io2 + row * D + (col & (D - 1))); }
                        else { if (resf) { L0[e] = *(const u32x4*)(resf + row * D + col); L1[e] = *(const u32x4*)(resf + row * D + col + 4); }
                               else { L0[e] = *(const u32x4*)(io2 + row * D + col); if (aux) L1[e] = *(const u32x4*)(aux + row * D + col); } }
                    }
            }
#pragma unroll
            for (int m2 = 0; m2 < 2; ++m2)
#pragma unroll
                for (int bj = 0; bj < 2; ++bj) {
                    const int m = mh * 2 + m2;
                    const size_t row = (size_t)(row0 + ai * HALF + m * 16); const int col = col0 + bj * HALF, e = m2 * 2 + bj;
                    float v[8];
#pragma unroll
                    for (int j = 0; j < 4; ++j) { v[j] = acc[ai][bj][m][0][j]; v[4 + j] = acc[ai][bj][m][1][j]; }
                    if (mode == 0) {
                        if (act == 1) {
#pragma unroll
                            for (int j = 0; j < 8; ++j) { const float t = fmaxf(v[j], 0.f); v[j] = t * t; }
                        }
                        *(u32x4*)(ob + row * ldo + col) = pack8(v);
                    } else if (mode == 1) {
                        float a[8]; unpack8(L0[e], a);
#pragma unroll
                        for (int j = 0; j < 8; ++j) v[j] = sigmoidf_(v[j] + bv[bj][j]) * a[j];
                        *(u32x4*)(ob + row * ldo + col) = pack8(v);
                    } else if (mode == 3) {
                        float a[8]; unpack8(L0[e], a);
#pragma unroll
                        for (int j = 0; j < 8; ++j) v[j] = sigmoidf_(v[j] + bv[bj][j]) * a[j];
                        if (col >= D) { float q[8]; unpack8(L1[e], q);
#pragma unroll
                            for (int j = 0; j < 8; ++j) v[j] += q[j]; }
                        *(u32x4*)(io2 + row * D + (col & (D - 1))) = pack8(v);
                    } else {
                        float r[8];
                        if (resf) {
#pragma unroll
                            for (int j = 0; j < 4; ++j) { r[j] = __uint_as_float(L0[e][j]); r[4 + j] = __uint_as_float(L1[e][j]); } }
                        else unpack8(L0[e], r);
#pragma unroll
                        for (int j = 0; j < 8; ++j) v[j] += ALPHA * r[j];
                        if (aux) { float a[8]; unpack8(L1[e], a);
#pragma unroll
                            for (int j = 0; j < 8; ++j) v[j] += a[j]; }
                        *(u32x4*)(io2 + row * D + col) = pack8(v);
                    }
                }
        }
    }
};

__device__ __forceinline__ void gemm_phase(const int tid, LAS unsigned char* lds, const Gemm g, const StaticOrder& S, const Epi& E) {
    const int wid = __builtin_amdgcn_readfirstlane(tid >> 6), lane = tid & 63, wr = wid >> 2, wc = wid & 3, fr = lane & 15, fq = lane >> 4;
    const int K = g.K, nt = K / BK;
    unsigned voffA, voffB;
    { int R, C; stage_rc(tid * 16, R, C); const int Rb = (R & ~31) + perm32(R & 31); voffA = (unsigned)(R * g.lda + C) * 2u; voffB = (unsigned)(Rb * g.ldb + C) * 2u; }
    const size_t p2A = (size_t)64 * g.lda * 2, p2B = (size_t)64 * g.ldb * 2;
    const size_t kstep = (size_t)(BK * 2);
    const size_t hstepA = (size_t)HALF * g.lda * 2, hstepB = (size_t)HALF * g.ldb * 2;
    const size_t tstepA = 2 * hstepA, tstepB = 2 * hstepB;
    const unsigned ldsw = (unsigned)wid * 1024u;
    const int aoff = lds_byte(wr * 64 + fr, fq * 8), boff = lds_byte(wc * 32 + fr, fq * 8);
#define XA voffA
#define XB voffB
#define p2XA p2A
#define p2XB p2B
#define PG8_SA(b, h) (((b) * 2 + (h)) * HTB)
#define PG8_SB(b, h) ((4 + (b) * 2 + (h)) * HTB)
#define PG8_STAGE(bufoff, gbase, voff) do { \
        __builtin_amdgcn_global_load_lds((const unsigned*)((const char*)(gbase) + (voff)), (LAS unsigned*)(lds + (bufoff) + ldsw), 16, 0, 0); \
        __builtin_amdgcn_global_load_lds((const unsigned*)((const char*)(gbase) + p2##voff + (voff)), (LAS unsigned*)(lds + (bufoff) + ldsw + 8192), 16, 0, 0); } while (0)
#define PG8_LDA(dst, b, h) do { _Pragma("unroll") for (int m = 0; m < 4; ++m) _Pragma("unroll") for (int k = 0; k < 2; ++k) dst[m][k] = *(const LAS bf16x8*)(lds + PG8_SA(b, h) + aoff + m * 2048 + k * 1024); } while (0)
#define PG8_LDB(dst, b, h) do { _Pragma("unroll") for (int n = 0; n < 2; ++n) _Pragma("unroll") for (int k = 0; k < 2; ++k) dst[n][k] = *(const LAS bf16x8*)(lds + PG8_SB(b, h) + boff + n * 2048 + k * 1024); } while (0)
#define PG8_MMA(ai, bj, At, Bt) do { __builtin_amdgcn_s_setprio(1); _Pragma("unroll") for (int m = 0; m < 4; ++m) _Pragma("unroll") for (int n = 0; n < 2; ++n) _Pragma("unroll") for (int k = 0; k < 2; ++k) \
        acc[ai][bj][m][n] = __builtin_amdgcn_mfma_f32_16x16x32_bf16(Bt[n][k], At[m][k], acc[ai][bj][m][n], 0, 0, 0); __builtin_amdgcn_s_setprio(0); } while (0)
#define PG8_WAIT_V(n) asm volatile("s_waitcnt vmcnt(" #n ")" ::: "memory")
#define PG8_WAIT_L(n) asm volatile("s_waitcnt lgkmcnt(" #n ")" ::: "memory")
#define PG8_BAR __builtin_amdgcn_s_barrier()
#define PG8_SCHED __builtin_amdgcn_sched_barrier(0)
    Unit cur, nxt; int ui = 0;
    if (!S.next(0, cur)) return;
    f32x4 acc[2][2][4][2];
    bf16x8 At[4][2], B0[2][2], B1[2][2];
    const char* cA = (const char*)g.A + (size_t)cur.pm * tstepA; const char* cB = (const char*)g.Bt + (size_t)cur.pn * tstepB;
    PG8_STAGE(PG8_SB(0, 0), cB, XB); PG8_STAGE(PG8_SB(0, 1), cB + hstepB, XB); PG8_STAGE(PG8_SA(0, 0), cA, XA); PG8_STAGE(PG8_SA(0, 1), cA + hstepA, XA);
    if (wr == 1) PG8_BAR;
    PG8_WAIT_V(2); PG8_BAR;
    PG8_STAGE(PG8_SB(1, 0), cB + kstep, XB); PG8_STAGE(PG8_SA(1, 0), cA + kstep, XA); PG8_STAGE(PG8_SB(1, 1), cB + hstepB + kstep, XB);
    PG8_WAIT_V(6); PG8_BAR;
    PG8_SCHED;
#pragma unroll
    for (int a = 0; a < 2; ++a)
#pragma unroll
        for (int b = 0; b < 2; ++b)
#pragma unroll
            for (int m = 0; m < 4; ++m)
#pragma unroll
                for (int n = 0; n < 2; ++n) acc[a][b][m][n] = (f32x4){0.f, 0.f, 0.f, 0.f};
    for (;;) {
        const bool has_next = S.next(ui + 1, nxt);
        const char* nA = has_next ? (const char*)g.A + (size_t)nxt.pm * tstepA : cA; const char* nB = has_next ? (const char*)g.Bt + (size_t)nxt.pn * tstepB : cB;
        for (int t = 0; t < nt; t += 2) {
            const bool last = (t == nt - 2);
            const char* a1 = cA + (size_t)(t + 1) * kstep;
            const char* a2 = last ? nA : cA + (size_t)(t + 2) * kstep; const char* b2 = last ? nB : cB + (size_t)(t + 2) * kstep;
            const char* a3 = a2 + kstep; const char* b3 = b2 + kstep;
            PG8_LDB(B0, 0, 0); PG8_LDB(B1, 0, 1); PG8_SCHED; PG8_LDA(At, 0, 0); PG8_STAGE(PG8_SA(1, 1), a1 + hstepA, XA);
            PG8_WAIT_V(8); PG8_WAIT_L(0); PG8_BAR; PG8_MMA(0, 0, At, B0); PG8_MMA(0, 1, At, B1); PG8_BAR; PG8_SCHED;
            PG8_LDA(At, 0, 1); PG8_STAGE(PG8_SB(0, 0), b2, XB); PG8_STAGE(PG8_SB(0, 1), b2 + hstepB, XB); PG8_STAGE(PG8_SA(0, 0), a2, XA);
            PG8_WAIT_V(8); PG8_WAIT_L(0); PG8_BAR; PG8_MMA(1, 0, At, B0); PG8_MMA(1, 1, At, B1); PG8_BAR; PG8_SCHED;
            PG8_LDB(B0, 1, 0); PG8_LDB(B1, 1, 1); PG8_SCHED; PG8_LDA(At, 1, 0); PG8_STAGE(PG8_SA(0, 1), a2 + hstepA, XA);
            PG8_WAIT_V(8); PG8_WAIT_L(0); PG8_BAR; PG8_MMA(0, 0, At, B0); PG8_MMA(0, 1, At, B1); PG8_BAR; PG8_SCHED;
            PG8_LDA(At, 1, 1); PG8_STAGE(PG8_SB(1, 0), b3, XB); PG8_STAGE(PG8_SB(1, 1), b3 + hstepB, XB); PG8_STAGE(PG8_SA(1, 0), a3, XA);
            PG8_WAIT_V(8); PG8_WAIT_L(0); PG8_BAR; PG8_MMA(1, 0, At, B0); PG8_MMA(1, 1, At, B1); PG8_BAR; PG8_SCHED;
        }
        if (wr == 0) PG8_BAR;
        E(acc, cur, wr, wc, fr, fq, lds + 131088 + ldsw);
        if (!has_next) break;
#pragma unroll
        for (int a = 0; a < 2; ++a)
#pragma unroll
            for (int b = 0; b < 2; ++b)
#pragma unroll
                for (int m = 0; m < 4; ++m)
#pragma unroll
                    for (int n = 0; n < 2; ++n) acc[a][b][m][n] = (f32x4){0.f, 0.f, 0.f, 0.f};
        cur = nxt; cA = nA; cB = nB; ++ui;
        if (wr == 1) PG8_BAR;
    }
    PG8_WAIT_V(0);
    PG8_BAR;
#undef PG8_SA
#undef PG8_SB
#undef PG8_STAGE
#undef PG8_LDA
#undef PG8_LDB
#undef PG8_MMA
#undef PG8_WAIT_V
#undef PG8_WAIT_L
#undef PG8_BAR
#undef PG8_SCHED
}
}

#define LDS_BARRIER() do { asm volatile("s_waitcnt lgkmcnt(0)" ::: "memory"); __builtin_amdgcn_s_barrier(); asm volatile("" ::: "memory"); } while (0)

__device__ __forceinline__ void tconv(const int tid_, const int bid_, const int gdim_, float* tile, const float* __restrict__ src, int K, int N, bf16_t* __restrict__ dst, int ldd) {
    const int tn = N / 64, nt = (K / 64) * tn;
    const int r = tid_ >> 3, c = (tid_ & 7) * 8;
    int t = bid_;
    f32x4 a, b;
    if (t < nt) { const f32x4* s = (const f32x4*)(src + (size_t)((t / tn) * 64 + r) * N + (t % tn) * 64 + c); a = s[0]; b = s[1]; }
    for (; t < nt; t += gdim_) {
        const int k0 = (t / tn) * 64, n0 = (t % tn) * 64;
#pragma unroll
        for (int j = 0; j < 4; ++j) { tile[r * 65 + c + j] = a[j]; tile[r * 65 + c + 4 + j] = b[j]; }
        const int t2 = t + gdim_;
        if (t2 < nt) { const f32x4* s = (const f32x4*)(src + (size_t)((t2 / tn) * 64 + r) * N + (t2 % tn) * 64 + c); a = s[0]; b = s[1]; }
        LDS_BARRIER();
        float v[8];
#pragma unroll
        for (int j = 0; j < 8; ++j) v[j] = tile[(c + j) * 65 + r];
        *(u32x4*)(dst + (size_t)(n0 + r) * ldd + k0 + c) = pack8(v);
        LDS_BARRIER();
    }
}
__device__ __forceinline__ void econv(const int tid_, const int bid_, const int gdim_, const float* __restrict__ src, bf16_t* __restrict__ dst, size_t n) {
    const size_t nth = (size_t)gdim_ * 512;
    for (size_t i = ((size_t)bid_ * 512 + tid_) * 8; i < n; i += nth * 8) {
        const f32x4 a = *(const f32x4*)(src + i), b = *(const f32x4*)(src + i + 4);
        float v[8] = {a[0], a[1], a[2], a[3], b[0], b[1], b[2], b[3]};
        *(u32x4*)(dst + i) = pack8(v);
    }
}

__device__ __forceinline__ void ln_phase(const int tid_, const int bid_, const int gdim_, bf16_t* xio, const float* __restrict__ g, const float* __restrict__ b, float* outf) {
    const int lane = tid_ & 63, wid = tid_ >> 6;
    const int nw = gdim_ * 8;
    float gg[16], bb[16];
#pragma unroll
    for (int i = 0; i < 2; ++i)
#pragma unroll
        for (int j = 0; j < 8; ++j) { gg[i * 8 + j] = g[i * 512 + lane * 8 + j]; bb[i * 8 + j] = b[i * 512 + lane * 8 + j]; }
    for (int row = bid_ * 8 + wid; row < MTOK; row += nw) {
        bf16_t* p = xio + (size_t)row * D + lane * 8;
        float v[16]; unpack8(*(const u32x4*)p, v); unpack8(*(const u32x4*)(p + 512), v + 8);
        float s = 0.f;
#pragma unroll
        for (int j = 0; j < 16; ++j) s += v[j];
        const float mean = wave_sum(s) * (1.0f / D);
        float q = 0.f;
#pragma unroll
        for (int j = 0; j < 16; ++j) { const float d = v[j] - mean; q += d * d; }
        const float rstd = __builtin_amdgcn_rsqf(wave_sum(q) * (1.0f / D) + LN_EPS);
#pragma unroll
        for (int j = 0; j < 16; ++j) v[j] = (v[j] - mean) * rstd * gg[j] + bb[j];
        if (!outf) { *(u32x4*)p = pack8(v); *(u32x4*)(p + 512) = pack8(v + 8); }
        else { float* o = outf + (size_t)row * D + lane * 8;
            *(f32x4*)o = (f32x4){v[0], v[1], v[2], v[3]}; *(f32x4*)(o + 4) = (f32x4){v[4], v[5], v[6], v[7]};
            *(f32x4*)(o + 512) = (f32x4){v[8], v[9], v[10], v[11]}; *(f32x4*)(o + 516) = (f32x4){v[12], v[13], v[14], v[15]}; }
    }
}

__device__ __forceinline__ void sconv_phase(const int tid_, const int bid_, const int gdim_, const bf16_t* __restrict__ h, const float* __restrict__ w  , bf16_t* __restrict__ yb) {
    const size_t nth = (size_t)gdim_ * 512;
    for (size_t idx = (size_t)bid_ * 512 + tid_; idx < (size_t)MTOK * 64; idx += nth) {
        const int tok = (int)(idx >> 6), c8 = (int)(idx & 63) * 8, t = tok & (SEQ - 1);
        float acc[8];
#pragma unroll
        for (int j = 0; j < 8; ++j) acc[j] = 0.f;
#pragma unroll
        for (int k = 0; k < 3; ++k) {
            const int tt = t - 2 + k;
            if (tt >= 0) {
                const bf16_t* row = h + (size_t)(tok - 2 + k) * INC + COL_B;
                float cgv[8], xh[8]; unpack8(*(const u32x4*)(row + 512 + c8), cgv); unpack8(*(const u32x4*)(row + 1024 + c8), xh);
                const f32x4 w0 = *(const f32x4*)(w + k * 512 + c8), w1 = *(const f32x4*)(w + k * 512 + c8 + 4);
#pragma unroll
                for (int j = 0; j < 4; ++j) { acc[j] += w0[j] * (cgv[j] * xh[j]); acc[4 + j] += w1[j] * (cgv[4 + j] * xh[4 + j]); }
            }
        }
        float bg[8]; unpack8(*(const u32x4*)(h + (size_t)tok * INC + COL_B + c8), bg);
#pragma unroll
        for (int j = 0; j < 8; ++j) acc[j] *= bg[j];
        *(u32x4*)(yb + (size_t)tok * DMIX + c8) = pack8(acc);
    }
}

__device__ __forceinline__ void vtrans_phase(const int tid_, const int bid_, const int gdim_, bf16_t* tile  , const bf16_t* __restrict__ h, bf16_t* __restrict__ vt) {
    const int r = tid_ >> 3, c = (tid_ & 7) * 8;
    int it = bid_;
    u32x4 u;
    if (it < BATCH * 8 * 32) { const int bh = it >> 5, tc = it & 31; u = *(const u32x4*)(h + (size_t)((bh >> 3) * SEQ + tc * 64 + r) * INC + COL_D + 1024 + (bh & 7) * 64 + c); }
    for (; it < BATCH * 8 * 32; it += gdim_) {
        const int bh = it >> 5, tc = it & 31;
#pragma unroll
        for (int j = 0; j < 4; ++j) { tile[(c + 2 * j) * 72 + r] = (bf16_t)(u[j] & 0xffffu); tile[(c + 2 * j + 1) * 72 + r] = (bf16_t)(u[j] >> 16); }
        const int i2 = it + gdim_;
        if (i2 < BATCH * 8 * 32) { const int bh2 = i2 >> 5, tc2 = i2 & 31; u = *(const u32x4*)(h + (size_t)((bh2 >> 3) * SEQ + tc2 * 64 + r) * INC + COL_D + 1024 + (bh2 & 7) * 64 + c); }
        LDS_BARRIER();
        *(u32x4*)(vt + (size_t)(bh * 64 + r) * SEQ + tc * 64 + c) = *(const u32x4*)(tile + r * 72 + c);
        LDS_BARRIER();
    }
}

__device__ __forceinline__ void attn_phase(const int tid_, const int bid_, const int gdim_, unsigned char* ldsb, const bf16_t* __restrict__ h, const bf16_t* __restrict__ vt, const float* __restrict__ rel_bias, bf16_t* __restrict__ yd) {
    constexpr float L2E = 1.4426950408889634f;
    float* rb = (float*)(ldsb + 131088);
    for (int i = tid_; i < 8 * 257; i += 512) rb[i] = rel_bias[i] * L2E;
    __syncthreads();
    const int lane = tid_ & 63, wid = __builtin_amdgcn_readfirstlane(tid_ >> 6), lr = lane & 15, quad = lane >> 4;
    const int nw = gdim_ * 8;
    unsigned char* wl = ldsb + wid * 16384;
    const int krow = lane >> 3, kchunk = (lane & 7) ^ (krow & 7);
    const int vrow = lane >> 2, vchunk = (lane & 3) ^ ((vrow >> 2) & 3);
    int koff[2][2], voff[4];
#pragma unroll
    for (int tt = 0; tt < 2; ++tt)
#pragma unroll
        for (int dh = 0; dh < 2; ++dh) { const int row = (lr >> 2) * 8 + tt * 4 + (lr & 3); koff[tt][dh] = row * 128 + (((dh * 4 + quad) ^ (row & 7)) * 16); }
#pragma unroll
    for (int dt = 0; dt < 4; ++dt) { const int d = dt * 16 + lr; voff[dt] = 4096 + d * 64 + ((quad ^ ((d >> 2) & 3)) * 16); }
    int it = 0;
    for (int item0 = bid_ * 8 + wid; item0 < BATCH * 8 * 32; item0 += nw, ++it) {
        const int c = ((item0 & 31) + 8 * it) & 31, hh = (item0 >> 5) & 7, b = item0 >> 8;
        const int q0 = c * 64;
        const bf16_t* hb = h + (size_t)b * SEQ * INC + COL_D + hh * 64;
        bf16x8 qf[4][2];
        asm volatile("s_waitcnt lgkmcnt(0)" ::: "memory");
        {
            const bf16_t* qg = hb + (size_t)(q0 + krow) * INC + kchunk * 8;
#pragma unroll
            for (int i = 0; i < 8; ++i) __builtin_amdgcn_global_load_lds((const unsigned*)(qg + (size_t)i * 8 * INC), (LAS unsigned*)(wl + 8192 + i * 1024), 16, 0, 0);
        }
        const bf16_t* vb = vt + (size_t)((b * 8 + hh) * 64) * SEQ;
        const float* rbh = rb + hh * 257;
        const float cb2 = rbh[256];
        f32x4 oacc[4][4];
#pragma unroll
        for (int qi = 0; qi < 4; ++qi)
#pragma unroll
            for (int dt = 0; dt < 4; ++dt) oacc[qi][dt] = (f32x4){0.f, 0.f, 0.f, 0.f};
        float mrun[4] = {-1e30f, -1e30f, -1e30f, -1e30f}, lsum[4] = {0.f, 0.f, 0.f, 0.f};
        const int kstart = (c > 8 ? c - 8 : 0) * 64, kend = c * 64 + 64;
        const bf16_t* kg = hb + 512 + (size_t)krow * INC + kchunk * 8;
        const bf16_t* vg = vb + (size_t)vrow * SEQ + vchunk * 8;
#define AT_LOAD(buf, kt) do { _Pragma("unroll") for (int i = 0; i < 4; ++i) \
                __builtin_amdgcn_global_load_lds((const unsigned*)(kg + (size_t)((kt) + i * 8) * INC), (LAS unsigned*)(wl + (buf) * 8192 + i * 1024), 16, 0, 0); \
            _Pragma("unroll") for (int i = 0; i < 4; ++i) \
                __builtin_amdgcn_global_load_lds((const unsigned*)(vg + (size_t)i * 16 * SEQ + (kt)), (LAS unsigned*)(wl + (buf) * 8192 + 4096 + i * 1024), 16, 0, 0); } while (0)
#define AT_COMPUTE(buf, kt) do { \
            const bool far_ = ((kt) + 31 + 128 <= q0); \
            const unsigned char* bb_ = wl + (buf) * 8192; \
            bf16x8 kf[2][2], vf[4]; \
            _Pragma("unroll") for (int tt = 0; tt < 2; ++tt) _Pragma("unroll") for (int dh = 0; dh < 2; ++dh) kf[tt][dh] = *(const bf16x8*)(bb_ + koff[tt][dh]); \
            _Pragma("unroll") for (int dt = 0; dt < 4; ++dt) vf[dt] = *(const bf16x8*)(bb_ + voff[dt]); \
            _Pragma("unroll") for (int qi = 0; qi < 4; ++qi) { \
                f32x4 s[2]; \
                _Pragma("unroll") for (int tt = 0; tt < 2; ++tt) { f32x4 a = (f32x4){0.f, 0.f, 0.f, 0.f}; \
                    a = __builtin_amdgcn_mfma_f32_16x16x32_bf16(kf[tt][0], qf[qi][0], a, 0, 0, 0); \
                    a = __builtin_amdgcn_mfma_f32_16x16x32_bf16(kf[tt][1], qf[qi][1], a, 0, 0, 0); s[tt] = a; } \
                float mx = -1e30f; \
                if (far_) { _Pragma("unroll") for (int tt = 0; tt < 2; ++tt) _Pragma("unroll") for (int j = 0; j < 4; ++j) { const float v = s[tt][j] * (0.125f * L2E) + cb2; s[tt][j] = v; mx = fmaxf(mx, v); } } \
                else { const int qpos = q0 + qi * 16 + lr; float bz[8]; \
                    _Pragma("unroll") for (int tt = 0; tt < 2; ++tt) _Pragma("unroll") for (int j = 0; j < 4; ++j) { \
                        int rel = qpos - ((kt) + quad * 8 + tt * 4 + j); rel = rel > 128 ? 128 : (rel < -128 ? -128 : rel); bz[tt * 4 + j] = rbh[rel + 128]; } \
                    _Pragma("unroll") for (int tt = 0; tt < 2; ++tt) _Pragma("unroll") for (int j = 0; j < 4; ++j) { \
                        const float v = s[tt][j] * (0.125f * L2E) + bz[tt * 4 + j]; s[tt][j] = v; mx = fmaxf(mx, v); } } \
                mx = fmaxf(mx, shflx(mx, lane, 16)); mx = fmaxf(mx, shflx(mx, lane, 32)); \
                const float mnew = fmaxf(mrun[qi], mx), sc = __builtin_amdgcn_exp2f(mrun[qi] - mnew); \
                mrun[qi] = mnew; \
                float ps = 0.f; float pv[8]; \
                _Pragma("unroll") for (int tt = 0; tt < 2; ++tt) _Pragma("unroll") for (int j = 0; j < 4; ++j) { const float p = __builtin_amdgcn_exp2f(s[tt][j] - mnew); pv[tt * 4 + j] = p; ps += p; } \
                lsum[qi] = lsum[qi] * sc + ps; \
                const u32x4 pu = pack8(pv); bf16x8 pf; __builtin_memcpy(&pf, &pu, 16); \
                _Pragma("unroll") for (int dt = 0; dt < 4; ++dt) { \
                    f32x4 o = oacc[qi][dt]; \
                    _Pragma("unroll") for (int j = 0; j < 4; ++j) o[j] *= sc; \
                    oacc[qi][dt] = __builtin_amdgcn_mfma_f32_16x16x32_bf16(vf[dt], pf, o, 0, 0, 0); } \
            } } while (0)
        AT_LOAD(0, kstart);
        asm volatile("s_waitcnt vmcnt(8)" ::: "memory");
#pragma unroll
        for (int qi = 0; qi < 4; ++qi)
#pragma unroll
            for (int dh = 0; dh < 2; ++dh) { const int row = qi * 16 + lr; qf[qi][dh] = *(const bf16x8*)(wl + 8192 + row * 128 + (((dh * 4 + quad) ^ (row & 7)) * 16)); }
        asm volatile("s_waitcnt lgkmcnt(0)" ::: "memory");
        for (int kt0 = kstart; kt0 < kend; kt0 += 64) {
            AT_LOAD(1, kt0 + 32);
            asm volatile("s_waitcnt vmcnt(8)" ::: "memory");
            AT_COMPUTE(0, kt0);
            if (kt0 + 64 < kend) { AT_LOAD(0, kt0 + 64); asm volatile("s_waitcnt vmcnt(8)" ::: "memory"); }
            else asm volatile("s_waitcnt vmcnt(0)" ::: "memory");
            AT_COMPUTE(1, kt0 + 32);
        }
#undef AT_LOAD
#undef AT_COMPUTE
#pragma unroll
        for (int qi = 0; qi < 4; ++qi) {
            float l = lsum[qi]; l += shflx(l, lane, 16); l += shflx(l, lane, 32);
            const float inv = __builtin_amdgcn_rcpf(l);
#pragma unroll
            for (int dt = 0; dt < 4; ++dt) {
                u32x2 pk; pk[0] = cvt_pk_bf16(oacc[qi][dt][0] * inv, oacc[qi][dt][1] * inv); pk[1] = cvt_pk_bf16(oacc[qi][dt][2] * inv, oacc[qi][dt][3] * inv);
                *(u32x2*)(wl + (qi * 16 + lr) * 136 + (dt * 16 + quad * 4) * 2) = pk;
            }
        }
        asm volatile("" ::: "memory");
#pragma unroll
        for (int i = 0; i < 8; ++i) {
            const int row = i * 8 + krow;
            *(u32x4*)(yd + (size_t)(b * SEQ + q0 + row) * DMIX + hh * 64 + (lane & 7) * 8) = *(const u32x4*)(wl + row * 136 + (lane & 7) * 16);
        }
    }
    __syncthreads();
}

__device__ __forceinline__ void lru_phase(const int tid_, const int bid_, const int gdim_, unsigned char* lds, const bf16_t* __restrict__ h, const float* __restrict__ conv_w, const float* __restrict__ conv_b,
                          const float* __restrict__ wrp, const float* __restrict__ brp, const float* __restrict__ wip, const float* __restrict__ bip,
                          const float* __restrict__ lam, bf16_t* __restrict__ ya_out) {
    bf16_t* WrT = (bf16_t*)lds;
    bf16_t* WiT = WrT + 64 * 72;
    bf16_t* xcb = WiT + 64 * 72;
    bf16_t* xraw = xcb + 64 * 72;
    bf16_t* yraw = xraw + 67 * 64 + 64;
    float* xcf = (float*)(yraw + 64 * 64);
    float* abuf = xcf + 4096;
    float* ubuf = abuf + 4096;
    float* ibuf = ubuf + 4096;
    float* hbuf = ibuf + 4096;
    float* gbuf = xcf;
    const int tid = tid_, lane = tid & 63, wid = tid >> 6, lr = lane & 15, quad = lane >> 4;
    for (int item = bid_; item < BATCH * 8; item += gdim_) {
        const int b = item >> 3, g = item & 7;
        __syncthreads();
        for (int e = tid; e < 4096; e += 512) { const int i = e >> 6, j = e & 63;
            WrT[j * 72 + i] = f2bf(wrp[(size_t)g * 4096 + e]); WiT[j * 72 + i] = f2bf(wip[(size_t)g * 4096 + e]); }
        const int ch = tid & 63, trow = tid >> 6;
        const int cg_ = g * 64 + ch;
        const float cw0 = conv_w[cg_], cw1 = conv_w[512 + cg_], cw2 = conv_w[1024 + cg_], cw3 = conv_w[1536 + cg_], cb = conv_b[cg_];
        const int r8 = tid >> 3, pc = (tid & 7) * 8;
        const bf16_t* hrow = h + (size_t)(b * SEQ + r8) * INC + COL_A + g * 64 + pc;
        u32x4 xa16 = *(const u32x4*)hrow, ya16 = *(const u32x4*)(hrow + 512), prev16 = (u32x4){0u, 0u, 0u, 0u};
        float hstate = 0.f;
        for (int tc = 0; tc < SEQ / 64; ++tc) {
            const int t0 = tc * 64;
            *(u32x4*)(xraw + (3 + r8) * 64 + pc) = xa16; *(u32x4*)(yraw + r8 * 64 + pc) = ya16;
            if (r8 >= 61) *(u32x4*)(xraw + (r8 - 61) * 64 + pc) = prev16;
            prev16 = xa16;
            if (tc + 1 < SEQ / 64) { const bf16_t* nx = hrow + (size_t)(t0 + 64) * INC; xa16 = *(const u32x4*)nx; ya16 = *(const u32x4*)(nx + 512); }
            LDS_BARRIER();
#pragma unroll
            for (int i = 0; i < 8; ++i) {
                const int tl = trow + 8 * i;
                const float x3 = bf2f(xraw[tl * 64 + ch]), x2 = bf2f(xraw[(tl + 1) * 64 + ch]), x1 = bf2f(xraw[(tl + 2) * 64 + ch]), x0 = bf2f(xraw[(tl + 3) * 64 + ch]);
                const float xc = cw3 * x0 + cw2 * x1 + cw1 * x2 + cw0 * x3 + cb;
                xcf[tl * 64 + ch] = xc; xcb[tl * 72 + ch] = f2bf(xc);
            }
            LDS_BARRIER();
            {
                const int tt = wid & 3, which = wid >> 2;
                const bf16_t* WT = which ? WiT : WrT;
                const bf16x8 a0 = *(const bf16x8*)(xcb + (tt * 16 + lr) * 72 + quad * 8), a1 = *(const bf16x8*)(xcb + (tt * 16 + lr) * 72 + 32 + quad * 8);
#pragma unroll
                for (int jt = 0; jt < 4; ++jt) {
                    const bf16x8 b0 = *(const bf16x8*)(WT + (jt * 16 + lr) * 72 + quad * 8), b1 = *(const bf16x8*)(WT + (jt * 16 + lr) * 72 + 32 + quad * 8);
                    f32x4 cacc = (f32x4){0.f, 0.f, 0.f, 0.f};
                    cacc = __builtin_amdgcn_mfma_f32_16x16x32_bf16(a0, b0, cacc, 0, 0, 0);
                    cacc = __builtin_amdgcn_mfma_f32_16x16x32_bf16(a1, b1, cacc, 0, 0, 0);
                    const int j = jt * 16 + lr, cj = g * 64 + j;
                    if (which == 0) {
                        const float bias = brp[cj], lm = lam[cj];
                        const float sp = fmaxf(-lm, 0.f) + flog1p_small(fexp(-fabsf(lm)));
#pragma unroll
                        for (int jj = 0; jj < 4; ++jj) {
                            const int tl = tt * 16 + quad * 4 + jj;
                            const float r = sigmoidf_(cacc[jj] + bias);
                            const float la = -8.0f * r * sp;
                            abuf[tl * 64 + j] = fexp(la);
                            ubuf[tl * 64 + j] = __builtin_amdgcn_sqrtf(fneg_expm1(2.0f * la)) * xcf[tl * 64 + j];
                        }
                    } else {
                        const float bias = bip[cj];
#pragma unroll
                        for (int jj = 0; jj < 4; ++jj) { const int tl = tt * 16 + quad * 4 + jj; ibuf[tl * 64 + j] = sigmoidf_(cacc[jj] + bias); }
                    }
                }
            }
            LDS_BARRIER();
            if (wid == 0) {
#pragma unroll 8
                for (int tl = 0; tl < 64; ++tl) { hstate = abuf[tl * 64 + lane] * hstate + ubuf[tl * 64 + lane] * ibuf[tl * 64 + lane]; hbuf[tl * 64 + lane] = hstate; }
            } else {
                for (int e = tid - 64; e < 4096; e += 448) {
                    const float y = bf2f(yraw[e]);
                    gbuf[e] = 0.5f * y * (1.0f + ftanh(0.7978845608028654f * (y + 0.044715f * y * y * y)));
                }
            }
            LDS_BARRIER();
            {
                float o[8];
                const f32x4 h0 = *(const f32x4*)(hbuf + r8 * 64 + pc), h1 = *(const f32x4*)(hbuf + r8 * 64 + pc + 4);
                const f32x4 g0 = *(const f32x4*)(gbuf + r8 * 64 + pc), g1 = *(const f32x4*)(gbuf + r8 * 64 + pc + 4);
#pragma unroll
                for (int j = 0; j < 4; ++j) { o[j] = h0[j] * g0[j]; o[4 + j] = h1[j] * g1[j]; }
                *(u32x4*)(ya_out + (size_t)(b * SEQ + t0 + r8) * DMIX + g * 64 + pc) = pack8(o);
            }
        }
    }
    __syncthreads();
}

constexpr int RT = 16, REC = 456;
__device__ __forceinline__ float dpp_x1(float v) { return __int_as_float(__builtin_amdgcn_update_dpp(0, __float_as_int(v), 0xB1, 0xF, 0xF, true)); }
__device__ __forceinline__ float dpp_x2(float v) { return __int_as_float(__builtin_amdgcn_update_dpp(0, __float_as_int(v), 0x4E, 0xF, 0xF, true)); }
__device__ __forceinline__ void rwkv_phase(const int tid_, const int bid_, const int gdim_, unsigned char* lds, const bf16_t* __restrict__ h, const float* __restrict__ mu, const float* __restrict__ w0p, const float* __restrict__ w2p,
                           const float* __restrict__ a0p, const float* __restrict__ a2p, const float* __restrict__ g2p, const float* __restrict__ kkp, const float* __restrict__ kap,
                           const float* __restrict__ rkp, const float* __restrict__ gng, const float* __restrict__ gnb, bf16_t* __restrict__ yc) {
    bf16_t* W2T = (bf16_t*)lds;
    bf16_t* A2T = W2T + 64 * 72;
    bf16_t* G2T = A2T + 64 * 72;
    bf16_t* linb = G2T + 64 * 136;
    float* lo = (float*)(linb + 4 * 4 * 264);
    float* rec = lo + 4 * 4 * 192;
    float* obuf = rec + 2 * RT * REC;
    const int tid = tid_, lane = tid & 63, wid = __builtin_amdgcn_readfirstlane(tid >> 6);
    constexpr int NC = SEQ / RT;
    for (int item = bid_; item < BATCH * 8; item += gdim_) {
        const int b = item >> 3, hh = item & 7, hj = hh * 64 + lane;
        __syncthreads();
        for (int e = tid; e < 4096; e += 512) { const int i = e >> 6, j = e & 63; W2T[j * 72 + i] = f2bf(w2p[i * 512 + hh * 64 + j]); A2T[j * 72 + i] = f2bf(a2p[i * 512 + hh * 64 + j]); }
        for (int e = tid; e < 8192; e += 512) { const int i = e >> 6, j = e & 63; G2T[j * 136 + i] = f2bf(g2p[i * 512 + hh * 64 + j]); }
        __syncthreads();
        if (wid < 4) {
            const int r = lane >> 2, kq = lane & 3, row = wid * 16 + r;
            f32x2 S[8];
#pragma unroll
            for (int i = 0; i < 8; ++i) S[i] = (f32x2){0.f, 0.f};
            LDS_BARRIER();
            for (int c = 0; c < NC; ++c) {
                const float* R0 = rec + (c & 1) * RT * REC + kq * 16;
                float* ob = obuf + (c & 1) * RT * 64 + row;
                f32x4 dt[2][8], up[2][12]; float vv[2]; f32x2 scs[2];
#define RW_LOAD(buf, t) do { const float* Rk = R0 + (t) * REC; _Pragma("unroll") for (int i = 0; i < 4; ++i) { dt[buf][i] = *(const f32x4*)(Rk + 4 * i); dt[buf][4 + i] = *(const f32x4*)(Rk + 64 + 4 * i); } \
                    vv[buf] = Rk[320 - kq * 16 + row]; scs[buf] = *(const f32x2*)(Rk + 448 - kq * 16); \
                    _Pragma("unroll") for (int q = 0; q < 3; ++q) _Pragma("unroll") for (int i = 0; i < 4; ++i) up[buf][q * 4 + i] = *(const f32x4*)(Rk + 128 + q * 64 + 4 * i); } while (0)
                RW_LOAD(0, 0);
#pragma unroll
                for (int t = 0; t < RT; ++t) {
                    const int cb = t & 1;
                    if (t + 1 < RT) RW_LOAD(cb ^ 1, t + 1);
                    const float vval = vv[cb];
                    f32x2 sa0 = (f32x2){0.f, 0.f}, sa1 = (f32x2){0.f, 0.f}, yp0 = (f32x2){0.f, 0.f}, yp1 = (f32x2){0.f, 0.f};
#pragma unroll
                    for (int i = 0; i < 4; ++i) {
                        const f32x4 ah = dt[cb][i], wr = dt[cb][4 + i];
                        sa0 += S[2 * i] * (f32x2){ah[0], ah[1]}; sa1 += S[2 * i + 1] * (f32x2){ah[2], ah[3]};
                        yp0 += S[2 * i] * (f32x2){wr[0], wr[1]}; yp1 += S[2 * i + 1] * (f32x2){wr[2], wr[3]};
                    }
                    sa0 += sa1; yp0 += yp1;
                    float sa = sa0[0] + sa0[1], yp = yp0[0] + yp0[1];
                    sa += dpp_x1(sa); yp += dpp_x1(yp);
                    sa += dpp_x2(sa); yp += dpp_x2(yp);
                    if (kq == 0) ob[t * 64] = yp + sa * scs[cb][0] + vval * scs[cb][1];
                    const f32x2 sav = (f32x2){sa, sa}, vvv = (f32x2){vval, vval};
#pragma unroll
                    for (int i = 0; i < 4; ++i) {
                        const f32x4 dc = up[cb][i], bb = up[cb][4 + i], kp = up[cb][8 + i];
                        S[2 * i] = S[2 * i] * (f32x2){dc[0], dc[1]} + sav * (f32x2){bb[0], bb[1]} + vvv * (f32x2){kp[0], kp[1]};
                        S[2 * i + 1] = S[2 * i + 1] * (f32x2){dc[2], dc[3]} + sav * (f32x2){bb[2], bb[3]} + vvv * (f32x2){kp[2], kp[3]};
                    }
                }
#undef RW_LOAD
                LDS_BARRIER();
            }
        } else {
            const int p = wid - 4, lr = lane & 15, quad = lane >> 4;
            bf16_t* lb = linb + p * 4 * 264;
            float* lop = lo + p * 4 * 192;
            const float mu_r = mu[hj], mu_k = mu[512 + hj], mu_v = mu[1024 + hj];
            float mu_l[4];
#pragma unroll
            for (int q = 0; q < 4; ++q) mu_l[q] = mu[1536 + lane + 64 * q];
            const float w0 = w0p[hj], a0 = a0p[hj], k_k = kkp[hj], k_a = kap[hj], r_k = rkp[hj], gn_g = gng[hj], gn_b = gnb[hj];
            const bf16_t* hC = h + (size_t)b * SEQ * INC + COL_C;
            unsigned zraw[5][7];
#define RW_GLOAD(cn) do { _Pragma("unroll") for (int rw = 0; rw < 5; ++rw) { const int t = (cn) * RT + p * 4 + rw - 1; \
                    const bf16_t* ptr = hC + (size_t)(t < 0 ? 0 : t) * INC; \
                    zraw[rw][0] = ptr[hj]; zraw[rw][1] = ptr[512 + hj]; zraw[rw][2] = ptr[1024 + hj]; \
                    _Pragma("unroll") for (int q = 0; q < 4; ++q) zraw[rw][3 + q] = ptr[1536 + lane + 64 * q]; } } while (0)
            RW_GLOAD(0);
            for (int c = -1; c < NC; ++c) {
                const bool do_prep = (c + 1 < NC), do_post = (c >= 1);
                float cr[5], ck[5], cv[5], cl[5][4];
#pragma unroll
                for (int rw = 0; rw < 5; ++rw) { cr[rw] = bf2f(zraw[rw][0]); ck[rw] = bf2f(zraw[rw][1]); cv[rw] = bf2f(zraw[rw][2]);
#pragma unroll
                    for (int q = 0; q < 4; ++q) cl[rw][q] = bf2f(zraw[rw][3 + q]); }
                if (c == -1 && p == 0) { cr[0] = 0.f; ck[0] = 0.f; cv[0] = 0.f; cl[0][0] = 0.f; cl[0][1] = 0.f; cl[0][2] = 0.f; cl[0][3] = 0.f; }
                if (c + 2 < NC) RW_GLOAD(c + 2);
                if (do_post) {
                    const float* Rb = rec + ((c - 1) & 1) * RT * REC;
                    const float* ob = obuf + ((c - 1) & 1) * RT * 64;
                    float ov[4], sm[8];
#pragma unroll
                    for (int u = 0; u < 4; ++u) { ov[u] = ob[(p * 4 + u) * 64 + lane]; sm[2 * u] = ov[u]; sm[2 * u + 1] = ov[u] * ov[u]; }
                    wave_sum_n<8>(sm);
#pragma unroll
                    for (int u = 0; u < 4; ++u) {
                        const int tt = p * 4 + u, t = (c - 1) * RT + tt;
                        const float* R = Rb + tt * REC;
                        const float mean = sm[2 * u] * (1.0f / 64.0f), var = fmaxf(sm[2 * u + 1] * (1.0f / 64.0f) - mean * mean, 0.f);
                        float o = (ov[u] - mean) * __builtin_amdgcn_rsqf(var + GN_EPS) * gn_g + gn_b;
                        o += R[450] * R[320 + lane];
                        yc[(size_t)(b * SEQ + t) * DMIX + hj] = f2bf(o * R[384 + lane]);
                    }
                }
                if (do_prep) {
                    float rr[4], kx[4], vx[4];
#pragma unroll
                    for (int u = 0; u < 4; ++u) {
                        rr[u] = cr[u + 1] + (cr[u] - cr[u + 1]) * mu_r; kx[u] = ck[u + 1] + (ck[u] - ck[u + 1]) * mu_k; vx[u] = cv[u + 1] + (cv[u] - cv[u + 1]) * mu_v;
#pragma unroll
                        for (int q = 0; q < 4; ++q) {
                            const float z = cl[u + 1][q] + (cl[u][q] - cl[u + 1][q]) * mu_l[q];
                            const float val = (q == 0) ? ftanh(z) : (q == 1 ? z : sigmoidf_(z));
                            lb[u * 264 + lane + 64 * q] = f2bf(val);
                        }
                    }
                    asm volatile("s_waitcnt lgkmcnt(0)" ::: "memory");
                    bf16x8 af[8];
#pragma unroll
                    for (int k8 = 0; k8 < 8; ++k8) af[k8] = *(const bf16x8*)(lb + (lane & 3) * 264 + k8 * 32 + quad * 8);
#pragma unroll
                    for (int jt = 0; jt < 4; ++jt) {
                        f32x4 cw = (f32x4){0.f, 0.f, 0.f, 0.f}, ca = cw, cgm = cw;
#pragma unroll
                        for (int kh = 0; kh < 2; ++kh) {
                            cw = __builtin_amdgcn_mfma_f32_16x16x32_bf16(af[kh], *(const bf16x8*)(W2T + (jt * 16 + lr) * 72 + kh * 32 + quad * 8), cw, 0, 0, 0);
                            ca = __builtin_amdgcn_mfma_f32_16x16x32_bf16(af[2 + kh], *(const bf16x8*)(A2T + (jt * 16 + lr) * 72 + kh * 32 + quad * 8), ca, 0, 0, 0);
                        }
#pragma unroll
                        for (int kh = 0; kh < 4; ++kh)
                            cgm = __builtin_amdgcn_mfma_f32_16x16x32_bf16(af[4 + kh], *(const bf16x8*)(G2T + (jt * 16 + lr) * 136 + kh * 32 + quad * 8), cgm, 0, 0, 0);
                        if (quad == 0) {
#pragma unroll
                            for (int jj = 0; jj < 4; ++jj) { lop[jj * 192 + jt * 16 + lr] = cw[jj]; lop[jj * 192 + 64 + jt * 16 + lr] = ca[jj]; lop[jj * 192 + 128 + jt * 16 + lr] = cgm[jj]; }
                        }
                    }
                    asm volatile("s_waitcnt lgkmcnt(0)" ::: "memory");
                    float* Rb = rec + ((c + 1) & 1) * RT * REC;
                    float dcy[4], av[4], kqv[4], kpv[4], ggv[4], red[16];
#pragma unroll
                    for (int u = 0; u < 4; ++u) {
                        const float wl = w0 + lop[u * 192 + lane], ap = a0 + lop[u * 192 + 64 + lane]; ggv[u] = lop[u * 192 + 128 + lane];
                        const float z = -wl;
                        const float sp = fmaxf(z, 0.f) + flog(1.0f + fexp(-fabsf(z)));
                        dcy[u] = fexp(-fexp(-sp - 0.5f));
                        av[u] = sigmoidf_(ap);
                        kqv[u] = kx[u] * k_k;
                        kpv[u] = kx[u] * (1.0f + (av[u] - 1.0f) * k_a);
                        red[4 * u] = kqv[u] * kqv[u]; red[4 * u + 1] = kqv[u] * av[u] * rr[u]; red[4 * u + 2] = kpv[u] * rr[u]; red[4 * u + 3] = rr[u] * kpv[u] * r_k;
                    }
                    wave_sum_n<16>(red);
#pragma unroll
                    for (int u = 0; u < 4; ++u) {
                        const int tt = p * 4 + u;
                        const float inv = __builtin_amdgcn_rcpf(fmaxf(__builtin_amdgcn_sqrtf(red[4 * u]), 1e-12f));
                        const float kkn = kqv[u] * inv;
                        float* R = Rb + tt * REC;
                        R[lane] = -kkn; R[64 + lane] = dcy[u] * rr[u]; R[128 + lane] = dcy[u]; R[192 + lane] = kkn * av[u]; R[256 + lane] = kpv[u]; R[320 + lane] = vx[u]; R[384 + lane] = ggv[u];
                        if (lane == 0) { R[448] = red[4 * u + 1] * inv; R[449] = red[4 * u + 2]; R[450] = red[4 * u + 3]; }
                    }
                }
                LDS_BARRIER();
            }
#undef RW_GLOAD
            {
                const float* Rb = rec + ((NC - 1) & 1) * RT * REC;
                const float* ob = obuf + ((NC - 1) & 1) * RT * 64;
                float ov[4], sm[8];
#pragma unroll
                for (int u = 0; u < 4; ++u) { ov[u] = ob[(p * 4 + u) * 64 + lane]; sm[2 * u] = ov[u]; sm[2 * u + 1] = ov[u] * ov[u]; }
                wave_sum_n<8>(sm);
#pragma unroll
                for (int u = 0; u < 4; ++u) {
                    const int tt = p * 4 + u, t = (NC - 1) * RT + tt;
                    const float* R = Rb + tt * REC;
                    const float mean = sm[2 * u] * (1.0f / 64.0f), var = fmaxf(sm[2 * u + 1] * (1.0f / 64.0f) - mean * mean, 0.f);
                    float o = (ov[u] - mean) * __builtin_amdgcn_rsqf(var + GN_EPS) * gn_g + gn_b;
                    o += R[450] * R[320 + lane];
                    yc[(size_t)(b * SEQ + t) * DMIX + hj] = f2bf(o * R[384 + lane]);
                }
            }
        }
    }
    __syncthreads();
}

#define XB_TMO      128
#define XB_XCNT(j)  (256  + 64 * (j))
#define XB_XSUB(j)  (1280 + 64 * (j))
#define XB_XGEN(j)  (2304 + 64 * (j))
#define XB_TOP      3328
#define XB_TOPGEN   3392
#define XCD_BAR_WORDS 3456
#define XB_SPIN_CAP (1u << 18)
__device__ __forceinline__ unsigned xb_ld(unsigned* p)              { return __hip_atomic_load(p, __ATOMIC_RELAXED, __HIP_MEMORY_SCOPE_AGENT); }
__device__ __forceinline__ unsigned xb_add(unsigned* p, unsigned v) { return __hip_atomic_fetch_add(p, v, __ATOMIC_RELAXED, __HIP_MEMORY_SCOPE_AGENT); }
__device__ __forceinline__ unsigned xb_xcc_id() { return (unsigned)__builtin_amdgcn_s_getreg((3 << 11) | 20) & 0xFu; }
#define XB_SPIN(cond, bar) do { unsigned _sp = 0; while (cond) { __builtin_amdgcn_s_sleep(1); \
    if ((++_sp & 255u) == 0u) { if (xb_ld(&(bar)[XB_TMO])) break; if (_sp > XB_SPIN_CAP) { atomicAdd(&(bar)[XB_TMO], 1u); break; } } } } while (0)
struct XcdBarrier { unsigned* bar; unsigned x; volatile LAS unsigned* st; };
__device__ __forceinline__ XcdBarrier xcd_barrier_post(unsigned* bar, volatile LAS unsigned* st) {
    XcdBarrier b; b.bar = bar; b.x = xb_xcc_id(); b.st = st;
    if (threadIdx.x == 0) (void)xb_add(&bar[XB_XCNT(b.x)], 1u);
    return b;
}
__device__ __forceinline__ void xcd_barrier_complete(unsigned* bar, unsigned x, unsigned& nloc, unsigned& nx) {
    const unsigned G = gridDim.x;
    unsigned sum, cnt, mine, sp = 0u;
    for (;;) {
        sum = 0u; cnt = 0u; mine = 0u;
#pragma unroll
        for (unsigned j = 0; j < 16; ++j) { const unsigned c = xb_ld(&bar[XB_XCNT(j)]); sum += c; cnt += (c > 0u) ? 1u : 0u; mine = (j == x) ? c : mine; }
        if (sum == G) break;
        __builtin_amdgcn_s_sleep(1);
        if ((++sp & 255u) == 0u) { if (xb_ld(&bar[XB_TMO])) break; if (sp > XB_SPIN_CAP) { atomicAdd(&bar[XB_TMO], 1u); break; } }
    }
    nloc = mine > 0u ? mine : 1u; nx = cnt > 0u ? cnt : 1u;
}
__device__ __forceinline__ void xcd_barrier(const XcdBarrier& b, const int tid) {
    asm volatile("s_waitcnt vmcnt(0)" ::: "memory");
    __syncthreads();
    if (tid == 0) {
        unsigned* bar = b.bar;
        __builtin_amdgcn_s_waitcnt(0);
        unsigned nloc = b.st[0], nx = b.st[1];
        if (nloc == 0u) { xcd_barrier_complete(bar, b.x, nloc, nx); b.st[0] = nloc; b.st[1] = nx; }
        const unsigned old = xb_add(&bar[XB_XSUB(b.x)], 1u);
        const unsigned gen = old / nloc;
        if (old + 1u == (gen + 1u) * nloc) {
            __builtin_amdgcn_fence(__ATOMIC_RELEASE, "agent");
            asm volatile("s_waitcnt vmcnt(0)" ::: "memory");
            const unsigned og = xb_add(&bar[XB_TOP], 1u);
            const unsigned tg = og / nx;
            if (og + 1u == (tg + 1u) * nx) xb_add(&bar[XB_TOPGEN], 1u);
            else XB_SPIN(xb_ld(&bar[XB_TOPGEN]) == tg, bar);
            __builtin_amdgcn_fence(__ATOMIC_ACQUIRE, "agent");
            xb_add(&bar[XB_XGEN(b.x)], 1u);
            asm volatile("s_waitcnt vmcnt(0)" ::: "memory");
        } else {
            XB_SPIN(xb_ld(&bar[XB_XGEN(b.x)]) == gen, bar);
            __builtin_amdgcn_fence(__ATOMIC_ACQUIRE, "agent");
            asm volatile("s_waitcnt vmcnt(0)" ::: "memory");
        }
    }
    __syncthreads();
}

constexpr int NPH = 12;
__global__ void __launch_bounds__(512, 2) mega(Params P, int ph_lo, int ph_hi) {
    extern __shared__ __attribute__((aligned(16))) unsigned char shm[];
    LAS unsigned char* lds = (LAS unsigned char*)shm;
    cg::grid_group grid = cg::this_grid();
    const int swid = __builtin_amdgcn_readfirstlane((int)threadIdx.x >> 6);
    volatile LAS unsigned* xst = (volatile LAS unsigned*)(lds + 131072);
    if (threadIdx.x < 2) xst[threadIdx.x] = 0u;
    __syncthreads();
    const XcdBarrier xbar = xcd_barrier_post((unsigned*)(P.ws + WS_BAR), xst);
    unsigned char* ws = P.ws;
    bf16_t* xb = (bf16_t*)(ws + WS_XB);
    bf16_t* wt = (bf16_t*)(ws + WS_WT);
    bf16_t* pb = (bf16_t*)(ws + WS_PB);
    bf16_t* hbuf = (bf16_t*)(ws + WS_H);
    bf16_t* vt = (bf16_t*)(ws + WS_VT);
    bf16_t* pq = hbuf;
    bf16_t* ubuf = hbuf;
    bf16_t* plb = (bf16_t*)(ws + WS_H + 512 * MiB);
    bf16_t* ybase = (bf16_t*)P.out;
    bf16_t* mb = plb;
    for (int ph = ph_lo; ph < ph_hi; ++ph) {
        const int l = ph / NPH, k = ph % NPH;
        const int njobs = (k == 1 || k == 5 || k == 6 || k == 9 || k == 10) ? 1 : (k == 4 ? 4 : (k == 8 ? 2 : 0));
        for (int rep = 0; rep < ((k == REPK) ? REPN : 1); ++rep) {
        int bid_ = blockIdx.x, gdim_ = gridDim.x; asm volatile("" : "+s"(bid_)); asm volatile("" : "+s"(gdim_)); int z_ = 0; asm volatile("" : "+s"(z_));
        int tid_ = (swid << 6) + (int)__builtin_amdgcn_mbcnt_hi(~0u, __builtin_amdgcn_mbcnt_lo(~0u, (unsigned)z_)); asm volatile("" : "+v"(tid_));
        if (njobs) {
            for (int n = 0; n < njobs; ++n) {
                pg8::Epi E; E.mode = 0; E.act = 0; E.ob = nullptr; E.ldo = 0; E.bias = nullptr; E.io2 = nullptr; E.resf = nullptr; E.aux = nullptr;
                pg8::Gemm g; g.M = MTOK; g.A = xb; g.lda = D; g.K = D; g.Bt = wt; g.ldb = D; g.N = D;
                int merge = 0;
                if (k == 1) { E.ob = hbuf; E.ldo = INC; g.Bt = wt + WO_IN; g.N = INC; }
                else if (k == 4) { E.ob = pq + (size_t)n * D; E.ldo = 4 * D; g.A = ybase + (size_t)n * MTOK * DMIX; g.lda = DMIX; g.K = DMIX; g.Bt = wt + WO_B + (size_t)n * D * DMIX; g.ldb = DMIX; }
                else if (k == 5) { E.mode = 3; E.ob = pq; E.ldo = 4 * D; E.bias = P.in[25 + z_] + (size_t)l * 4 * D; E.io2 = mb; g.Bt = wt + WO_G; g.N = 4 * D; merge = 1; }
                else if (k == 6) { E.mode = 2; E.io2 = xb; if (l == 0) E.resf = P.in[0 + z_]; g.A = mb; g.Bt = wt + WO_OUT4; }
                else if (k == 8 && n == 0) { E.act = 1; E.ob = ubuf; E.ldo = DFF; g.Bt = wt + WO_FF1; g.N = DFF; }
                else if (k == 8) { E.ob = plb; E.ldo = D; g.A = pb; g.lda = DPLE; g.K = DPLE; g.Bt = wt + WO_PLE; g.ldb = DPLE; }
                else if (k == 9) { E.mode = 1; E.ob = plb; E.ldo = D; E.bias = P.in[33 + z_] + (size_t)l * D; g.Bt = wt + WO_PLEG; }
                else { E.mode = 2; E.io2 = xb; E.aux = plb; g.A = ubuf; g.lda = DFF; g.K = DFF; g.Bt = wt + WO_FF2; g.ldb = DFF; }
                pg8::StaticOrder S; S.init(g.M, g.N, gdim_, bid_, merge);
                pg8::gemm_phase(tid_, lds, g, S, E);
                __syncthreads();
            }
        } else if (k == 0) {
            float* tile = (float*)shm;
            tconv(tid_, bid_, gdim_, tile, P.in[2 + z_] + (size_t)l * D * INC, D, INC, wt + WO_IN, D);
            for (int n = 0; n < 4; ++n) tconv(tid_, bid_, gdim_, tile, P.in[24 + z_] + ((size_t)l * 4 + n) * D * D, D, D, wt + WO_G + (size_t)n * D * D, D);
            for (int n = 0; n < 4; ++n) tconv(tid_, bid_, gdim_, tile, P.in[23 + z_] + ((size_t)l * 4 + n) * DMIX * D, DMIX, D, wt + WO_B + (size_t)n * D * DMIX, DMIX);
            tconv(tid_, bid_, gdim_, tile, P.in[26 + z_] + (size_t)l * D * D, D, D, wt + WO_OUT4, D);
            tconv(tid_, bid_, gdim_, tile, P.in[29 + z_] + (size_t)l * D * DFF, D, DFF, wt + WO_FF1, D);
            tconv(tid_, bid_, gdim_, tile, P.in[30 + z_] + (size_t)l * DFF * D, DFF, D, wt + WO_FF2, DFF);
            tconv(tid_, bid_, gdim_, tile, P.in[31 + z_] + (size_t)l * DPLE * D, DPLE, D, wt + WO_PLE, DPLE);
            tconv(tid_, bid_, gdim_, tile, P.in[32 + z_] + (size_t)l * D * D, D, D, wt + WO_PLEG, D);
            econv(tid_, bid_, gdim_, P.in[1 + z_] + (size_t)l * MTOK * DPLE, pb, (size_t)MTOK * DPLE);
            if (l == 0) econv(tid_, bid_, gdim_, P.in[0 + z_], xb, (size_t)MTOK * D);
        } else if (k == 2) {
            for (int r2 = 0; r2 < REP_LRU; ++r2) { int t2_ = tid_, b2_ = bid_; asm volatile("" : "+v"(t2_)); asm volatile("" : "+s"(b2_));
            lru_phase(t2_, b2_, gdim_, shm, hbuf, P.in[3 + z_] + (size_t)l * 4 * DMIX, P.in[4 + z_] + (size_t)l * DMIX, P.in[5 + z_] + (size_t)l * 8 * 4096, P.in[6 + z_] + (size_t)l * DMIX,
                      P.in[7 + z_] + (size_t)l * 8 * 4096, P.in[8 + z_] + (size_t)l * DMIX, P.in[9 + z_] + (size_t)l * DMIX, ybase);
            }
            for (int r2 = 0; r2 < REP_RWKV; ++r2) { int t2_ = tid_, b2_ = bid_; asm volatile("" : "+v"(t2_)); asm volatile("" : "+s"(b2_));
            rwkv_phase(t2_, b2_, gdim_, shm, hbuf, P.in[11 + z_] + (size_t)l * 1792, P.in[12 + z_] + (size_t)l * DMIX, P.in[13 + z_] + (size_t)l * 64 * DMIX, P.in[14 + z_] + (size_t)l * DMIX,
                       P.in[15 + z_] + (size_t)l * 64 * DMIX, P.in[16 + z_] + (size_t)l * 128 * DMIX, P.in[17 + z_] + (size_t)l * DMIX, P.in[18 + z_] + (size_t)l * DMIX,
                       P.in[19 + z_] + (size_t)l * DMIX, P.in[20 + z_] + (size_t)l * DMIX, P.in[21 + z_] + (size_t)l * DMIX, ybase + (size_t)2 * MTOK * DMIX);
            }
            for (int r2 = 0; r2 < REP_SV; ++r2) { int t2_ = tid_, b2_ = bid_; asm volatile("" : "+v"(t2_)); asm volatile("" : "+s"(b2_));
            sconv_phase(t2_, b2_, gdim_, hbuf, P.in[10 + z_] + (size_t)l * 3 * DMIX, ybase + (size_t)1 * MTOK * DMIX);
            vtrans_phase(t2_, b2_, gdim_, (bf16_t*)shm, hbuf, vt);
            }
        } else if (k == 3) {
            attn_phase(tid_, bid_, gdim_, shm, hbuf, vt, P.in[22 + z_], ybase + (size_t)3 * MTOK * DMIX);
        } else if (k == 7) {
            ln_phase(tid_, bid_, gdim_, xb, P.in[27 + z_] + (size_t)l * D, P.in[28 + z_] + (size_t)l * D, nullptr);
        } else {
            ln_phase(tid_, bid_, gdim_, xb, P.in[34 + z_] + (size_t)l * D, P.in[35 + z_] + (size_t)l * D, l == DEPTH - 1 ? P.out : nullptr);
        }
        }
        if (ph + 1 < ph_hi) { if (ph == ph_lo) { asm volatile("s_waitcnt vmcnt(0) lgkmcnt(0)" ::: "memory"); grid.sync(); } else { int zb_ = 0; asm volatile("" : "+s"(zb_)); const int tb_ = (swid << 6) + (int)__builtin_amdgcn_mbcnt_hi(~0u, __builtin_amdgcn_mbcnt_lo(~0u, (unsigned)zb_)); xcd_barrier(xbar, tb_); } }
    }
}

extern "C" void kernel_launch(void* const* d_in, const int* in_sizes, int n_in, void* d_out, int out_size, void* d_ws, size_t ws_size, hipStream_t stream) {
    static int grid = 0;
    if (grid == 0) {
        int dev = 0, cus = 0, per_cu = 0;
        hipGetDevice(&dev);
        hipDeviceGetAttribute(&cus, hipDeviceAttributeMultiprocessorCount, dev);
        hipFuncSetAttribute((const void*)mega, hipFuncAttributeMaxDynamicSharedMemorySize, LDS_BYTES);
        hipOccupancyMaxActiveBlocksPerMultiprocessor(&per_cu, (const void*)mega, 512, LDS_BYTES);
        if (per_cu < 1) { fprintf(stderr, "kernel_launch: occupancy query says %d blocks/CU\n", per_cu); per_cu = 1; }
        (void)hipGetLastError();
        grid = cus * 1;
        if (n_in != 36 || ws_size < 1013 * MiB) fprintf(stderr, "kernel_launch: unexpected n_in %d / ws_size %zu\n", n_in, ws_size);
    }
    (void)hipMemsetAsync((char*)d_ws + WS_BAR, 0, XCD_BAR_WORDS * sizeof(unsigned), stream);
    Params p{};
    for (int i = 0; i < 36; ++i) p.in[i] = (const float*)d_in[i];
    p.out = (float*)d_out; p.ws = (unsigned char*)d_ws;
#if ONE_LAUNCH
    int lo = 0, hi = DEPTH * NPH;
    void* args[] = {&p, &lo, &hi};
    hipError_t e = hipLaunchCooperativeKernel((const void*)mega, dim3(grid), dim3(512), args, LDS_BYTES, stream);
    if (e != hipSuccess) fprintf(stderr, "cooperative launch failed: %s (grid %d)\n", hipGetErrorString(e), grid);
#else
    for (int ph = 0; ph < DEPTH * NPH; ++ph) hipLaunchKernelGGL(mega, dim3(grid), dim3(512), LDS_BYTES, stream, p, ph, ph + 1);
#endif
}
```

```cpp
#include <hip/hip_runtime.h>
#include <hip/hip_cooperative_groups.h>
#include <cstdio>
#include <cstdint>
namespace cg = cooperative_groups;

#ifndef REPK
#define REPK -1
#endif
#ifndef REPN
#define REPN 1
#endif
#ifndef REP_LRU
#define REP_LRU 1
#endif
#ifndef REP_RWKV
#define REP_RWKV 1
#endif
#ifndef REP_SV
#define REP_SV 1
#endif
#ifndef ONE_LAUNCH
#define ONE_LAUNCH 1
#endif

#define LAS __attribute__((address_space(3)))
typedef unsigned short bf16_t;
typedef short bf16x8 __attribute__((ext_vector_type(8)));
typedef short bf16x4 __attribute__((ext_vector_type(4)));
typedef float f32x4 __attribute__((ext_vector_type(4)));
typedef float f32x2 __attribute__((ext_vector_type(2)));
typedef unsigned u32x4 __attribute__((ext_vector_type(4)));
typedef unsigned u32x2 __attribute__((ext_vector_type(2)));

constexpr int D = 1024, BATCH = 32, SEQ = 2048, DEPTH = 2, MTOK = BATCH * SEQ;
constexpr int DMIX = 512, INC = 5888, DFF = 4096, DPLE = 256;
constexpr int COL_A = 0, COL_B = 1024, COL_C = 2560, COL_D = 4352;
constexpr float ALPHA = 1.4142135623730951f;
constexpr float LN_EPS = 1e-5f, GN_EPS = 64e-5f;

constexpr size_t MiB = 1ull << 20;
constexpr size_t WS_XB = 0, WS_WT = 128 * MiB, WS_PB = 180 * MiB, WS_H = 212 * MiB, WS_VT = 948 * MiB;
constexpr size_t WO_IN = 0, WO_G = 6029312, WO_B = WO_G + 4194304, WO_OUT4 = WO_B + 2097152, WO_FF1 = WO_OUT4 + 4194304,
                 WO_FF2 = WO_FF1 + 4194304, WO_PLE = WO_FF2 + 4194304, WO_PLEG = WO_PLE + 262144;
constexpr int LDS_BYTES = 131072 + 16 + 8256;
constexpr size_t WS_BAR = 1012 * MiB;

struct Params {
    const float* in[36];
    float* out;
    unsigned char* ws;
};

__device__ __forceinline__ float bf2f(unsigned v) { return __uint_as_float(v << 16); }
typedef __bf16 bf16x2_t __attribute__((ext_vector_type(2)));
__device__ __forceinline__ unsigned cvt_pk_bf16(float lo, float hi) { f32x2 v = {lo, hi}; bf16x2_t b = __builtin_convertvector(v, bf16x2_t); unsigned r; __builtin_memcpy(&r, &b, 4); return r; }
__device__ __forceinline__ bf16_t f2bf(float f) { return (bf16_t)(cvt_pk_bf16(f, 0.f) & 0xffffu); }
__device__ __forceinline__ float fexp(float x) { return __builtin_amdgcn_exp2f(x * 1.4426950408889634f); }
__device__ __forceinline__ float flog(float x) { return __builtin_amdgcn_logf(x) * 0.6931471805599453f; }
__device__ __forceinline__ float ftanh(float x) { return 1.0f - 2.0f * __builtin_amdgcn_rcpf(1.0f + fexp(2.0f * x)); }
__device__ __forceinline__ float flog1p_small(float x) { return flog(1.0f + x); }
__device__ __forceinline__ float fneg_expm1(float t) { return 1.0f - fexp(t); }
__device__ __forceinline__ float sigmoidf_(float x) { return __builtin_amdgcn_rcpf(1.0f + fexp(-x)); }
__device__ __forceinline__ float wave_sum(float v) {
    v += __int_as_float(__builtin_amdgcn_update_dpp(0, __float_as_int(v), 0xB1, 0xF, 0xF, true));
    v += __int_as_float(__builtin_amdgcn_update_dpp(0, __float_as_int(v), 0x4E, 0xF, 0xF, true));
    v += __int_as_float(__builtin_amdgcn_update_dpp(0, __float_as_int(v), 0x141, 0xF, 0xF, true));
    v += __int_as_float(__builtin_amdgcn_update_dpp(0, __float_as_int(v), 0x140, 0xF, 0xF, true));
    const float s0 = __int_as_float(__builtin_amdgcn_readlane(__float_as_int(v), 0)), s1 = __int_as_float(__builtin_amdgcn_readlane(__float_as_int(v), 16));
    const float s2 = __int_as_float(__builtin_amdgcn_readlane(__float_as_int(v), 32)), s3 = __int_as_float(__builtin_amdgcn_readlane(__float_as_int(v), 48));
    return (s0 + s1) + (s2 + s3);
}
template <int N> __device__ __forceinline__ void wave_sum_n(float (&v)[N]) {
#pragma unroll
    for (int i = 0; i < N; ++i) v[i] += __int_as_float(__builtin_amdgcn_update_dpp(0, __float_as_int(v[i]), 0xB1, 0xF, 0xF, true));
#pragma unroll
    for (int i = 0; i < N; ++i) v[i] += __int_as_float(__builtin_amdgcn_update_dpp(0, __float_as_int(v[i]), 0x4E, 0xF, 0xF, true));
#pragma unroll
    for (int i = 0; i < N; ++i) v[i] += __int_as_float(__builtin_amdgcn_update_dpp(0, __float_as_int(v[i]), 0x141, 0xF, 0xF, true));
#pragma unroll
    for (int i = 0; i < N; ++i) v[i] += __int_as_float(__builtin_amdgcn_update_dpp(0, __float_as_int(v[i]), 0x140, 0xF, 0xF, true));
#pragma unroll
    for (int i = 0; i < N; ++i) v[i] += __int_as_float(__builtin_amdgcn_update_dpp(0, __float_as_int(v[i]), 0x142, 0xA, 0xF, false));
#pragma unroll
    for (int i = 0; i < N; ++i) v[i] += __int_as_float(__builtin_amdgcn_update_dpp(0, __float_as_int(v[i]), 0x143, 0xC, 0xF, false));
#pragma unroll
    for (int i = 0; i < N; ++i) v[i] = __int_as_float(__builtin_amdgcn_readlane(__float_as_int(v[i]), 63));
}
__device__ __forceinline__ float shflx(float v, int lane, int m) { return __int_as_float(__builtin_amdgcn_ds_bpermute((lane ^ m) << 2, __float_as_int(v))); }
__device__ __forceinline__ void unpack8(u32x4 u, float* f) {
#pragma unroll
    for (int i = 0; i < 4; ++i) { f[2 * i] = __uint_as_float(u[i] << 16); f[2 * i + 1] = __uint_as_float(u[i] & 0xffff0000u); }
}
__device__ __forceinline__ u32x4 pack8(const float* f) {
    u32x4 u;
#pragma unroll
    for (int i = 0; i < 4; ++i) u[i] = cvt_pk_bf16(f[2 * i], f[2 * i + 1]);
    return u;
}

namespace pg8 {
constexpr int BM = 256, BK = 64, HALF = 128, HTB = HALF * BK * 2, STAGE_BYTES = 8 * HTB, NXCD = 8, WGM = 8;
__host__ __device__ __forceinline__ int lds_byte(int r, int c) { const int st = (r >> 4) * 2 + (c >> 5), rr = r & 15, cc = c & 31, ob = rr * 64 + cc * 2; return st * 1024 + (ob ^ (((ob >> 9) & 1) << 5)); }
__host__ __device__ __forceinline__ void stage_rc(int b, int& R, int& C) { const int st = b / 1024, sb = b % 1024, swz = sb ^ (((sb >> 9) & 1) << 5); R = (st >> 1) * 16 + swz / 64; C = (st & 1) * 32 + (swz % 64) / 2; }
__host__ __device__ __forceinline__ int perm32(int rho) { const int n = rho >> 4, i = rho & 15; return 8 * (i >> 2) + 4 * n + (i & 3); }
struct Unit { int pm, pn; };
struct Gemm { const bf16_t* A; const bf16_t* Bt; int M, N, K, lda, ldb; };
struct StaticOrder {
    int nM, nN, nwg, G, c, merge;
    __device__ void init(int M, int N, int G_, int c_, int merge_) { merge = merge_; nM = M / BM; nN = (merge_ ? N / 4 : N) / BM; nwg = nM * nN; G = G_; c = c_; }
    __device__ bool next(int i, Unit& u) const {
        int n = 0; if (merge) { n = i & 3; i >>= 2; }
        const long L = (long)i * G + c; if (L >= nwg) return false;
        int wgid = (int)L; { const int q = nwg / NXCD, r = nwg % NXCD, xcd = wgid % NXCD, off = wgid / NXCD; wgid = (xcd < r ? xcd * (q + 1) : r * (q + 1) + (xcd - r) * q) + off; }
        const int nig = WGM * nN, gid = wgid / nig, fm = gid * WGM, gsz = (nM - fm) < WGM ? (nM - fm) : WGM;
        u.pm = fm + ((wgid % nig) % gsz); u.pn = (wgid % nig) / gsz + n * nN; return true;
    }
};

struct Epi {
    int mode;
    int act;
    bf16_t* ob; int ldo;
    const float* bias;
    bf16_t* io2;
    const float* resf;
    const bf16_t* aux;
    __device__ __forceinline__ void operator()(const f32x4 (&acc)[2][2][4][2], const Unit& u, int wr, int wc, int fr, int fq, LAS unsigned char* dump) const {
        int row0 = u.pm * BM + wr * 64 + fr, col0 = u.pn * BM + wc * 32 + 8 * fq;
        asm volatile("" : "+v"(row0), "+v"(col0));
        float bv[2][8];
        if (mode == 1 || mode == 3) {
#pragma unroll
            for (int bj = 0; bj < 2; ++bj) { const f32x4 b0 = *(const f32x4*)(bias + col0 + bj * HALF), b1 = *(const f32x4*)(bias + col0 + bj * HALF + 4);
#pragma unroll
                for (int j = 0; j < 4; ++j) { bv[bj][j] = b0[j]; bv[bj][4 + j] = b1[j]; } }
        }
        if (mode != 0) {
#pragma unroll
            for (int ai = 0; ai < 2; ++ai)
#pragma unroll
                for (int m = 0; m < 4; ++m)
#pragma unroll
                    for (int bj = 0; bj < 2; ++bj) {
                        const size_t row = (size_t)(row0 + ai * HALF + m * 16); const int col = col0 + bj * HALF;
                        const void* p0 = (mode == 2) ? (resf ? (const void*)(resf + row * D + col) : (const void*)(io2 + row * D + col)) : (const void*)(ob + row * ldo + col);
                        __builtin_amdgcn_global_load_lds((const unsigned*)p0, (LAS unsigned*)dump, 16, 0, 0);
                        if (mode == 2 && aux) __builtin_amdgcn_global_load_lds((const unsigned*)(aux + row * D + col), (LAS unsigned*)dump, 16, 0, 0);
                    }
        }
#pragma unroll
        for (int aim = 0; aim < 4; ++aim) {
            const int ai = aim >> 1, mh = aim & 1;
            u32x4 L0[4], L1[4];
            if (mode != 0) {
#pragma unroll
                for (int m2 = 0; m2 < 2; ++m2)
#pragma unroll
                    for (int bj = 0; bj < 2; ++bj) {
                        const int m = mh * 2 + m2;
                        const size_t row = (size_t)(row0 + ai * HALF + m * 16); const int col = col0 + bj * HALF, e = m2 * 2 + bj;
                        if (mode == 1) L0[e] = *(const u32x4*)(ob + row * ldo + col);
                        else if (mode == 3) { L0[e] = *(const u32x4*)(ob + row * ldo + col);
                            if (col >= D) L1[e] = *(const u32x4*)(io2 + row * D + (col & (D - 1))); }
                        else { if (resf) { L0[e] = *(const u32x4*)(resf + row * D + col); L1[e] = *(const u32x4*)(resf + row * D + col + 4); }
                               else { L0[e] = *(const u32x4*)(io2 + row * D + col); if (aux) L1[e] = *(const u32x4*)(aux + row * D + col); } }
                    }
            }
#pragma unroll
            for (int m2 = 0; m2 < 2; ++m2)
#pragma unroll
                for (int bj = 0; bj < 2; ++bj) {
                    const int m = mh * 2 + m2;
                    const size_t row = (size_t)(row0 + ai * HALF + m * 16); const int col = col0 + bj * HALF, e = m2 * 2 + bj;
                    float v[8];
#pragma unroll
                    for (int j = 0; j < 4; ++j) { v[j] = acc[ai][bj][m][0][j]; v[4 + j] = acc[ai][bj][m][1][j]; }
                    if (mode == 0) {
                        if (act == 1) {
#pragma unroll
                            for (int j = 0; j < 8; ++j) { const float t = fmaxf(v[j], 0.f); v[j] = t * t; }
                        }
                        *(u32x4*)(ob + row * ldo + col) = pack8(v);
                    } else if (mode == 1) {
                        float a[8]; unpack8(L0[e], a);
#pragma unroll
                        for (int j = 0; j < 8; ++j) v[j] = sigmoidf_(v[j] + bv[bj][j]) * a[j];
                        *(u32x4*)(ob + row * ldo + col) = pack8(v);
                    } else if (mode == 3) {
                        float a[8]; unpack8(L0[e], a);
#pragma unroll
                        for (int j = 0; j < 8; ++j) v[j] = sigmoidf_(v[j] + bv[bj][j]) * a[j];
                        if (col >= D) { float q[8]; unpack8(L1[e], q);
#pragma unroll
                            for (int j = 0; j < 8; ++j) v[j] += q[j]; }
                        *(u32x4*)(io2 + row * D + (col & (D - 1))) = pack8(v);
                    } else {
                        float r[8];
                        if (resf) {
#pragma unroll
                            for (int j = 0; j < 4; ++j) { r[j] = __uint_as_float(L0[e][j]); r[4 + j] = __uint_as_float(L1[e][j]); } }
                        else unpack8(L0[e], r);
#pragma unroll
                        for (int j = 0; j < 8; ++j) v[j] += ALPHA * r[j];
                        if (aux) { float a[8]; unpack8(L1[e], a);
#pragma unroll
                            for (int j = 0; j < 8; ++j) v[j] += a[j]; }
                        *(u32x4*)(io2 + row * D + col) = pack8(v);
                    }
                }
        }
    }
};

__device__ __forceinline__ void gemm_phase(const int tid, LAS unsigned char* lds, const Gemm g, const StaticOrder& S, const Epi& E) {
    const int wid = __builtin_amdgcn_readfirstlane(tid >> 6), lane = tid & 63, wr = wid >> 2, wc = wid & 3, fr = lane & 15, fq = lane >> 4;
    const int K = g.K, nt = K / BK;
    unsigned voffA, voffB;
    { int R, C; stage_rc(tid * 16, R, C); const int Rb = (R & ~31) + perm32(R & 31); voffA = (unsigned)(R * g.lda + C) * 2u; voffB = (unsigned)(Rb * g.ldb + C) * 2u; }
    const size_t p2A = (size_t)64 * g.lda * 2, p2B = (size_t)64 * g.ldb * 2;
    const size_t kstep = (size_t)(BK * 2);
    const size_t hstepA = (size_t)HALF * g.lda * 2, hstepB = (size_t)HALF * g.ldb * 2;
    const size_t tstepA = 2 * hstepA, tstepB = 2 * hstepB;
    const unsigned ldsw = (unsigned)wid * 1024u;
    const int aoff = lds_byte(wr * 64 + fr, fq * 8), boff = lds_byte(wc * 32 + fr, fq * 8);
#define XA voffA
#define XB voffB
#define p2XA p2A
#define p2XB p2B
#define PG8_SA(b, h) (((b) * 2 + (h)) * HTB)
#define PG8_SB(b, h) ((4 + (b) * 2 + (h)) * HTB)
#define PG8_STAGE(bufoff, gbase, voff) do { \
        __builtin_amdgcn_global_load_lds((const unsigned*)((const char*)(gbase) + (voff)), (LAS unsigned*)(lds + (bufoff) + ldsw), 16, 0, 0); \
        __builtin_amdgcn_global_load_lds((const unsigned*)((const char*)(gbase) + p2##voff + (voff)), (LAS unsigned*)(lds + (bufoff) + ldsw + 8192), 16, 0, 0); } while (0)
#define PG8_LDA(dst, b, h) do { _Pragma("unroll") for (int m = 0; m < 4; ++m) _Pragma("unroll") for (int k = 0; k < 2; ++k) dst[m][k] = *(const LAS bf16x8*)(lds + PG8_SA(b, h) + aoff + m * 2048 + k * 1024); } while (0)
#define PG8_LDB(dst, b, h) do { _Pragma("unroll") for (int n = 0; n < 2; ++n) _Pragma("unroll") for (int k = 0; k < 2; ++k) dst[n][k] = *(const LAS bf16x8*)(lds + PG8_SB(b, h) + boff + n * 2048 + k * 1024); } while (0)
#define PG8_MMA(ai, bj, At, Bt) do { __builtin_amdgcn_s_setprio(1); _Pragma("unroll") for (int m = 0; m < 4; ++m) _Pragma("unroll") for (int n = 0; n < 2; ++n) _Pragma("unroll") for (int k = 0; k < 2; ++k) \
        acc[ai][bj][m][n] = __builtin_amdgcn_mfma_f32_16x16x32_bf16(Bt[n][k], At[m][k], acc[ai][bj][m][n], 0, 0, 0); __builtin_amdgcn_s_setprio(0); } while (0)
#define PG8_WAIT_V(n) asm volatile("s_waitcnt vmcnt(" #n ")" ::: "memory")
#define PG8_WAIT_L(n) asm volatile("s_waitcnt lgkmcnt(" #n ")" ::: "memory")
#define PG8_BAR __builtin_amdgcn_s_barrier()
#define PG8_SCHED __builtin_amdgcn_sched_barrier(0)
    Unit cur, nxt; int ui = 0;
    if (!S.next(0, cur)) return;
    f32x4 acc[2][2][4][2];
    bf16x8 At[4][2], B0[2][2], B1[2][2];
    const char* cA = (const char*)g.A + (size_t)cur.pm * tstepA; const char* cB = (const char*)g.Bt + (size_t)cur.pn * tstepB;
    PG8_STAGE(PG8_SB(0, 0), cB, XB); PG8_STAGE(PG8_SB(0, 1), cB + hstepB, XB); PG8_STAGE(PG8_SA(0, 0), cA, XA); PG8_STAGE(PG8_SA(0, 1), cA + hstepA, XA);
    if (wr == 1) PG8_BAR;
    PG8_WAIT_V(2); PG8_BAR;
    PG8_STAGE(PG8_SB(1, 0), cB + kstep, XB); PG8_STAGE(PG8_SA(1, 0), cA + kstep, XA); PG8_STAGE(PG8_SB(1, 1), cB + hstepB + kstep, XB);
    PG8_WAIT_V(6); PG8_BAR;
    PG8_SCHED;
#pragma unroll
    for (int a = 0; a < 2; ++a)
#pragma unroll
        for (int b = 0; b < 2; ++b)
#pragma unroll
            for (int m = 0; m < 4; ++m)
#pragma unroll
                for (int n = 0; n < 2; ++n) acc[a][b][m][n] = (f32x4){0.f, 0.f, 0.f, 0.f};
    for (;;) {
        const bool has_next = S.next(ui + 1, nxt);
        const char* nA = has_next ? (const char*)g.A + (size_t)nxt.pm * tstepA : cA; const char* nB = has_next ? (const char*)g.Bt + (size_t)nxt.pn * tstepB : cB;
        for (int t = 0; t < nt; t += 2) {
            const bool last = (t == nt - 2);
            const char* a1 = cA + (size_t)(t + 1) * kstep;
            const char* a2 = last ? nA : cA + (size_t)(t + 2) * kstep; const char* b2 = last ? nB : cB + (size_t)(t + 2) * kstep;
            const char* a3 = a2 + kstep; const char* b3 = b2 + kstep;
            PG8_LDB(B0, 0, 0); PG8_LDB(B1, 0, 1); PG8_SCHED; PG8_LDA(At, 0, 0); PG8_STAGE(PG8_SA(1, 1), a1 + hstepA, XA);
            PG8_WAIT_V(8); PG8_WAIT_L(0); PG8_BAR; PG8_MMA(0, 0, At, B0); PG8_MMA(0, 1, At, B1); PG8_BAR; PG8_SCHED;
            PG8_LDA(At, 0, 1); PG8_STAGE(PG8_SB(0, 0), b2, XB); PG8_STAGE(PG8_SB(0, 1), b2 + hstepB, XB); PG8_STAGE(PG8_SA(0, 0), a2, XA);
            PG8_WAIT_V(8); PG8_WAIT_L(0); PG8_BAR; PG8_MMA(1, 0, At, B0); PG8_MMA(1, 1, At, B1); PG8_BAR; PG8_SCHED;
            PG8_LDB(B0, 1, 0); PG8_LDB(B1, 1, 1); PG8_SCHED; PG8_LDA(At, 1, 0); PG8_STAGE(PG8_SA(0, 1), a2 + hstepA, XA);
            PG8_WAIT_V(8); PG8_WAIT_L(0); PG8_BAR; PG8_MMA(0, 0, At, B0); PG8_MMA(0, 1, At, B1); PG8_BAR; PG8_SCHED;
            PG8_LDA(At, 1, 1); PG8_STAGE(PG8_SB(1, 0), b3, XB); PG8_STAGE(PG8_SB(1, 1), b3 + hstepB, XB); PG8_STAGE(PG8_SA(1, 0), a3, XA);
            PG8_WAIT_V(8); PG8_WAIT_L(0); PG8_BAR; PG8_MMA(1, 0, At, B0); PG8_MMA(1, 1, At, B1); PG8_BAR; PG8_SCHED;
        }
        if (wr == 0) PG8_BAR;
        E(acc, cur, wr, wc, fr, fq, lds + 131088 + ldsw);
        if (!has_next) break;
#pragma unroll
        for (int a = 0; a < 2; ++a)
#pragma unroll
            for (int b = 0; b < 2; ++b)
#pragma unroll
                for (int m = 0; m < 4; ++m)
#pragma unroll
                    for (int n = 0; n < 2; ++n) acc[a][b][m][n] = (f32x4){0.f, 0.f, 0.f, 0.f};
        cur = nxt; cA = nA; cB = nB; ++ui;
        if (wr == 1) PG8_BAR;
    }
    PG8_WAIT_V(0);
    PG8_BAR;
#undef PG8_SA
#undef PG8_SB
#undef PG8_STAGE
#undef PG8_LDA
#undef PG8_LDB
#undef PG8_MMA
#undef PG8_WAIT_V
#undef PG8_WAIT_L
#undef PG8_BAR
#undef PG8_SCHED
}
}

#define LDS_BARRIER() do { asm volatile("s_waitcnt lgkmcnt(0)" ::: "memory"); __builtin_amdgcn_s_barrier(); asm volatile("" ::: "memory"); } while (0)

__device__ __forceinline__ void tconv(const int tid_, const int bid_, const int gdim_, float* tile, const float* __restrict__ src, int K, int N, bf16_t* __restrict__ dst, int ldd) {
    const int tn = N / 64, nt = (K / 64) * tn;
    const int r = tid_ >> 3, c = (tid_ & 7) * 8;
    int t = bid_;
    f32x4 a, b;
    if (t < nt) { const f32x4* s = (const f32x4*)(src + (size_t)((t / tn) * 64 + r) * N + (t % tn) * 64 + c); a = s[0]; b = s[1]; }
    for (; t < nt; t += gdim_) {
        const int k0 = (t / tn) * 64, n0 = (t % tn) * 64;
#pragma unroll
        for (int j = 0; j < 4; ++j) { tile[r * 65 + c + j] = a[j]; tile[r * 65 + c + 4 + j] = b[j]; }
        const int t2 = t + gdim_;
        if (t2 < nt) { const f32x4* s = (const f32x4*)(src + (size_t)((t2 / tn) * 64 + r) * N + (t2 % tn) * 64 + c); a = s[0]; b = s[1]; }
        LDS_BARRIER();
        float v[8];
#pragma unroll
        for (int j = 0; j < 8; ++j) v[j] = tile[(c + j) * 65 + r];
        *(u32x4*)(dst + (size_t)(n0 + r) * ldd + k0 + c) = pack8(v);
        LDS_BARRIER();
    }
}
__device__ __forceinline__ void econv(const int tid_, const int bid_, const int gdim_, const float* __restrict__ src, bf16_t* __restrict__ dst, size_t n) {
    const size_t nth = (size_t)gdim_ * 512;
    for (size_t i = ((size_t)bid_ * 512 + tid_) * 8; i < n; i += nth * 8) {
        const f32x4 a = *(const f32x4*)(src + i), b = *(const f32x4*)(src + i + 4);
        float v[8] = {a[0], a[1], a[2], a[3], b[0], b[1], b[2], b[3]};
        *(u32x4*)(dst + i) = pack8(v);
    }
}

__device__ __forceinline__ void ln_phase(const int tid_, const int bid_, const int gdim_, bf16_t* xio, const float* __restrict__ g, const float* __restrict__ b, float* outf) {
    const int lane = tid_ & 63, wid = tid_ >> 6;
    const int nw = gdim_ * 8;
    float gg[16], bb[16];
#pragma unroll
    for (int i = 0; i < 2; ++i)
#pragma unroll
        for (int j = 0; j < 8; ++j) { gg[i * 8 + j] = g[i * 512 + lane * 8 + j]; bb[i * 8 + j] = b[i * 512 + lane * 8 + j]; }
    for (int row = bid_ * 8 + wid; row < MTOK; row += nw) {
        bf16_t* p = xio + (size_t)row * D + lane * 8;
        float v[16]; unpack8(*(const u32x4*)p, v); unpack8(*(const u32x4*)(p + 512), v + 8);
        float s = 0.f;
#pragma unroll
        for (int j = 0; j < 16; ++j) s += v[j];
        const float mean = wave_sum(s) * (1.0f / D);
        float q = 0.f;
#pragma unroll
        for (int j = 0; j < 16; ++j) { const float d = v[j] - mean; q += d * d; }
        const float rstd = __builtin_amdgcn_rsqf(wave_sum(q) * (1.0f / D) + LN_EPS);
#pragma unroll
        for (int j = 0; j < 16; ++j) v[j] = (v[j] - mean) * rstd * gg[j] + bb[j];
        if (!outf) { *(u32x4*)p = pack8(v); *(u32x4*)(p + 512) = pack8(v + 8); }
        else { float* o = outf + (size_t)row * D + lane * 8;
            *(f32x4*)o = (f32x4){v[0], v[1], v[2], v[3]}; *(f32x4*)(o + 4) = (f32x4){v[4], v[5], v[6], v[7]};
            *(f32x4*)(o + 512) = (f32x4){v[8], v[9], v[10], v[11]}; *(f32x4*)(o + 516) = (f32x4){v[12], v[13], v[14], v[15]}; }
    }
}

__device__ __forceinline__ void sconv_phase(const int tid_, const int bid_, const int gdim_, const bf16_t* __restrict__ h, const float* __restrict__ w  , bf16_t* __restrict__ yb) {
    const size_t nth = (size_t)gdim_ * 512;
    for (size_t idx = (size_t)bid_ * 512 + tid_; idx < (size_t)MTOK * 64; idx += nth) {
        const int tok = (int)(idx >> 6), c8 = (int)(idx & 63) * 8, t = tok & (SEQ - 1);
        float acc[8];
#pragma unroll
        for (int j = 0; j < 8; ++j) acc[j] = 0.f;
#pragma unroll
        for (int k = 0; k < 3; ++k) {
            const int tt = t - 2 + k;
            if (tt >= 0) {
                const bf16_t* row = h + (size_t)(tok - 2 + k) * INC + COL_B;
                float cgv[8], xh[8]; unpack8(*(const u32x4*)(row + 512 + c8), cgv); unpack8(*(const u32x4*)(row + 1024 + c8), xh);
                const f32x4 w0 = *(const f32x4*)(w + k * 512 + c8), w1 = *(const f32x4*)(w + k * 512 + c8 + 4);
#pragma unroll
                for (int j = 0; j < 4; ++j) { acc[j] += w0[j] * (cgv[j] * xh[j]); acc[4 + j] += w1[j] * (cgv[4 + j] * xh[4 + j]); }
            }
        }
        float bg[8]; unpack8(*(const u32x4*)(h + (size_t)tok * INC + COL_B + c8), bg);
#pragma unroll
        for (int j = 0; j < 8; ++j) acc[j] *= bg[j];
        *(u32x4*)(yb + (size_t)tok * DMIX + c8) = pack8(acc);
    }
}

__device__ __forceinline__ void vtrans_phase(const int tid_, const int bid_, const int gdim_, bf16_t* tile  , const bf16_t* __restrict__ h, bf16_t* __restrict__ vt) {
    const int r = tid_ >> 3, c = (tid_ & 7) * 8;
    int it = bid_;
    u32x4 u;
    if (it < BATCH * 8 * 32) { const int bh = it >> 5, tc = it & 31; u = *(const u32x4*)(h + (size_t)((bh >> 3) * SEQ + tc * 64 + r) * INC + COL_D + 1024 + (bh & 7) * 64 + c); }
    for (; it < BATCH * 8 * 32; it += gdim_) {
        const int bh = it >> 5, tc = it & 31;
#pragma unroll
        for (int j = 0; j < 4; ++j) { tile[(c + 2 * j) * 72 + r] = (bf16_t)(u[j] & 0xffffu); tile[(c + 2 * j + 1) * 72 + r] = (bf16_t)(u[j] >> 16); }
        const int i2 = it + gdim_;
        if (i2 < BATCH * 8 * 32) { const int bh2 = i2 >> 5, tc2 = i2 & 31; u = *(const u32x4*)(h + (size_t)((bh2 >> 3) * SEQ + tc2 * 64 + r) * INC + COL_D + 1024 + (bh2 & 7) * 64 + c); }
        LDS_BARRIER();
        *(u32x4*)(vt + (size_t)(bh * 64 + r) * SEQ + tc * 64 + c) = *(const u32x4*)(tile + r * 72 + c);
        LDS_BARRIER();
    }
}

__device__ __forceinline__ void attn_phase(const int tid_, const int bid_, const int gdim_, unsigned char* ldsb, const bf16_t* __restrict__ h, const bf16_t* __restrict__ vt, const float* __restrict__ rel_bias, bf16_t* __restrict__ yd) {
    constexpr float L2E = 1.4426950408889634f;
    float* rb = (float*)(ldsb + 131088);
    for (int i = tid_; i < 8 * 257; i += 512) rb[i] = rel_bias[i] * L2E;
    __syncthreads();
    const int lane = tid_ & 63, wid = __builtin_amdgcn_readfirstlane(tid_ >> 6), lr = lane & 15, quad = lane >> 4;
    const int nw = gdim_ * 8;
    unsigned char* wl = ldsb + wid * 16384;
    const int krow = lane >> 3, kchunk = (lane & 7) ^ (krow & 7);
    const int vrow = lane >> 2, vchunk = (lane & 3) ^ ((vrow >> 2) & 3);
    int koff[2][2], voff[4];
#pragma unroll
    for (int tt = 0; tt < 2; ++tt)
#pragma unroll
        for (int dh = 0; dh < 2; ++dh) { const int row = (lr >> 2) * 8 + tt * 4 + (lr & 3); koff[tt][dh] = row * 128 + (((dh * 4 + quad) ^ (row & 7)) * 16); }
#pragma unroll
    for (int dt = 0; dt < 4; ++dt) { const int d = dt * 16 + lr; voff[dt] = 4096 + d * 64 + ((quad ^ ((d >> 2) & 3)) * 16); }
    int it = 0;
    const int vbid = (bid_ & 7) * (gdim_ >> 3) + (bid_ >> 3);
    for (int item0 = vbid * 8 + wid; item0 < BATCH * 8 * 32; item0 += nw, ++it) {
        const int c = ((item0 & 31) + 8 * it) & 31, hh = (item0 >> 5) & 7, b = item0 >> 8;
        const int q0 = c * 64;
        const bf16_t* hb = h + (size_t)b * SEQ * INC + COL_D + hh * 64;
        bf16x8 qf[4][2];
        asm volatile("s_waitcnt lgkmcnt(0)" ::: "memory");
        {
            const bf16_t* qg = hb + (size_t)(q0 + krow) * INC + kchunk * 8;
#pragma unroll
            for (int i = 0; i < 8; ++i) __builtin_amdgcn_global_load_lds((const unsigned*)(qg + (size_t)i * 8 * INC), (LAS unsigned*)(wl + 8192 + i * 1024), 16, 0, 0);
        }
        const bf16_t* vb = vt + (size_t)((b * 8 + hh) * 64) * SEQ;
        const float* rbh = rb + hh * 257;
        const float cb2 = rbh[256];
        f32x4 oacc[4][4];
#pragma unroll
        for (int qi = 0; qi < 4; ++qi)
#pragma unroll
            for (int dt = 0; dt < 4; ++dt) oacc[qi][dt] = (f32x4){0.f, 0.f, 0.f, 0.f};
        float mrun[4] = {-1e30f, -1e30f, -1e30f, -1e30f}, lsum[4] = {0.f, 0.f, 0.f, 0.f};
        const int kstart = (c > 8 ? c - 8 : 0) * 64, kend = c * 64 + 64;
        const bf16_t* kg = hb + 512 + (size_t)krow * INC + kchunk * 8;
        const bf16_t* vg = vb + (size_t)vrow * SEQ + vchunk * 8;
#define AT_LOAD(buf, kt) do { _Pragma("unroll") for (int i = 0; i < 4; ++i) \
                __builtin_amdgcn_global_load_lds((const unsigned*)(kg + (size_t)((kt) + i * 8) * INC), (LAS unsigned*)(wl + (buf) * 8192 + i * 1024), 16, 0, 0); \
            _Pragma("unroll") for (int i = 0; i < 4; ++i) \
                __builtin_amdgcn_global_load_lds((const unsigned*)(vg + (size_t)i * 16 * SEQ + (kt)), (LAS unsigned*)(wl + (buf) * 8192 + 4096 + i * 1024), 16, 0, 0); } while (0)
#define AT_COMPUTE(buf, kt) do { \
            const bool far_ = ((kt) + 31 + 128 <= q0); \
            const unsigned char* bb_ = wl + (buf) * 8192; \
            bf16x8 kf[2][2], vf[4]; \
            _Pragma("unroll") for (int tt = 0; tt < 2; ++tt) _Pragma("unroll") for (int dh = 0; dh < 2; ++dh) kf[tt][dh] = *(const bf16x8*)(bb_ + koff[tt][dh]); \
            _Pragma("unroll") for (int dt = 0; dt < 4; ++dt) vf[dt] = *(const bf16x8*)(bb_ + voff[dt]); \
            _Pragma("unroll") for (int qi = 0; qi < 4; ++qi) { \
                f32x4 s[2]; \
                _Pragma("unroll") for (int tt = 0; tt < 2; ++tt) { f32x4 a = (f32x4){0.f, 0.f, 0.f, 0.f}; \
                    a = __builtin_amdgcn_mfma_f32_16x16x32_bf16(kf[tt][0], qf[qi][0], a, 0, 0, 0); \
                    a = __builtin_amdgcn_mfma_f32_16x16x32_bf16(kf[tt][1], qf[qi][1], a, 0, 0, 0); s[tt] = a; } \
                float mx = -1e30f; \
                if (far_) { _Pragma("unroll") for (int tt = 0; tt < 2; ++tt) _Pragma("unroll") for (int j = 0; j < 4; ++j) { const float v = s[tt][j] * (0.125f * L2E) + cb2; s[tt][j] = v; mx = fmaxf(mx, v); } } \
                else { const int qpos = q0 + qi * 16 + lr; float bz[8]; \
                    _Pragma("unroll") for (int tt = 0; tt < 2; ++tt) _Pragma("unroll") for (int j = 0; j < 4; ++j) { \
                        int rel = qpos - ((kt) + quad * 8 + tt * 4 + j); rel = rel > 128 ? 128 : (rel < -128 ? -128 : rel); bz[tt * 4 + j] = rbh[rel + 128]; } \
                    _Pragma("unroll") for (int tt = 0; tt < 2; ++tt) _Pragma("unroll") for (int j = 0; j < 4; ++j) { \
                        const float v = s[tt][j] * (0.125f * L2E) + bz[tt * 4 + j]; s[tt][j] = v; mx = fmaxf(mx, v); } } \
                mx = fmaxf(mx, shflx(mx, lane, 16)); mx = fmaxf(mx, shflx(mx, lane, 32)); \
                const float mnew = fmaxf(mrun[qi], mx), sc = __builtin_amdgcn_exp2f(mrun[qi] - mnew); \
                mrun[qi] = mnew; \
                float ps = 0.f; float pv[8]; \
                _Pragma("unroll") for (int tt = 0; tt < 2; ++tt) _Pragma("unroll") for (int j = 0; j < 4; ++j) { const float p = __builtin_amdgcn_exp2f(s[tt][j] - mnew); pv[tt * 4 + j] = p; ps += p; } \
                lsum[qi] = lsum[qi] * sc + ps; \
                const u32x4 pu = pack8(pv); bf16x8 pf; __builtin_memcpy(&pf, &pu, 16); \
                _Pragma("unroll") for (int dt = 0; dt < 4; ++dt) { \
                    f32x4 o = oacc[qi][dt]; \
                    _Pragma("unroll") for (int j = 0; j < 4; ++j) o[j] *= sc; \
                    oacc[qi][dt] = __builtin_amdgcn_mfma_f32_16x16x32_bf16(vf[dt], pf, o, 0, 0, 0); } \
            } } while (0)
        AT_LOAD(0, kstart);
        asm volatile("s_waitcnt vmcnt(8)" ::: "memory");
#pragma unroll
        for (int qi = 0; qi < 4; ++qi)
#pragma unroll
            for (int dh = 0; dh < 2; ++dh) { const int row = qi * 16 + lr; qf[qi][dh] = *(const bf16x8*)(wl + 8192 + row * 128 + (((dh * 4 + quad) ^ (row & 7)) * 16)); }
        asm volatile("s_waitcnt lgkmcnt(0)" ::: "memory");
        for (int kt0 = kstart; kt0 < kend; kt0 += 64) {
            AT_LOAD(1, kt0 + 32);
            asm volatile("s_waitcnt vmcnt(8)" ::: "memory");
            AT_COMPUTE(0, kt0);
            if (kt0 + 64 < kend) { AT_LOAD(0, kt0 + 64); asm volatile("s_waitcnt vmcnt(8)" ::: "memory"); }
            else asm volatile("s_waitcnt vmcnt(0)" ::: "memory");
            AT_COMPUTE(1, kt0 + 32);
        }
#undef AT_LOAD
#undef AT_COMPUTE
#pragma unroll
        for (int qi = 0; qi < 4; ++qi) {
            float l = lsum[qi]; l += shflx(l, lane, 16); l += shflx(l, lane, 32);
            const float inv = __builtin_amdgcn_rcpf(l);
#pragma unroll
            for (int dt = 0; dt < 4; ++dt) {
                u32x2 pk; pk[0] = cvt_pk_bf16(oacc[qi][dt][0] * inv, oacc[qi][dt][1] * inv); pk[1] = cvt_pk_bf16(oacc[qi][dt][2] * inv, oacc[qi][dt][3] * inv);
                *(u32x2*)(wl + (qi * 16 + lr) * 136 + (dt * 16 + quad * 4) * 2) = pk;
            }
        }
        asm volatile("" ::: "memory");
#pragma unroll
        for (int i = 0; i < 8; ++i) {
            const int row = i * 8 + krow;
            *(u32x4*)(yd + (size_t)(b * SEQ + q0 + row) * DMIX + hh * 64 + (lane & 7) * 8) = *(const u32x4*)(wl + row * 136 + (lane & 7) * 16);
        }
    }
    __syncthreads();
}

__device__ __forceinline__ void lru_phase(const int tid_, const int bid_, const int gdim_, unsigned char* lds, const bf16_t* __restrict__ h, const float* __restrict__ conv_w, const float* __restrict__ conv_b,
                          const float* __restrict__ wrp, const float* __restrict__ brp, const float* __restrict__ wip, const float* __restrict__ bip,
                          const float* __restrict__ lam, bf16_t* __restrict__ ya_out) {
    bf16_t* WrT = (bf16_t*)lds;
    bf16_t* WiT = WrT + 64 * 72;
    bf16_t* xcb = WiT + 64 * 72;
    bf16_t* xraw = xcb + 64 * 72;
    bf16_t* yraw = xraw + 67 * 64 + 64;
    float* xcf = (float*)(yraw + 64 * 64);
    float* abuf = xcf + 4096;
    float* ubuf = abuf + 4096;
    float* ibuf = ubuf + 4096;
    float* hbuf = ibuf + 4096;
    float* gbuf = xcf;
    const int tid = tid_, lane = tid & 63, wid = tid >> 6, lr = lane & 15, quad = lane >> 4;
    for (int item = bid_; item < BATCH * 8; item += gdim_) {
        const int b = item >> 3, g = item & 7;
        __syncthreads();
        for (int e = tid; e < 4096; e += 512) { const int i = e >> 6, j = e & 63;
            WrT[j * 72 + i] = f2bf(wrp[(size_t)g * 4096 + e]); WiT[j * 72 + i] = f2bf(wip[(size_t)g * 4096 + e]); }
        const int ch = tid & 63, trow = tid >> 6;
        const int cg_ = g * 64 + ch;
        const float cw0 = conv_w[cg_], cw1 = conv_w[512 + cg_], cw2 = conv_w[1024 + cg_], cw3 = conv_w[1536 + cg_], cb = conv_b[cg_];
        const int r8 = tid >> 3, pc = (tid & 7) * 8;
        const bf16_t* hrow = h + (size_t)(b * SEQ + r8) * INC + COL_A + g * 64 + pc;
        u32x4 xa16 = *(const u32x4*)hrow, ya16 = *(const u32x4*)(hrow + 512), prev16 = (u32x4){0u, 0u, 0u, 0u};
        float hstate = 0.f;
        for (int tc = 0; tc < SEQ / 64; ++tc) {
            const int t0 = tc * 64;
            *(u32x4*)(xraw + (3 + r8) * 64 + pc) = xa16; *(u32x4*)(yraw + r8 * 64 + pc) = ya16;
            if (r8 >= 61) *(u32x4*)(xraw + (r8 - 61) * 64 + pc) = prev16;
            prev16 = xa16;
            if (tc + 1 < SEQ / 64) { const bf16_t* nx = hrow + (size_t)(t0 + 64) * INC; xa16 = *(const u32x4*)nx; ya16 = *(const u32x4*)(nx + 512); }
            LDS_BARRIER();
#pragma unroll
            for (int i = 0; i < 8; ++i) {
                const int tl = trow + 8 * i;
                const float x3 = bf2f(xraw[tl * 64 + ch]), x2 = bf2f(xraw[(tl + 1) * 64 + ch]), x1 = bf2f(xraw[(tl + 2) * 64 + ch]), x0 = bf2f(xraw[(tl + 3) * 64 + ch]);
                const float xc = cw3 * x0 + cw2 * x1 + cw1 * x2 + cw0 * x3 + cb;
                xcf[tl * 64 + ch] = xc; xcb[tl * 72 + ch] = f2bf(xc);
            }
            LDS_BARRIER();
            {
                const int tt = wid & 3, which = wid >> 2;
                const bf16_t* WT = which ? WiT : WrT;
                const bf16x8 a0 = *(const bf16x8*)(xcb + (tt * 16 + lr) * 72 + quad * 8), a1 = *(const bf16x8*)(xcb + (tt * 16 + lr) * 72 + 32 + quad * 8);
#pragma unroll
                for (int jt = 0; jt < 4; ++jt) {
                    const bf16x8 b0 = *(const bf16x8*)(WT + (jt * 16 + lr) * 72 + quad * 8), b1 = *(const bf16x8*)(WT + (jt * 16 + lr) * 72 + 32 + quad * 8);
                    f32x4 cacc = (f32x4){0.f, 0.f, 0.f, 0.f};
                    cacc = __builtin_amdgcn_mfma_f32_16x16x32_bf16(a0, b0, cacc, 0, 0, 0);
                    cacc = __builtin_amdgcn_mfma_f32_16x16x32_bf16(a1, b1, cacc, 0, 0, 0);
                    const int j = jt * 16 + lr, cj = g * 64 + j;
                    if (which == 0) {
                        const float bias = brp[cj], lm = lam[cj];
                        const float sp = fmaxf(-lm, 0.f) + flog1p_small(fexp(-fabsf(lm)));
#pragma unroll
                        for (int jj = 0; jj < 4; ++jj) {
                            const int tl = tt * 16 + quad * 4 + jj;
                            const float r = sigmoidf_(cacc[jj] + bias);
                            const float la = -8.0f * r * sp;
                            abuf[tl * 64 + j] = fexp(la);
                            ubuf[tl * 64 + j] = __builtin_amdgcn_sqrtf(fneg_expm1(2.0f * la)) * xcf[tl * 64 + j];
                        }
                    } else {
                        const float bias = bip[cj];
#pragma unroll
                        for (int jj = 0; jj < 4; ++jj) { const int tl = tt * 16 + quad * 4 + jj; ibuf[tl * 64 + j] = sigmoidf_(cacc[jj] + bias); }
                    }
                }
            }
            LDS_BARRIER();
            if (wid == 0) {
#pragma unroll 8
                for (int tl = 0; tl < 64; ++tl) { hstate = abuf[tl * 64 + lane] * hstate + ubuf[tl * 64 + lane] * ibuf[tl * 64 + lane]; hbuf[tl * 64 + lane] = hstate; }
            } else {
                for (int e = tid - 64; e < 4096; e += 448) {
                    const float y = bf2f(yraw[e]);
                    gbuf[e] = 0.5f * y * (1.0f + ftanh(0.7978845608028654f * (y + 0.044715f * y * y * y)));
                }
            }
            LDS_BARRIER();
            {
                float o[8];
                const f32x4 h0 = *(const f32x4*)(hbuf + r8 * 64 + pc), h1 = *(const f32x4*)(hbuf + r8 * 64 + pc + 4);
                const f32x4 g0 = *(const f32x4*)(gbuf + r8 * 64 + pc), g1 = *(const f32x4*)(gbuf + r8 * 64 + pc + 4);
#pragma unroll
                for (int j = 0; j < 4; ++j) { o[j] = h0[j] * g0[j]; o[4 + j] = h1[j] * g1[j]; }
                *(u32x4*)(ya_out + (size_t)(b * SEQ + t0 + r8) * DMIX + g * 64 + pc) = pack8(o);
            }
        }
    }
    __syncthreads();
}

constexpr int RT = 16, REC = 456;
__device__ __forceinline__ float dpp_x1(float v) { return __int_as_float(__builtin_amdgcn_update_dpp(0, __float_as_int(v), 0xB1, 0xF, 0xF, true)); }
__device__ __forceinline__ float dpp_x2(float v) { return __int_as_float(__builtin_amdgcn_update_dpp(0, __float_as_int(v), 0x4E, 0xF, 0xF, true)); }
__device__ __forceinline__ void rwkv_phase(const int tid_, const int bid_, const int gdim_, unsigned char* lds, const bf16_t* __restrict__ h, const float* __restrict__ mu, const float* __restrict__ w0p, const float* __restrict__ w2p,
                           const float* __restrict__ a0p, const float* __restrict__ a2p, const float* __restrict__ g2p, const float* __restrict__ kkp, const float* __restrict__ kap,
                           const float* __restrict__ rkp, const float* __restrict__ gng, const float* __restrict__ gnb, bf16_t* __restrict__ yc) {
    bf16_t* W2T = (bf16_t*)lds;
    bf16_t* A2T = W2T + 64 * 72;
    bf16_t* G2T = A2T + 64 * 72;
    bf16_t* linb = G2T + 64 * 136;
    float* lo = (float*)(linb + 4 * 4 * 264);
    float* rec = lo + 4 * 4 * 192;
    float* obuf = rec + 2 * RT * REC;
    const int tid = tid_, lane = tid & 63, wid = __builtin_amdgcn_readfirstlane(tid >> 6);
    constexpr int NC = SEQ / RT;
    for (int item = bid_; item < BATCH * 8; item += gdim_) {
        const int b = item >> 3, hh = item & 7, hj = hh * 64 + lane;
        __syncthreads();
        for (int e = tid; e < 4096; e += 512) { const int i = e >> 6, j = e & 63; W2T[j * 72 + i] = f2bf(w2p[i * 512 + hh * 64 + j]); A2T[j * 72 + i] = f2bf(a2p[i * 512 + hh * 64 + j]); }
        for (int e = tid; e < 8192; e += 512) { const int i = e >> 6, j = e & 63; G2T[j * 136 + i] = f2bf(g2p[i * 512 + hh * 64 + j]); }
        __syncthreads();
        if (wid < 4) {
            const int r = lane >> 2, kq = lane & 3, row = wid * 16 + r;
            f32x2 S[8];
#pragma unroll
            for (int i = 0; i < 8; ++i) S[i] = (f32x2){0.f, 0.f};
            LDS_BARRIER();
            for (int c = 0; c < NC; ++c) {
                const float* R0 = rec + (c & 1) * RT * REC + kq * 16;
                float* ob = obuf + (c & 1) * RT * 64 + row;
                f32x4 dt[2][8], up[2][12]; float vv[2]; f32x2 scs[2];
#define RW_LOAD(buf, t) do { const float* Rk = R0 + (t) * REC; _Pragma("unroll") for (int i = 0; i < 4; ++i) { dt[buf][i] = *(const f32x4*)(Rk + 4 * i); dt[buf][4 + i] = *(const f32x4*)(Rk + 64 + 4 * i); } \
                    vv[buf] = Rk[320 - kq * 16 + row]; scs[buf] = *(const f32x2*)(Rk + 448 - kq * 16); \
                    _Pragma("unroll") for (int q = 0; q < 3; ++q) _Pragma("unroll") for (int i = 0; i < 4; ++i) up[buf][q * 4 + i] = *(const f32x4*)(Rk + 128 + q * 64 + 4 * i); } while (0)
                RW_LOAD(0, 0);
#pragma unroll
                for (int t = 0; t < RT; ++t) {
                    const int cb = t & 1;
                    if (t + 1 < RT) RW_LOAD(cb ^ 1, t + 1);
                    const float vval = vv[cb];
                    f32x2 sa0 = (f32x2){0.f, 0.f}, sa1 = (f32x2){0.f, 0.f}, yp0 = (f32x2){0.f, 0.f}, yp1 = (f32x2){0.f, 0.f};
#pragma unroll
                    for (int i = 0; i < 4; ++i) {
                        const f32x4 ah = dt[cb][i], wr = dt[cb][4 + i];
                        sa0 += S[2 * i] * (f32x2){ah[0], ah[1]}; sa1 += S[2 * i + 1] * (f32x2){ah[2], ah[3]};
                        yp0 += S[2 * i] * (f32x2){wr[0], wr[1]}; yp1 += S[2 * i + 1] * (f32x2){wr[2], wr[3]};
                    }
                    sa0 += sa1; yp0 += yp1;
                    float sa = sa0[0] + sa0[1], yp = yp0[0] + yp0[1];
                    sa += dpp_x1(sa); yp += dpp_x1(yp);
                    sa += dpp_x2(sa); yp += dpp_x2(yp);
                    if (kq == 0) ob[t * 64] = yp + sa * scs[cb][0] + vval * scs[cb][1];
                    const f32x2 sav = (f32x2){sa, sa}, vvv = (f32x2){vval, vval};
#pragma unroll
                    for (int i = 0; i < 4; ++i) {
                        const f32x4 dc = up[cb][i], bb = up[cb][4 + i], kp = up[cb][8 + i];
                        S[2 * i] = S[2 * i] * (f32x2){dc[0], dc[1]} + sav * (f32x2){bb[0], bb[1]} + vvv * (f32x2){kp[0], kp[1]};
                        S[2 * i + 1] = S[2 * i + 1] * (f32x2){dc[2], dc[3]} + sav * (f32x2){bb[2], bb[3]} + vvv * (f32x2){kp[2], kp[3]};
                    }
                }
#undef RW_LOAD
                LDS_BARRIER();
            }
        } else {
            const int p = wid - 4, lr = lane & 15, quad = lane >> 4;
            bf16_t* lb = linb + p * 4 * 264;
            float* lop = lo + p * 4 * 192;
            const float mu_r = mu[hj], mu_k = mu[512 + hj], mu_v = mu[1024 + hj];
            float mu_l[4];
#pragma unroll
            for (int q = 0; q < 4; ++q) mu_l[q] = mu[1536 + lane + 64 * q];
            const float w0 = w0p[hj], a0 = a0p[hj], k_k = kkp[hj], k_a = kap[hj], r_k = rkp[hj], gn_g = gng[hj], gn_b = gnb[hj];
            const bf16_t* hC = h + (size_t)b * SEQ * INC + COL_C;
            unsigned zraw[5][7];
#define RW_GLOAD(cn) do { _Pragma("unroll") for (int rw = 0; rw < 5; ++rw) { const int t = (cn) * RT + p * 4 + rw - 1; \
                    const bf16_t* ptr = hC + (size_t)(t < 0 ? 0 : t) * INC; \
                    zraw[rw][0] = ptr[hj]; zraw[rw][1] = ptr[512 + hj]; zraw[rw][2] = ptr[1024 + hj]; \
                    _Pragma("unroll") for (int q = 0; q < 4; ++q) zraw[rw][3 + q] = ptr[1536 + lane + 64 * q]; } } while (0)
            RW_GLOAD(0);
            for (int c = -1; c < NC; ++c) {
                const bool do_prep = (c + 1 < NC), do_post = (c >= 1);
                float cr[5], ck[5], cv[5], cl[5][4];
#pragma unroll
                for (int rw = 0; rw < 5; ++rw) { cr[rw] = bf2f(zraw[rw][0]); ck[rw] = bf2f(zraw[rw][1]); cv[rw] = bf2f(zraw[rw][2]);
#pragma unroll
                    for (int q = 0; q < 4; ++q) cl[rw][q] = bf2f(zraw[rw][3 + q]); }
                if (c == -1 && p == 0) { cr[0] = 0.f; ck[0] = 0.f; cv[0] = 0.f; cl[0][0] = 0.f; cl[0][1] = 0.f; cl[0][2] = 0.f; cl[0][3] = 0.f; }
                if (c + 2 < NC) RW_GLOAD(c + 2);
                if (do_post) {
                    const float* Rb = rec + ((c - 1) & 1) * RT * REC;
                    const float* ob = obuf + ((c - 1) & 1) * RT * 64;
                    float ov[4], sm[8];
#pragma unroll
                    for (int u = 0; u < 4; ++u) { ov[u] = ob[(p * 4 + u) * 64 + lane]; sm[2 * u] = ov[u]; sm[2 * u + 1] = ov[u] * ov[u]; }
                    wave_sum_n<8>(sm);
#pragma unroll
                    for (int u = 0; u < 4; ++u) {
                        const int tt = p * 4 + u, t = (c - 1) * RT + tt;
                        const float* R = Rb + tt * REC;
                        const float mean = sm[2 * u] * (1.0f / 64.0f), var = fmaxf(sm[2 * u + 1] * (1.0f / 64.0f) - mean * mean, 0.f);
                        float o = (ov[u] - mean) * __builtin_amdgcn_rsqf(var + GN_EPS) * gn_g + gn_b;
                        o += R[450] * R[320 + lane];
                        yc[(size_t)(b * SEQ + t) * DMIX + hj] = f2bf(o * R[384 + lane]);
                    }
                }
                if (do_prep) {
                    float rr[4], kx[4], vx[4];
#pragma unroll
                    for (int u = 0; u < 4; ++u) {
                        rr[u] = cr[u + 1] + (cr[u] - cr[u + 1]) * mu_r; kx[u] = ck[u + 1] + (ck[u] - ck[u + 1]) * mu_k; vx[u] = cv[u + 1] + (cv[u] - cv[u + 1]) * mu_v;
#pragma unroll
                        for (int q = 0; q < 4; ++q) {
                            const float z = cl[u + 1][q] + (cl[u][q] - cl[u + 1][q]) * mu_l[q];
                            const float val = (q == 0) ? ftanh(z) : (q == 1 ? z : sigmoidf_(z));
                            lb[u * 264 + lane + 64 * q] = f2bf(val);
                        }
                    }
                    asm volatile("s_waitcnt lgkmcnt(0)" ::: "memory");
                    bf16x8 af[8];
#pragma unroll
                    for (int k8 = 0; k8 < 8; ++k8) af[k8] = *(const bf16x8*)(lb + (lane & 3) * 264 + k8 * 32 + quad * 8);
#pragma unroll
                    for (int jt = 0; jt < 4; ++jt) {
                        f32x4 cw = (f32x4){0.f, 0.f, 0.f, 0.f}, ca = cw, cgm = cw;
#pragma unroll
                        for (int kh = 0; kh < 2; ++kh) {
                            cw = __builtin_amdgcn_mfma_f32_16x16x32_bf16(af[kh], *(const bf16x8*)(W2T + (jt * 16 + lr) * 72 + kh * 32 + quad * 8), cw, 0, 0, 0);
                            ca = __builtin_amdgcn_mfma_f32_16x16x32_bf16(af[2 + kh], *(const bf16x8*)(A2T + (jt * 16 + lr) * 72 + kh * 32 + quad * 8), ca, 0, 0, 0);
                        }
#pragma unroll
                        for (int kh = 0; kh < 4; ++kh)
                            cgm = __builtin_amdgcn_mfma_f32_16x16x32_bf16(af[4 + kh], *(const bf16x8*)(G2T + (jt * 16 + lr) * 136 + kh * 32 + quad * 8), cgm, 0, 0, 0);
                        if (quad == 0) {
#pragma unroll
                            for (int jj = 0; jj < 4; ++jj) { lop[jj * 192 + jt * 16 + lr] = cw[jj]; lop[jj * 192 + 64 + jt * 16 + lr] = ca[jj]; lop[jj * 192 + 128 + jt * 16 + lr] = cgm[jj]; }
                        }
                    }
                    asm volatile("s_waitcnt lgkmcnt(0)" ::: "memory");
                    float* Rb = rec + ((c + 1) & 1) * RT * REC;
                    float dcy[4], av[4], kqv[4], kpv[4], ggv[4], red[16];
#pragma unroll
                    for (int u = 0; u < 4; ++u) {
                        const float wl = w0 + lop[u * 192 + lane], ap = a0 + lop[u * 192 + 64 + lane]; ggv[u] = lop[u * 192 + 128 + lane];
                        const float z = -wl;
                        const float sp = fmaxf(z, 0.f) + flog(1.0f + fexp(-fabsf(z)));
                        dcy[u] = fexp(-fexp(-sp - 0.5f));
                        av[u] = sigmoidf_(ap);
                        kqv[u] = kx[u] * k_k;
                        kpv[u] = kx[u] * (1.0f + (av[u] - 1.0f) * k_a);
                        red[4 * u] = kqv[u] * kqv[u]; red[4 * u + 1] = kqv[u] * av[u] * rr[u]; red[4 * u + 2] = kpv[u] * rr[u]; red[4 * u + 3] = rr[u] * kpv[u] * r_k;
                    }
                    wave_sum_n<16>(red);
#pragma unroll
                    for (int u = 0; u < 4; ++u) {
                        const int tt = p * 4 + u;
                        const float inv = __builtin_amdgcn_rcpf(fmaxf(__builtin_amdgcn_sqrtf(red[4 * u]), 1e-12f));
                        const float kkn = kqv[u] * inv;
                        float* R = Rb + tt * REC;
                        R[lane] = -kkn; R[64 + lane] = dcy[u] * rr[u]; R[128 + lane] = dcy[u]; R[192 + lane] = kkn * av[u]; R[256 + lane] = kpv[u]; R[320 + lane] = vx[u]; R[384 + lane] = ggv[u];
                        if (lane == 0) { R[448] = red[4 * u + 1] * inv; R[449] = red[4 * u + 2]; R[450] = red[4 * u + 3]; }
                    }
                }
                LDS_BARRIER();
            }
#undef RW_GLOAD
            {
                const float* Rb = rec + ((NC - 1) & 1) * RT * REC;
                const float* ob = obuf + ((NC - 1) & 1) * RT * 64;
                float ov[4], sm[8];
#pragma unroll
                for (int u = 0; u < 4; ++u) { ov[u] = ob[(p * 4 + u) * 64 + lane]; sm[2 * u] = ov[u]; sm[2 * u + 1] = ov[u] * ov[u]; }
                wave_sum_n<8>(sm);
#pragma unroll
                for (int u = 0; u < 4; ++u) {
                    const int tt = p * 4 + u, t = (NC - 1) * RT + tt;
                    const float* R = Rb + tt * REC;
                    const float mean = sm[2 * u] * (1.0f / 64.0f), var = fmaxf(sm[2 * u + 1] * (1.0f / 64.0f) - mean * mean, 0.f);
                    float o = (ov[u] - mean) * __builtin_amdgcn_rsqf(var + GN_EPS) * gn_g + gn_b;
                    o += R[450] * R[320 + lane];
                    yc[(size_t)(b * SEQ + t) * DMIX + hj] = f2bf(o * R[384 + lane]);
                }
            }
        }
    }
    __syncthreads();
}

#define XB_TMO      128
#define XB_XCNT(j)  (256  + 64 * (j))
#define XB_XSUB(j)  (1280 + 64 * (j))
#define XB_XGEN(j)  (2304 + 64 * (j))
#define XB_TOP      3328
#define XB_TOPGEN   3392
#define XCD_BAR_WORDS 3456
#define XB_SPIN_CAP (1u << 18)
__device__ __forceinline__ unsigned xb_ld(unsigned* p)              { return __hip_atomic_load(p, __ATOMIC_RELAXED, __HIP_MEMORY_SCOPE_AGENT); }
__device__ __forceinline__ unsigned xb_add(unsigned* p, unsigned v) { return __hip_atomic_fetch_add(p, v, __ATOMIC_RELAXED, __HIP_MEMORY_SCOPE_AGENT); }
__device__ __forceinline__ unsigned xb_xcc_id() { return (unsigned)__builtin_amdgcn_s_getreg((3 << 11) | 20) & 0xFu; }
#define XB_SPIN(cond, bar) do { unsigned _sp = 0; while (cond) { __builtin_amdgcn_s_sleep(1); \
    if ((++_sp & 255u) == 0u) { if (xb_ld(&(bar)[XB_TMO])) break; if (_sp > XB_SPIN_CAP) { atomicAdd(&(bar)[XB_TMO], 1u); break; } } } } while (0)
struct XcdBarrier { unsigned* bar; unsigned x; volatile LAS unsigned* st; };
__device__ __forceinline__ XcdBarrier xcd_barrier_post(unsigned* bar, volatile LAS unsigned* st) {
    XcdBarrier b; b.bar = bar; b.x = xb_xcc_id(); b.st = st;
    if (threadIdx.x == 0) (void)xb_add(&bar[XB_XCNT(b.x)], 1u);
    return b;
}
__device__ __forceinline__ void xcd_barrier_complete(unsigned* bar, unsigned x, unsigned& nloc, unsigned& nx) {
    const unsigned G = gridDim.x;
    unsigned sum, cnt, mine, sp = 0u;
    for (;;) {
        sum = 0u; cnt = 0u; mine = 0u;
#pragma unroll
        for (unsigned j = 0; j < 16; ++j) { const unsigned c = xb_ld(&bar[XB_XCNT(j)]); sum += c; cnt += (c > 0u) ? 1u : 0u; mine = (j == x) ? c : mine; }
        if (sum == G) break;
        __builtin_amdgcn_s_sleep(1);
        if ((++sp & 255u) == 0u) { if (xb_ld(&bar[XB_TMO])) break; if (sp > XB_SPIN_CAP) { atomicAdd(&bar[XB_TMO], 1u); break; } }
    }
    nloc = mine > 0u ? mine : 1u; nx = cnt > 0u ? cnt : 1u;
}
__device__ __forceinline__ void xcd_barrier(const XcdBarrier& b, const int tid) {
    asm volatile("s_waitcnt vmcnt(0)" ::: "memory");
    __syncthreads();
    if (tid == 0) {
        unsigned* bar = b.bar;
        __builtin_amdgcn_s_waitcnt(0);
        unsigned nloc = b.st[0], nx = b.st[1];
        if (nloc == 0u) { xcd_barrier_complete(bar, b.x, nloc, nx); b.st[0] = nloc; b.st[1] = nx; }
        const unsigned old = xb_add(&bar[XB_XSUB(b.x)], 1u);
        const unsigned gen = old / nloc;
        if (old + 1u == (gen + 1u) * nloc) {
            __builtin_amdgcn_fence(__ATOMIC_RELEASE, "agent");
            asm volatile("s_waitcnt vmcnt(0)" ::: "memory");
            const unsigned og = xb_add(&bar[XB_TOP], 1u);
            const unsigned tg = og / nx;
            if (og + 1u == (tg + 1u) * nx) xb_add(&bar[XB_TOPGEN], 1u);
            else XB_SPIN(xb_ld(&bar[XB_TOPGEN]) == tg, bar);
            __builtin_amdgcn_fence(__ATOMIC_ACQUIRE, "agent");
            xb_add(&bar[XB_XGEN(b.x)], 1u);
            asm volatile("s_waitcnt vmcnt(0)" ::: "memory");
        } else {
            XB_SPIN(xb_ld(&bar[XB_XGEN(b.x)]) == gen, bar);
            __builtin_amdgcn_fence(__ATOMIC_ACQUIRE, "agent");
            asm volatile("s_waitcnt vmcnt(0)" ::: "memory");
        }
    }
    __syncthreads();
}

constexpr int NPH = 12;
__global__ void __launch_bounds__(512, 2) mega(Params P, int ph_lo, int ph_hi) {
    extern __shared__ __attribute__((aligned(16))) unsigned char shm[];
    LAS unsigned char* lds = (LAS unsigned char*)shm;
    cg::grid_group grid = cg::this_grid();
    const int swid = __builtin_amdgcn_readfirstlane((int)threadIdx.x >> 6);
    volatile LAS unsigned* xst = (volatile LAS unsigned*)(lds + 131072);
    if (threadIdx.x < 2) xst[threadIdx.x] = 0u;
    __syncthreads();
    const XcdBarrier xbar = xcd_barrier_post((unsigned*)(P.ws + WS_BAR), xst);
    unsigned char* ws = P.ws;
    bf16_t* xb = (bf16_t*)(ws + WS_XB);
    bf16_t* wt = (bf16_t*)(ws + WS_WT);
    bf16_t* pb = (bf16_t*)(ws + WS_PB);
    bf16_t* hbuf = (bf16_t*)(ws + WS_H);
    bf16_t* vt = (bf16_t*)(ws + WS_VT);
    bf16_t* pq = hbuf;
    bf16_t* ubuf = hbuf;
    bf16_t* plb = (bf16_t*)(ws + WS_H + 512 * MiB);
    bf16_t* ybase = (bf16_t*)P.out;
    bf16_t* mb = plb;
    for (int ph = ph_lo; ph < ph_hi; ++ph) {
        const int l = ph / NPH, k = ph % NPH;
        const int njobs = (k == 1 || k == 5 || k == 6 || k == 9 || k == 10) ? 1 : (k == 4 ? 4 : (k == 8 ? 2 : 0));
        for (int rep = 0; rep < ((k == REPK) ? REPN : 1); ++rep) {
        int bid_ = blockIdx.x, gdim_ = gridDim.x; asm volatile("" : "+s"(bid_)); asm volatile("" : "+s"(gdim_)); int z_ = 0; asm volatile("" : "+s"(z_));
        int tid_ = (swid << 6) + (int)__builtin_amdgcn_mbcnt_hi(~0u, __builtin_amdgcn_mbcnt_lo(~0u, (unsigned)z_)); asm volatile("" : "+v"(tid_));
        if (njobs) {
            for (int n = 0; n < njobs; ++n) {
                pg8::Epi E; E.mode = 0; E.act = 0; E.ob = nullptr; E.ldo = 0; E.bias = nullptr; E.io2 = nullptr; E.resf = nullptr; E.aux = nullptr;
                pg8::Gemm g; g.M = MTOK; g.A = xb; g.lda = D; g.K = D; g.Bt = wt; g.ldb = D; g.N = D;
                int merge = 0;
                if (k == 1) { E.ob = hbuf; E.ldo = INC; g.Bt = wt + WO_IN; g.N = INC; }
                else if (k == 4) { E.ob = pq + (size_t)n * D; E.ldo = 4 * D; g.A = ybase + (size_t)n * MTOK * DMIX; g.lda = DMIX; g.K = DMIX; g.Bt = wt + WO_B + (size_t)n * D * DMIX; g.ldb = DMIX; }
                else if (k == 5) { E.mode = 3; E.ob = pq; E.ldo = 4 * D; E.bias = P.in[25 + z_] + (size_t)l * 4 * D; E.io2 = mb; g.Bt = wt + WO_G; g.N = 4 * D; merge = 1; }
                else if (k == 6) { E.mode = 2; E.io2 = xb; if (l == 0) E.resf = P.in[0 + z_]; g.A = mb; g.Bt = wt + WO_OUT4; }
                else if (k == 8 && n == 0) { E.act = 1; E.ob = ubuf; E.ldo = DFF; g.Bt = wt + WO_FF1; g.N = DFF; }
                else if (k == 8) { E.ob = plb; E.ldo = D; g.A = pb; g.lda = DPLE; g.K = DPLE; g.Bt = wt + WO_PLE; g.ldb = DPLE; }
                else if (k == 9) { E.mode = 1; E.ob = plb; E.ldo = D; E.bias = P.in[33 + z_] + (size_t)l * D; g.Bt = wt + WO_PLEG; }
                else { E.mode = 2; E.io2 = xb; E.aux = plb; g.A = ubuf; g.lda = DFF; g.K = DFF; g.Bt = wt + WO_FF2; g.ldb = DFF; }
                pg8::StaticOrder S; S.init(g.M, g.N, gdim_, bid_, merge);
                pg8::gemm_phase(tid_, lds, g, S, E);
                __syncthreads();
            }
        } else if (k == 0) {
            float* tile = (float*)shm;
            tconv(tid_, bid_, gdim_, tile, P.in[2 + z_] + (size_t)l * D * INC, D, INC, wt + WO_IN, D);
            for (int n = 0; n < 4; ++n) tconv(tid_, bid_, gdim_, tile, P.in[24 + z_] + ((size_t)l * 4 + n) * D * D, D, D, wt + WO_G + (size_t)n * D * D, D);
            for (int n = 0; n < 4; ++n) tconv(tid_, bid_, gdim_, tile, P.in[23 + z_] + ((size_t)l * 4 + n) * DMIX * D, DMIX, D, wt + WO_B + (size_t)n * D * DMIX, DMIX);
            tconv(tid_, bid_, gdim_, tile, P.in[26 + z_] + (size_t)l * D * D, D, D, wt + WO_OUT4, D);
            tconv(tid_, bid_, gdim_, tile, P.in[29 + z_] + (size_t)l * D * DFF, D, DFF, wt + WO_FF1, D);
            tconv(tid_, bid_, gdim_, tile, P.in[30 + z_] + (size_t)l * DFF * D, DFF, D, wt + WO_FF2, DFF);
            tconv(tid_, bid_, gdim_, tile, P.in[31 + z_] + (size_t)l * DPLE * D, DPLE, D, wt + WO_PLE, DPLE);
            tconv(tid_, bid_, gdim_, tile, P.in[32 + z_] + (size_t)l * D * D, D, D, wt + WO_PLEG, D);
            econv(tid_, bid_, gdim_, P.in[1 + z_] + (size_t)l * MTOK * DPLE, pb, (size_t)MTOK * DPLE);
            if (l == 0) econv(tid_, bid_, gdim_, P.in[0 + z_], xb, (size_t)MTOK * D);
        } else if (k == 2) {
            for (int r2 = 0; r2 < REP_LRU; ++r2) { int t2_ = tid_, b2_ = bid_; asm volatile("" : "+v"(t2_)); asm volatile("" : "+s"(b2_));
            lru_phase(t2_, b2_, gdim_, shm, hbuf, P.in[3 + z_] + (size_t)l * 4 * DMIX, P.in[4 + z_] + (size_t)l * DMIX, P.in[5 + z_] + (size_t)l * 8 * 4096, P.in[6 + z_] + (size_t)l * DMIX,
                      P.in[7 + z_] + (size_t)l * 8 * 4096, P.in[8 + z_] + (size_t)l * DMIX, P.in[9 + z_] + (size_t)l * DMIX, ybase);
            }
            for (int r2 = 0; r2 < REP_RWKV; ++r2) { int t2_ = tid_, b2_ = bid_; asm volatile("" : "+v"(t2_)); asm volatile("" : "+s"(b2_));
            rwkv_phase(t2_, b2_, gdim_, shm, hbuf, P.in[11 + z_] + (size_t)l * 1792, P.in[12 + z_] + (size_t)l * DMIX, P.in[13 + z_] + (size_t)l * 64 * DMIX, P.in[14 + z_] + (size_t)l * DMIX,
                       P.in[15 + z_] + (size_t)l * 64 * DMIX, P.in[16 + z_] + (size_t)l * 128 * DMIX, P.in[17 + z_] + (size_t)l * DMIX, P.in[18 + z_] + (size_t)l * DMIX,
                       P.in[19 + z_] + (size_t)l * DMIX, P.in[20 + z_] + (size_t)l * DMIX, P.in[21 + z_] + (size_t)l * DMIX, ybase + (size_t)2 * MTOK * DMIX);
            }
            for (int r2 = 0; r2 < REP_SV; ++r2) { int t2_ = tid_, b2_ = bid_; asm volatile("" : "+v"(t2_)); asm volatile("" : "+s"(b2_));
            sconv_phase(t2_, b2_, gdim_, hbuf, P.in[10 + z_] + (size_t)l * 3 * DMIX, ybase + (size_t)1 * MTOK * DMIX);
            vtrans_phase(t2_, b2_, gdim_, (bf16_t*)shm, hbuf, vt);
            }
        } else if (k == 3) {
            attn_phase(tid_, bid_, gdim_, shm, hbuf, vt, P.in[22 + z_], ybase + (size_t)3 * MTOK * DMIX);
        } else if (k == 7) {
            ln_phase(tid_, bid_, gdim_, xb, P.in[27 + z_] + (size_t)l * D, P.in[28 + z_] + (size_t)l * D, nullptr);
        } else {
            ln_phase(tid_, bid_, gdim_, xb, P.in[34 + z_] + (size_t)l * D, P.in[35 + z_] + (size_t)l * D, l == DEPTH - 1 ? P.out : nullptr);
        }
        }
        if (ph + 1 < ph_hi) { if (ph == ph_lo) { asm volatile("s_waitcnt vmcnt(0) lgkmcnt(0)" ::: "memory"); grid.sync(); } else { int zb_ = 0; asm volatile("" : "+s"(zb_)); const int tb_ = (swid << 6) + (int)__builtin_amdgcn_mbcnt_hi(~0u, __builtin_amdgcn_mbcnt_lo(~0u, (unsigned)zb_)); xcd_barrier(xbar, tb_); } }
    }
}

extern "C" void kernel_launch(void* const* d_in, const int* in_sizes, int n_in, void* d_out, int out_size, void* d_ws, size_t ws_size, hipStream_t stream) {
    static int grid = 0;
    if (grid == 0) {
        int dev = 0, cus = 0, per_cu = 0;
        hipGetDevice(&dev);
        hipDeviceGetAttribute(&cus, hipDeviceAttributeMultiprocessorCount, dev);
        hipFuncSetAttribute((const void*)mega, hipFuncAttributeMaxDynamicSharedMemorySize, LDS_BYTES);
        hipOccupancyMaxActiveBlocksPerMultiprocessor(&per_cu, (const void*)mega, 512, LDS_BYTES);
        if (per_cu < 1) { fprintf(stderr, "kernel_launch: occupancy query says %d blocks/CU\n", per_cu); per_cu = 1; }
        (void)hipGetLastError();
        grid = cus * 1;
        if (n_in != 36 || ws_size < 1013 * MiB) fprintf(stderr, "kernel_launch: unexpected n_in %d / ws_size %zu\n", n_in, ws_size);
    }
    (void)hipMemsetAsync((char*)d_ws + WS_BAR, 0, XCD_BAR_WORDS * sizeof(unsigned), stream);
    Params p{};
    for (int i = 0; i < 36; ++i) p.in[i] = (const float*)d_in[i];
    p.out = (float*)d_out; p.ws = (unsigned char*)d_ws;
#if ONE_LAUNCH
    int lo = 0, hi = DEPTH * NPH;
    void* args[] = {&p, &lo, &hi};
    hipError_t e = hipLaunchCooperativeKernel((const void*)mega, dim3(grid), dim3(512), args, LDS_BYTES, stream);
    if (e != hipSuccess) fprintf(stderr, "cooperative launch failed: %s (grid %d)\n", hipGetErrorString(e), grid);
#else
    for (int ph = 0; ph < DEPTH * NPH; ++ph) hipLaunchKernelGGL(mega, dim3(grid), dim3(512), LDS_BYTES, stream, p, ph, ph + 1);
#endif
}
```

```cpp
#include <hip/hip_runtime.h>
#include <hip/hip_cooperative_groups.h>
#include <cstdio>
#include <cstdint>
namespace cg = cooperative_groups;

#ifndef REPK
#define REPK -1
#endif
#ifndef REPN
#define REPN 1
#endif
#ifndef REP_LRU
#define REP_LRU 1
#endif
#ifndef REP_RWKV
#define REP_RWKV 1
#endif
#ifndef REP_SV
#define REP_SV 1
#endif
#ifndef ONE_LAUNCH
#define ONE_LAUNCH 1
#endif

#define LAS __attribute__((address_space(3)))
typedef unsigned short bf16_t;
typedef short bf16x8 __attribute__((ext_vector_type(8)));
typedef short bf16x4 __attribute__((ext_vector_type(4)));
typedef float f32x4 __attribute__((ext_vector_type(4)));
typedef float f32x2 __attribute__((ext_vector_type(2)));
typedef unsigned u32x4 __attribute__((ext_vector_type(4)));
typedef unsigned u32x2 __attribute__((ext_vector_type(2)));

constexpr int D = 1024, BATCH = 32, SEQ = 2048, DEPTH = 2, MTOK = BATCH * SEQ;
constexpr int DMIX = 512, INC = 5888, DFF = 4096, DPLE = 256;
constexpr int COL_A = 0, COL_B = 1024, COL_C = 2560, COL_D = 4352;
constexpr float ALPHA = 1.4142135623730951f;
constexpr float LN_EPS = 1e-5f, GN_EPS = 64e-5f;

constexpr size_t MiB = 1ull << 20;
constexpr size_t WS_XB = 0, WS_WT = 128 * MiB, WS_PB = 180 * MiB, WS_H = 212 * MiB, WS_VT = 948 * MiB;
constexpr size_t WO_IN = 0, WO_G = 6029312, WO_B = WO_G + 4194304, WO_OUT4 = WO_B + 2097152, WO_FF1 = WO_OUT4 + 4194304,
                 WO_FF2 = WO_FF1 + 4194304, WO_PLE = WO_FF2 + 4194304, WO_PLEG = WO_PLE + 262144;
constexpr int LDS_BYTES = 131072 + 16 + 9216;
constexpr size_t WS_BAR = 1012 * MiB;

struct Params {
    const float* in[36];
    float* out;
    unsigned char* ws;
};

__device__ __forceinline__ float bf2f(unsigned v) { return __uint_as_float(v << 16); }
typedef __bf16 bf16x2_t __attribute__((ext_vector_type(2)));
__device__ __forceinline__ unsigned cvt_pk_bf16(float lo, float hi) { f32x2 v = {lo, hi}; bf16x2_t b = __builtin_convertvector(v, bf16x2_t); unsigned r; __builtin_memcpy(&r, &b, 4); return r; }
__device__ __forceinline__ bf16_t f2bf(float f) { return (bf16_t)(cvt_pk_bf16(f, 0.f) & 0xffffu); }
__device__ __forceinline__ float fexp(float x) { return __builtin_amdgcn_exp2f(x * 1.4426950408889634f); }
__device__ __forceinline__ float flog(float x) { return __builtin_amdgcn_logf(x) * 0.6931471805599453f; }
__device__ __forceinline__ float ftanh(float x) { return 1.0f - 2.0f * __builtin_amdgcn_rcpf(1.0f + fexp(2.0f * x)); }
__device__ __forceinline__ float flog1p_small(float x) { return flog(1.0f + x); }
__device__ __forceinline__ float fneg_expm1(float t) { return 1.0f - fexp(t); }
__device__ __forceinline__ float sigmoidf_(float x) { return __builtin_amdgcn_rcpf(1.0f + fexp(-x)); }
__device__ __forceinline__ float wave_sum(float v) {
    v += __int_as_float(__builtin_amdgcn_update_dpp(0, __float_as_int(v), 0xB1, 0xF, 0xF, true));
    v += __int_as_float(__builtin_amdgcn_update_dpp(0, __float_as_int(v), 0x4E, 0xF, 0xF, true));
    v += __int_as_float(__builtin_amdgcn_update_dpp(0, __float_as_int(v), 0x141, 0xF, 0xF, true));
    v += __int_as_float(__builtin_amdgcn_update_dpp(0, __float_as_int(v), 0x140, 0xF, 0xF, true));
    const float s0 = __int_as_float(__builtin_amdgcn_readlane(__float_as_int(v), 0)), s1 = __int_as_float(__builtin_amdgcn_readlane(__float_as_int(v), 16));
    const float s2 = __int_as_float(__builtin_amdgcn_readlane(__float_as_int(v), 32)), s3 = __int_as_float(__builtin_amdgcn_readlane(__float_as_int(v), 48));
    return (s0 + s1) + (s2 + s3);
}
template <int N> __device__ __forceinline__ void wave_sum_n(float (&v)[N]) {
#pragma unroll
    for (int i = 0; i < N; ++i) v[i] += __int_as_float(__builtin_amdgcn_update_dpp(0, __float_as_int(v[i]), 0xB1, 0xF, 0xF, true));
#pragma unroll
    for (int i = 0; i < N; ++i) v[i] += __int_as_float(__builtin_amdgcn_update_dpp(0, __float_as_int(v[i]), 0x4E, 0xF, 0xF, true));
#pragma unroll
    for (int i = 0; i < N; ++i) v[i] += __int_as_float(__builtin_amdgcn_update_dpp(0, __float_as_int(v[i]), 0x141, 0xF, 0xF, true));
#pragma unroll
    for (int i = 0; i < N; ++i) v[i] += __int_as_float(__builtin_amdgcn_update_dpp(0, __float_as_int(v[i]), 0x140, 0xF, 0xF, true));
#pragma unroll
    for (int i = 0; i < N; ++i) v[i] += __int_as_float(__builtin_amdgcn_update_dpp(0, __float_as_int(v[i]), 0x142, 0xA, 0xF, false));
#pragma unroll
    for (int i = 0; i < N; ++i) v[i] += __int_as_float(__builtin_amdgcn_update_dpp(0, __float_as_int(v[i]), 0x143, 0xC, 0xF, false));
#pragma unroll
    for (int i = 0; i < N; ++i) v[i] = __int_as_float(__builtin_amdgcn_readlane(__float_as_int(v[i]), 63));
}
__device__ __forceinline__ float shflx(float v, int lane, int m) { return __int_as_float(__builtin_amdgcn_ds_bpermute((lane ^ m) << 2, __float_as_int(v))); }
__device__ __forceinline__ void unpack8(u32x4 u, float* f) {
#pragma unroll
    for (int i = 0; i < 4; ++i) { f[2 * i] = __uint_as_float(u[i] << 16); f[2 * i + 1] = __uint_as_float(u[i] & 0xffff0000u); }
}
__device__ __forceinline__ u32x4 pack8(const float* f) {
    u32x4 u;
#pragma unroll
    for (int i = 0; i < 4; ++i) u[i] = cvt_pk_bf16(f[2 * i], f[2 * i + 1]);
    return u;
}

namespace pg8 {
constexpr int BM = 256, BK = 64, HALF = 128, HTB = HALF * BK * 2, STAGE_BYTES = 8 * HTB, NXCD = 8, WGM = 8;
__host__ __device__ __forceinline__ int lds_byte(int r, int c) { const int st = (r >> 4) * 2 + (c >> 5), rr = r & 15, cc = c & 31, ob = rr * 64 + cc * 2; return st * 1024 + (ob ^ (((ob >> 9) & 1) << 5)); }
__host__ __device__ __forceinline__ void stage_rc(int b, int& R, int& C) { const int st = b / 1024, sb = b % 1024, swz = sb ^ (((sb >> 9) & 1) << 5); R = (st >> 1) * 16 + swz / 64; C = (st & 1) * 32 + (swz % 64) / 2; }
__host__ __device__ __forceinline__ int perm32(int rho) { const int n = rho >> 4, i = rho & 15; return 8 * (i >> 2) + 4 * n + (i & 3); }
struct Unit { int pm, pn; };
struct Gemm { const bf16_t* A; const bf16_t* Bt; int M, N, K, lda, ldb; };
struct StaticOrder {
    int nM, nN, nwg, G, c, merge;
    __device__ void init(int M, int N, int G_, int c_, int merge_) { merge = merge_; nM = M / BM; nN = (merge_ ? N / 4 : N) / BM; nwg = nM * nN; G = G_; c = c_; }
    __device__ bool next(int i, Unit& u) const {
        int n = 0; if (merge) { n = i & 3; i >>= 2; }
        const long L = (long)i * G + c; if (L >= nwg) return false;
        int wgid = (int)L; { const int q = nwg / NXCD, r = nwg % NXCD, xcd = wgid % NXCD, off = wgid / NXCD; wgid = (xcd < r ? xcd * (q + 1) : r * (q + 1) + (xcd - r) * q) + off; }
        const int nig = WGM * nN, gid = wgid / nig, fm = gid * WGM, gsz = (nM - fm) < WGM ? (nM - fm) : WGM;
        u.pm = fm + ((wgid % nig) % gsz); u.pn = (wgid % nig) / gsz + n * nN; return true;
    }
};

struct Epi {
    int mode;
    int act;
    bf16_t* ob; int ldo;
    const float* bias;
    bf16_t* io2;
    const float* resf;
    const bf16_t* aux;
    __device__ __forceinline__ void operator()(const f32x4 (&acc)[2][2][4][2], const Unit& u, int wr, int wc, int fr, int fq, LAS unsigned char* dump) const {
        int row0 = u.pm * BM + wr * 64 + fr, col0 = u.pn * BM + wc * 32 + 8 * fq;
        asm volatile("" : "+v"(row0), "+v"(col0));
        float bv[2][8];
        if (mode == 1 || mode == 3) {
#pragma unroll
            for (int bj = 0; bj < 2; ++bj) { const f32x4 b0 = *(const f32x4*)(bias + col0 + bj * HALF), b1 = *(const f32x4*)(bias + col0 + bj * HALF + 4);
#pragma unroll
                for (int j = 0; j < 4; ++j) { bv[bj][j] = b0[j]; bv[bj][4 + j] = b1[j]; } }
        }
        if (mode != 0) {
#pragma unroll
            for (int ai = 0; ai < 2; ++ai)
#pragma unroll
                for (int m = 0; m < 4; ++m)
#pragma unroll
                    for (int bj = 0; bj < 2; ++bj) {
                        const size_t row = (size_t)(row0 + ai * HALF + m * 16); const int col = col0 + bj * HALF;
                        const void* p0 = (mode == 2) ? (resf ? (const void*)(resf + row * D + col) : (const void*)(io2 + row * D + col)) : (const void*)(ob + row * ldo + col);
                        __builtin_amdgcn_global_load_lds((const unsigned*)p0, (LAS unsigned*)dump, 16, 0, 0);
                        if (mode == 2 && aux) __builtin_amdgcn_global_load_lds((const unsigned*)(aux + row * D + col), (LAS unsigned*)dump, 16, 0, 0);
                    }
        }
#pragma unroll
        for (int aim = 0; aim < 4; ++aim) {
            const int ai = aim >> 1, mh = aim & 1;
            u32x4 L0[4], L1[4];
            if (mode != 0) {
#pragma unroll
                for (int m2 = 0; m2 < 2; ++m2)
#pragma unroll
                    for (int bj = 0; bj < 2; ++bj) {
                        const int m = mh * 2 + m2;
                        const size_t row = (size_t)(row0 + ai * HALF + m * 16); const int col = col0 + bj * HALF, e = m2 * 2 + bj;
                        if (mode == 1) L0[e] = *(const u32x4*)(ob + row * ldo + col);
                        else if (mode == 3) { L0[e] = *(const u32x4*)(ob + row * ldo + col);
                            if (col >= D) L1[e] = *(const u32x4*)(io2 + row * D + (col & (D - 1))); }
                        else { if (resf) { L0[e] = *(const u32x4*)(resf + row * D + col); L1[e] = *(const u32x4*)(resf + row * D + col + 4); }
                               else { L0[e] = *(const u32x4*)(io2 + row * D + col); if (aux) L1[e] = *(const u32x4*)(aux + row * D + col); } }
                    }
            }
#pragma unroll
            for (int m2 = 0; m2 < 2; ++m2)
#pragma unroll
                for (int bj = 0; bj < 2; ++bj) {
                    const int m = mh * 2 + m2;
                    const size_t row = (size_t)(row0 + ai * HALF + m * 16); const int col = col0 + bj * HALF, e = m2 * 2 + bj;
                    float v[8];
#pragma unroll
                    for (int j = 0; j < 4; ++j) { v[j] = acc[ai][bj][m][0][j]; v[4 + j] = acc[ai][bj][m][1][j]; }
                    if (mode == 0) {
                        if (act == 1) {
#pragma unroll
                            for (int j = 0; j < 8; ++j) { const float t = fmaxf(v[j], 0.f); v[j] = t * t; }
                        }
                        *(u32x4*)(ob + row * ldo + col) = pack8(v);
                    } else if (mode == 1) {
                        float a[8]; unpack8(L0[e], a);
#pragma unroll
                        for (int j = 0; j < 8; ++j) v[j] = sigmoidf_(v[j] + bv[bj][j]) * a[j];
                        *(u32x4*)(ob + row * ldo + col) = pack8(v);
                    } else if (mode == 3) {
                        float a[8]; unpack8(L0[e], a);
#pragma unroll
                        for (int j = 0; j < 8; ++j) v[j] = sigmoidf_(v[j] + bv[bj][j]) * a[j];
                        if (col >= D) { float q[8]; unpack8(L1[e], q);
#pragma unroll
                            for (int j = 0; j < 8; ++j) v[j] += q[j]; }
                        *(u32x4*)(io2 + row * D + (col & (D - 1))) = pack8(v);
                    } else {
                        float r[8];
                        if (resf) {
#pragma unroll
                            for (int j = 0; j < 4; ++j) { r[j] = __uint_as_float(L0[e][j]); r[4 + j] = __uint_as_float(L1[e][j]); } }
                        else unpack8(L0[e], r);
#pragma unroll
                        for (int j = 0; j < 8; ++j) v[j] += ALPHA * r[j];
                        if (aux) { float a[8]; unpack8(L1[e], a);
#pragma unroll
                            for (int j = 0; j < 8; ++j) v[j] += a[j]; }
                        *(u32x4*)(io2 + row * D + col) = pack8(v);
                    }
                }
        }
    }
};

__device__ __forceinline__ void gemm_phase(const int tid, LAS unsigned char* lds, const Gemm g, const StaticOrder& S, const Epi& E) {
    const int wid = __builtin_amdgcn_readfirstlane(tid >> 6), lane = tid & 63, wr = wid >> 2, wc = wid & 3, fr = lane & 15, fq = lane >> 4;
    const int K = g.K, nt = K / BK;
    unsigned voffA, voffB;
    { int R, C; stage_rc(tid * 16, R, C); const int Rb = (R & ~31) + perm32(R & 31); voffA = (unsigned)(R * g.lda + C) * 2u; voffB = (unsigned)(Rb * g.ldb + C) * 2u; }
    const size_t p2A = (size_t)64 * g.lda * 2, p2B = (size_t)64 * g.ldb * 2;
    const size_t kstep = (size_t)(BK * 2);
    const size_t hstepA = (size_t)HALF * g.lda * 2, hstepB = (size_t)HALF * g.ldb * 2;
    const size_t tstepA = 2 * hstepA, tstepB = 2 * hstepB;
    const unsigned ldsw = (unsigned)wid * 1024u;
    const int aoff = lds_byte(wr * 64 + fr, fq * 8), boff = lds_byte(wc * 32 + fr, fq * 8);
#define XA voffA
#define XB voffB
#define p2XA p2A
#define p2XB p2B
#define PG8_SA(b, h) (((b) * 2 + (h)) * HTB)
#define PG8_SB(b, h) ((4 + (b) * 2 + (h)) * HTB)
#define PG8_STAGE(bufoff, gbase, voff) do { \
        __builtin_amdgcn_global_load_lds((const unsigned*)((const char*)(gbase) + (voff)), (LAS unsigned*)(lds + (bufoff) + ldsw), 16, 0, 0); \
        __builtin_amdgcn_global_load_lds((const unsigned*)((const char*)(gbase) + p2##voff + (voff)), (LAS unsigned*)(lds + (bufoff) + ldsw + 8192), 16, 0, 0); } while (0)
#define PG8_LDA(dst, b, h) do { _Pragma("unroll") for (int m = 0; m < 4; ++m) _Pragma("unroll") for (int k = 0; k < 2; ++k) dst[m][k] = *(const LAS bf16x8*)(lds + PG8_SA(b, h) + aoff + m * 2048 + k * 1024); } while (0)
#define PG8_LDB(dst, b, h) do { _Pragma("unroll") for (int n = 0; n < 2; ++n) _Pragma("unroll") for (int k = 0; k < 2; ++k) dst[n][k] = *(const LAS bf16x8*)(lds + PG8_SB(b, h) + boff + n * 2048 + k * 1024); } while (0)
#define PG8_MMA(ai, bj, At, Bt) do { __builtin_amdgcn_s_setprio(1); _Pragma("unroll") for (int m = 0; m < 4; ++m) _Pragma("unroll") for (int n = 0; n < 2; ++n) _Pragma("unroll") for (int k = 0; k < 2; ++k) \
        acc[ai][bj][m][n] = __builtin_amdgcn_mfma_f32_16x16x32_bf16(Bt[n][k], At[m][k], acc[ai][bj][m][n], 0, 0, 0); __builtin_amdgcn_s_setprio(0); } while (0)
#define PG8_WAIT_V(n) asm volatile("s_waitcnt vmcnt(" #n ")" ::: "memory")
#define PG8_WAIT_L(n) asm volatile("s_waitcnt lgkmcnt(" #n ")" ::: "memory")
#define PG8_BAR __builtin_amdgcn_s_barrier()
#define PG8_SCHED __builtin_amdgcn_sched_barrier(0)
    Unit cur, nxt; int ui = 0;
    if (!S.next(0, cur)) return;
    f32x4 acc[2][2][4][2];
    bf16x8 At[4][2], B0[2][2], B1[2][2];
    const char* cA = (const char*)g.A + (size_t)cur.pm * tstepA; const char* cB = (const char*)g.Bt + (size_t)cur.pn * tstepB;
    PG8_STAGE(PG8_SB(0, 0), cB, XB); PG8_STAGE(PG8_SB(0, 1), cB + hstepB, XB); PG8_STAGE(PG8_SA(0, 0), cA, XA); PG8_STAGE(PG8_SA(0, 1), cA + hstepA, XA);
    if (wr == 1) PG8_BAR;
    PG8_WAIT_V(2); PG8_BAR;
    PG8_STAGE(PG8_SB(1, 0), cB + kstep, XB); PG8_STAGE(PG8_SA(1, 0), cA + kstep, XA); PG8_STAGE(PG8_SB(1, 1), cB + hstepB + kstep, XB);
    PG8_WAIT_V(6); PG8_BAR;
    PG8_SCHED;
#pragma unroll
    for (int a = 0; a < 2; ++a)
#pragma unroll
        for (int b = 0; b < 2; ++b)
#pragma unroll
            for (int m = 0; m < 4; ++m)
#pragma unroll
                for (int n = 0; n < 2; ++n) acc[a][b][m][n] = (f32x4){0.f, 0.f, 0.f, 0.f};
    for (;;) {
        const bool has_next = S.next(ui + 1, nxt);
        const char* nA = has_next ? (const char*)g.A + (size_t)nxt.pm * tstepA : cA; const char* nB = has_next ? (const char*)g.Bt + (size_t)nxt.pn * tstepB : cB;
        for (int t = 0; t < nt; t += 2) {
            const bool last = (t == nt - 2);
            const char* a1 = cA + (size_t)(t + 1) * kstep;
            const char* a2 = last ? nA : cA + (size_t)(t + 2) * kstep; const char* b2 = last ? nB : cB + (size_t)(t + 2) * kstep;
            const char* a3 = a2 + kstep; const char* b3 = b2 + kstep;
            PG8_LDB(B0, 0, 0); PG8_LDB(B1, 0, 1); PG8_SCHED; PG8_LDA(At, 0, 0); PG8_STAGE(PG8_SA(1, 1), a1 + hstepA, XA);
            PG8_WAIT_V(8); PG8_WAIT_L(0); PG8_BAR; PG8_MMA(0, 0, At, B0); PG8_MMA(0, 1, At, B1); PG8_BAR; PG8_SCHED;
            PG8_LDA(At, 0, 1); PG8_STAGE(PG8_SB(0, 0), b2, XB); PG8_STAGE(PG8_SB(0, 1), b2 + hstepB, XB); PG8_STAGE(PG8_SA(0, 0), a2, XA);
            PG8_WAIT_V(8); PG8_WAIT_L(0); PG8_BAR; PG8_MMA(1, 0, At, B0); PG8_MMA(1, 1, At, B1); PG8_BAR; PG8_SCHED;
            PG8_LDB(B0, 1, 0); PG8_LDB(B1, 1, 1); PG8_SCHED; PG8_LDA(At, 1, 0); PG8_STAGE(PG8_SA(0, 1), a2 + hstepA, XA);
            PG8_WAIT_V(8); PG8_WAIT_L(0); PG8_BAR; PG8_MMA(0, 0, At, B0); PG8_MMA(0, 1, At, B1); PG8_BAR; PG8_SCHED;
            PG8_LDA(At, 1, 1); PG8_STAGE(PG8_SB(1, 0), b3, XB); PG8_STAGE(PG8_SB(1, 1), b3 + hstepB, XB); PG8_STAGE(PG8_SA(1, 0), a3, XA);
            PG8_WAIT_V(8); PG8_WAIT_L(0); PG8_BAR; PG8_MMA(1, 0, At, B0); PG8_MMA(1, 1, At, B1); PG8_BAR; PG8_SCHED;
        }
        if (wr == 0) PG8_BAR;
        E(acc, cur, wr, wc, fr, fq, lds + 131088 + ldsw);
        if (!has_next) break;
#pragma unroll
        for (int a = 0; a < 2; ++a)
#pragma unroll
            for (int b = 0; b < 2; ++b)
#pragma unroll
                for (int m = 0; m < 4; ++m)
#pragma unroll
                    for (int n = 0; n < 2; ++n) acc[a][b][m][n] = (f32x4){0.f, 0.f, 0.f, 0.f};
        cur = nxt; cA = nA; cB = nB; ++ui;
        if (wr == 1) PG8_BAR;
    }
    PG8_WAIT_V(0);
    PG8_BAR;
#undef PG8_SA
#undef PG8_SB
#undef PG8_STAGE
#undef PG8_LDA
#undef PG8_LDB
#undef PG8_MMA
#undef PG8_WAIT_V
#undef PG8_WAIT_L
#undef PG8_BAR
#undef PG8_SCHED
}
}

#define LDS_BARRIER() do { asm volatile("s_waitcnt lgkmcnt(0)" ::: "memory"); __builtin_amdgcn_s_barrier(); asm volatile("" ::: "memory"); } while (0)

__device__ __forceinline__ void tconv(const int tid_, const int bid_, const int gdim_, float* tile, const float* __restrict__ src, int K, int N, bf16_t* __restrict__ dst, int ldd) {
    const int tn = N / 64, nt = (K / 64) * tn;
    const int r = tid_ >> 3, c = (tid_ & 7) * 8;
    int t = bid_;
    f32x4 a, b;
    if (t < nt) { const f32x4* s = (const f32x4*)(src + (size_t)((t / tn) * 64 + r) * N + (t % tn) * 64 + c); a = s[0]; b = s[1]; }
    for (; t < nt; t += gdim_) {
        const int k0 = (t / tn) * 64, n0 = (t % tn) * 64;
#pragma unroll
        for (int j = 0; j < 4; ++j) { tile[r * 65 + c + j] = a[j]; tile[r * 65 + c + 4 + j] = b[j]; }
        const int t2 = t + gdim_;
        if (t2 < nt) { const f32x4* s = (const f32x4*)(src + (size_t)((t2 / tn) * 64 + r) * N + (t2 % tn) * 64 + c); a = s[0]; b = s[1]; }
        LDS_BARRIER();
        float v[8];
#pragma unroll
        for (int j = 0; j < 8; ++j) v[j] = tile[(c + j) * 65 + r];
        *(u32x4*)(dst + (size_t)(n0 + r) * ldd + k0 + c) = pack8(v);
        LDS_BARRIER();
    }
}
__device__ __forceinline__ void econv(const int tid_, const int bid_, const int gdim_, const float* __restrict__ src, bf16_t* __restrict__ dst, size_t n) {
    const size_t nth = (size_t)gdim_ * 512;
    for (size_t i = ((size_t)bid_ * 512 + tid_) * 8; i < n; i += nth * 8) {
        const f32x4 a = *(const f32x4*)(src + i), b = *(const f32x4*)(src + i + 4);
        float v[8] = {a[0], a[1], a[2], a[3], b[0], b[1], b[2], b[3]};
        *(u32x4*)(dst + i) = pack8(v);
    }
}

__device__ __forceinline__ void ln_phase(const int tid_, const int bid_, const int gdim_, bf16_t* xio, const float* __restrict__ g, const float* __restrict__ b, float* outf) {
    const int lane = tid_ & 63, wid = tid_ >> 6;
    const int nw = gdim_ * 8;
    float gg[16], bb[16];
#pragma unroll
    for (int i = 0; i < 2; ++i)
#pragma unroll
        for (int j = 0; j < 8; ++j) { gg[i * 8 + j] = g[i * 512 + lane * 8 + j]; bb[i * 8 + j] = b[i * 512 + lane * 8 + j]; }
    for (int row = bid_ * 8 + wid; row < MTOK; row += nw) {
        bf16_t* p = xio + (size_t)row * D + lane * 8;
        float v[16]; unpack8(*(const u32x4*)p, v); unpack8(*(const u32x4*)(p + 512), v + 8);
        float s = 0.f;
#pragma unroll
        for (int j = 0; j < 16; ++j) s += v[j];
        const float mean = wave_sum(s) * (1.0f / D);
        float q = 0.f;
#pragma unroll
        for (int j = 0; j < 16; ++j) { const float d = v[j] - mean; q += d * d; }
        const float rstd = __builtin_amdgcn_rsqf(wave_sum(q) * (1.0f / D) + LN_EPS);
#pragma unroll
        for (int j = 0; j < 16; ++j) v[j] = (v[j] - mean) * rstd * gg[j] + bb[j];
        if (!outf) { *(u32x4*)p = pack8(v); *(u32x4*)(p + 512) = pack8(v + 8); }
        else { float* o = outf + (size_t)row * D + lane * 8;
            *(f32x4*)o = (f32x4){v[0], v[1], v[2], v[3]}; *(f32x4*)(o + 4) = (f32x4){v[4], v[5], v[6], v[7]};
            *(f32x4*)(o + 512) = (f32x4){v[8], v[9], v[10], v[11]}; *(f32x4*)(o + 516) = (f32x4){v[12], v[13], v[14], v[15]}; }
    }
}

__device__ __forceinline__ void sconv_phase(const int tid_, const int bid_, const int gdim_, const bf16_t* __restrict__ h, const float* __restrict__ w  , bf16_t* __restrict__ yb) {
    const size_t nth = (size_t)gdim_ * 512;
    for (size_t idx = (size_t)bid_ * 512 + tid_; idx < (size_t)MTOK * 64; idx += nth) {
        const int tok = (int)(idx >> 6), c8 = (int)(idx & 63) * 8, t = tok & (SEQ - 1);
        float acc[8];
#pragma unroll
        for (int j = 0; j < 8; ++j) acc[j] = 0.f;
#pragma unroll
        for (int k = 0; k < 3; ++k) {
            const int tt = t - 2 + k;
            if (tt >= 0) {
                const bf16_t* row = h + (size_t)(tok - 2 + k) * INC + COL_B;
                float cgv[8], xh[8]; unpack8(*(const u32x4*)(row + 512 + c8), cgv); unpack8(*(const u32x4*)(row + 1024 + c8), xh);
                const f32x4 w0 = *(const f32x4*)(w + k * 512 + c8), w1 = *(const f32x4*)(w + k * 512 + c8 + 4);
#pragma unroll
                for (int j = 0; j < 4; ++j) { acc[j] += w0[j] * (cgv[j] * xh[j]); acc[4 + j] += w1[j] * (cgv[4 + j] * xh[4 + j]); }
            }
        }
        float bg[8]; unpack8(*(const u32x4*)(h + (size_t)tok * INC + COL_B + c8), bg);
#pragma unroll
        for (int j = 0; j < 8; ++j) acc[j] *= bg[j];
        *(u32x4*)(yb + (size_t)tok * DMIX + c8) = pack8(acc);
    }
}

__device__ __forceinline__ void vtrans_phase(const int tid_, const int it0, const int gdim_, bf16_t* tile  , const bf16_t* __restrict__ h, bf16_t* __restrict__ vt) {
    const int r = tid_ >> 3, c = (tid_ & 7) * 8;
    int it = it0;
    u32x4 u;
    if (it < BATCH * 8 * 32) { const int bh = it >> 5, tc = it & 31; u = *(const u32x4*)(h + (size_t)((bh >> 3) * SEQ + tc * 64 + r) * INC + COL_D + 1024 + (bh & 7) * 64 + c); }
    for (; it < BATCH * 8 * 32; it += gdim_) {
        const int bh = it >> 5, tc = it & 31;
#pragma unroll
        for (int j = 0; j < 4; ++j) { tile[(c + 2 * j) * 72 + r] = (bf16_t)(u[j] & 0xffffu); tile[(c + 2 * j + 1) * 72 + r] = (bf16_t)(u[j] >> 16); }
        const int i2 = it + gdim_;
        if (i2 < BATCH * 8 * 32) { const int bh2 = i2 >> 5, tc2 = i2 & 31; u = *(const u32x4*)(h + (size_t)((bh2 >> 3) * SEQ + tc2 * 64 + r) * INC + COL_D + 1024 + (bh2 & 7) * 64 + c); }
        LDS_BARRIER();
        *(u32x4*)(vt + (size_t)(bh * 64 + r) * SEQ + tc * 64 + c) = *(const u32x4*)(tile + r * 72 + c);
        LDS_BARRIER();
    }
}

__device__ __forceinline__ void attn_phase(const int tid_, const int bid_, const int gdim_, unsigned char* ldsb, const bf16_t* __restrict__ h, const bf16_t* __restrict__ vt, const float* __restrict__ rel_bias, bf16_t* __restrict__ yd) {
    constexpr float L2E = 1.4426950408889634f;
    float* rb = (float*)(ldsb + 131088);
    for (int i = tid_; i < 8 * 257; i += 512) rb[i] = rel_bias[i] * L2E;
    __syncthreads();
    const int lane = tid_ & 63, wid = __builtin_amdgcn_readfirstlane(tid_ >> 6), lr = lane & 15, quad = lane >> 4;
    const int nw = gdim_ * 8;
    unsigned char* wl = ldsb + wid * 16384;
    const int krow = lane >> 3, kchunk = (lane & 7) ^ (krow & 7);
    const int vrow = lane >> 2, vchunk = (lane & 3) ^ ((vrow >> 2) & 3);
    int koff[2][2], voff[4];
#pragma unroll
    for (int tt = 0; tt < 2; ++tt)
#pragma unroll
        for (int dh = 0; dh < 2; ++dh) { const int row = (lr >> 2) * 8 + tt * 4 + (lr & 3); koff[tt][dh] = row * 128 + (((dh * 4 + quad) ^ (row & 7)) * 16); }
#pragma unroll
    for (int dt = 0; dt < 4; ++dt) { const int d = dt * 16 + lr; voff[dt] = 4096 + d * 64 + ((quad ^ ((d >> 2) & 3)) * 16); }
    int it = 0;
    const int vbid = (bid_ & 7) * (gdim_ >> 3) + (bid_ >> 3);
    for (int item0 = vbid * 8 + wid; item0 < BATCH * 8 * 32; item0 += nw, ++it) {
        const int c = ((item0 & 31) + 8 * it) & 31, hh = (item0 >> 5) & 7, b = item0 >> 8;
        const int q0 = c * 64;
        const bf16_t* hb = h + (size_t)b * SEQ * INC + COL_D + hh * 64;
        bf16x8 qf[4][2];
        asm volatile("s_waitcnt lgkmcnt(0)" ::: "memory");
        {
            const bf16_t* qg = hb + (size_t)(q0 + krow) * INC + kchunk * 8;
#pragma unroll
            for (int i = 0; i < 8; ++i) __builtin_amdgcn_global_load_lds((const unsigned*)(qg + (size_t)i * 8 * INC), (LAS unsigned*)(wl + 8192 + i * 1024), 16, 0, 0);
        }
        const bf16_t* vb = vt + (size_t)((b * 8 + hh) * 64) * SEQ;
        const float* rbh = rb + hh * 257;
        const float cb2 = rbh[256];
        f32x4 oacc[4][4];
#pragma unroll
        for (int qi = 0; qi < 4; ++qi)
#pragma unroll
            for (int dt = 0; dt < 4; ++dt) oacc[qi][dt] = (f32x4){0.f, 0.f, 0.f, 0.f};
        float mrun[4] = {-1e30f, -1e30f, -1e30f, -1e30f}, lsum[4] = {0.f, 0.f, 0.f, 0.f};
        const int kstart = (c > 8 ? c - 8 : 0) * 64, kend = c * 64 + 64;
        const bf16_t* kg = hb + 512 + (size_t)krow * INC + kchunk * 8;
        const bf16_t* vg = vb + (size_t)vrow * SEQ + vchunk * 8;
#define AT_LOAD(buf, kt) do { _Pragma("unroll") for (int i = 0; i < 4; ++i) \
                __builtin_amdgcn_global_load_lds((const unsigned*)(kg + (size_t)((kt) + i * 8) * INC), (LAS unsigned*)(wl + (buf) * 8192 + i * 1024), 16, 0, 0); \
            _Pragma("unroll") for (int i = 0; i < 4; ++i) \
                __builtin_amdgcn_global_load_lds((const unsigned*)(vg + (size_t)i * 16 * SEQ + (kt)), (LAS unsigned*)(wl + (buf) * 8192 + 4096 + i * 1024), 16, 0, 0); } while (0)
#define AT_COMPUTE(buf, kt) do { \
            const bool far_ = ((kt) + 31 + 128 <= q0); \
            const unsigned char* bb_ = wl + (buf) * 8192; \
            bf16x8 kf[2][2], vf[4]; \
            _Pragma("unroll") for (int tt = 0; tt < 2; ++tt) _Pragma("unroll") for (int dh = 0; dh < 2; ++dh) kf[tt][dh] = *(const bf16x8*)(bb_ + koff[tt][dh]); \
            _Pragma("unroll") for (int dt = 0; dt < 4; ++dt) vf[dt] = *(const bf16x8*)(bb_ + voff[dt]); \
            _Pragma("unroll") for (int qi = 0; qi < 4; ++qi) { \
                f32x4 s[2]; \
                _Pragma("unroll") for (int tt = 0; tt < 2; ++tt) { f32x4 a = (f32x4){0.f, 0.f, 0.f, 0.f}; \
                    a = __builtin_amdgcn_mfma_f32_16x16x32_bf16(kf[tt][0], qf[qi][0], a, 0, 0, 0); \
                    a = __builtin_amdgcn_mfma_f32_16x16x32_bf16(kf[tt][1], qf[qi][1], a, 0, 0, 0); s[tt] = a; } \
                float mx = -1e30f; \
                if (far_) { _Pragma("unroll") for (int tt = 0; tt < 2; ++tt) _Pragma("unroll") for (int j = 0; j < 4; ++j) { const float v = s[tt][j] * (0.125f * L2E) + cb2; s[tt][j] = v; mx = fmaxf(mx, v); } } \
                else { const int qpos = q0 + qi * 16 + lr; float bz[8]; \
                    _Pragma("unroll") for (int tt = 0; tt < 2; ++tt) _Pragma("unroll") for (int j = 0; j < 4; ++j) { \
                        int rel = qpos - ((kt) + quad * 8 + tt * 4 + j); rel = rel > 128 ? 128 : (rel < -128 ? -128 : rel); bz[tt * 4 + j] = rbh[rel + 128]; } \
                    _Pragma("unroll") for (int tt = 0; tt < 2; ++tt) _Pragma("unroll") for (int j = 0; j < 4; ++j) { \
                        const float v = s[tt][j] * (0.125f * L2E) + bz[tt * 4 + j]; s[tt][j] = v; mx = fmaxf(mx, v); } } \
                mx = fmaxf(mx, shflx(mx, lane, 16)); mx = fmaxf(mx, shflx(mx, lane, 32)); \
                const float mnew = fmaxf(mrun[qi], mx), sc = __builtin_amdgcn_exp2f(mrun[qi] - mnew); \
                mrun[qi] = mnew; \
                float ps = 0.f; float pv[8]; \
                _Pragma("unroll") for (int tt = 0; tt < 2; ++tt) _Pragma("unroll") for (int j = 0; j < 4; ++j) { const float p = __builtin_amdgcn_exp2f(s[tt][j] - mnew); pv[tt * 4 + j] = p; ps += p; } \
                lsum[qi] = lsum[qi] * sc + ps; \
                const u32x4 pu = pack8(pv); bf16x8 pf; __builtin_memcpy(&pf, &pu, 16); \
                _Pragma("unroll") for (int dt = 0; dt < 4; ++dt) { \
                    f32x4 o = oacc[qi][dt]; \
                    _Pragma("unroll") for (int j = 0; j < 4; ++j) o[j] *= sc; \
                    oacc[qi][dt] = __builtin_amdgcn_mfma_f32_16x16x32_bf16(vf[dt], pf, o, 0, 0, 0); } \
            } } while (0)
        AT_LOAD(0, kstart);
        asm volatile("s_waitcnt vmcnt(8)" ::: "memory");
#pragma unroll
        for (int qi = 0; qi < 4; ++qi)
#pragma unroll
            for (int dh = 0; dh < 2; ++dh) { const int row = qi * 16 + lr; qf[qi][dh] = *(const bf16x8*)(wl + 8192 + row * 128 + (((dh * 4 + quad) ^ (row & 7)) * 16)); }
        asm volatile("s_waitcnt lgkmcnt(0)" ::: "memory");
        for (int kt0 = kstart; kt0 < kend; kt0 += 64) {
            AT_LOAD(1, kt0 + 32);
            asm volatile("s_waitcnt vmcnt(8)" ::: "memory");
            AT_COMPUTE(0, kt0);
            if (kt0 + 64 < kend) { AT_LOAD(0, kt0 + 64); asm volatile("s_waitcnt vmcnt(8)" ::: "memory"); }
            else asm volatile("s_waitcnt vmcnt(0)" ::: "memory");
            AT_COMPUTE(1, kt0 + 32);
        }
#undef AT_LOAD
#undef AT_COMPUTE
#pragma unroll
        for (int qi = 0; qi < 4; ++qi) {
            float l = lsum[qi]; l += shflx(l, lane, 16); l += shflx(l, lane, 32);
            const float inv = __builtin_amdgcn_rcpf(l);
#pragma unroll
            for (int dt = 0; dt < 4; ++dt) {
                u32x2 pk; pk[0] = cvt_pk_bf16(oacc[qi][dt][0] * inv, oacc[qi][dt][1] * inv); pk[1] = cvt_pk_bf16(oacc[qi][dt][2] * inv, oacc[qi][dt][3] * inv);
                *(u32x2*)(wl + (qi * 16 + lr) * 136 + (dt * 16 + quad * 4) * 2) = pk;
            }
        }
        asm volatile("" ::: "memory");
#pragma unroll
        for (int i = 0; i < 8; ++i) {
            const int row = i * 8 + krow;
            *(u32x4*)(yd + (size_t)(b * SEQ + q0 + row) * DMIX + hh * 64 + (lane & 7) * 8) = *(const u32x4*)(wl + row * 136 + (lane & 7) * 16);
        }
    }
    __syncthreads();
}

__device__ __forceinline__ int lru_phase(const int tid_, const int bid_, const int gdim_, unsigned char* lds, const bf16_t* __restrict__ h, const float* __restrict__ conv_w, const float* __restrict__ conv_b,
                          const float* __restrict__ wrp, const float* __restrict__ brp, const float* __restrict__ wip, const float* __restrict__ bip,
                          const float* __restrict__ lam, bf16_t* __restrict__ ya_out, bf16_t* __restrict__ vt) {
    bf16_t* vtile = (bf16_t*)(lds + 131088);
    bf16_t* WrT = (bf16_t*)lds;
    bf16_t* WiT = WrT + 64 * 72;
    bf16_t* xcb = WiT + 64 * 72;
    bf16_t* xraw = xcb + 64 * 72;
    bf16_t* yraw = xraw + 67 * 64 + 64;
    float* xcf = (float*)(yraw + 64 * 64);
    float* abuf = xcf + 4096;
    float* ubuf = abuf + 4096;
    float* ibuf = ubuf + 4096;
    float* hbuf = ibuf + 4096;
    float* gbuf = xcf;
    const int tid = tid_, lane = tid & 63, wid = tid >> 6, lr = lane & 15, quad = lane >> 4;
    int vt_it = bid_; u32x4 vt_u = (u32x4){0u, 0u, 0u, 0u};
    if (vt_it < BATCH * 8 * 32) { const int bh = vt_it >> 5, tcv = vt_it & 31; vt_u = *(const u32x4*)(h + (size_t)((bh >> 3) * SEQ + tcv * 64 + (tid >> 3)) * INC + COL_D + 1024 + (bh & 7) * 64 + (tid & 7) * 8); }
    for (int item = bid_; item < BATCH * 8; item += gdim_) {
        const int b = item >> 3, g = item & 7;
        __syncthreads();
        for (int e = tid; e < 4096; e += 512) { const int i = e >> 6, j = e & 63;
            WrT[j * 72 + i] = f2bf(wrp[(size_t)g * 4096 + e]); WiT[j * 72 + i] = f2bf(wip[(size_t)g * 4096 + e]); }
        const int ch = tid & 63, trow = tid >> 6;
        const int cg_ = g * 64 + ch;
        const float cw0 = conv_w[cg_], cw1 = conv_w[512 + cg_], cw2 = conv_w[1024 + cg_], cw3 = conv_w[1536 + cg_], cb = conv_b[cg_];
        const int r8 = tid >> 3, pc = (tid & 7) * 8;
        const bf16_t* hrow = h + (size_t)(b * SEQ + r8) * INC + COL_A + g * 64 + pc;
        u32x4 xa16 = *(const u32x4*)hrow, ya16 = *(const u32x4*)(hrow + 512), prev16 = (u32x4){0u, 0u, 0u, 0u};
        float hstate = 0.f;
        for (int tc = 0; tc < SEQ / 64; ++tc) {
            const int t0 = tc * 64;
            *(u32x4*)(xraw + (3 + r8) * 64 + pc) = xa16; *(u32x4*)(yraw + r8 * 64 + pc) = ya16;
            if (r8 >= 61) *(u32x4*)(xraw + (r8 - 61) * 64 + pc) = prev16;
            prev16 = xa16;
            if (tc + 1 < SEQ / 64) { const bf16_t* nx = hrow + (size_t)(t0 + 64) * INC; xa16 = *(const u32x4*)nx; ya16 = *(const u32x4*)(nx + 512); }
            const int vt_cur = vt_it;
            if (vt_cur < BATCH * 8 * 32) {
#pragma unroll
                for (int j = 0; j < 4; ++j) { vtile[(pc + 2 * j) * 72 + r8] = (bf16_t)(vt_u[j] & 0xffffu); vtile[(pc + 2 * j + 1) * 72 + r8] = (bf16_t)(vt_u[j] >> 16); }
                vt_it += gdim_;
                if (vt_it < BATCH * 8 * 32) { const int bh = vt_it >> 5, tcv = vt_it & 31; vt_u = *(const u32x4*)(h + (size_t)((bh >> 3) * SEQ + tcv * 64 + r8) * INC + COL_D + 1024 + (bh & 7) * 64 + pc); }
            }
            LDS_BARRIER();
            if (vt_cur < BATCH * 8 * 32) { const int bh = vt_cur >> 5, tcv = vt_cur & 31;
                *(u32x4*)(vt + (size_t)(bh * 64 + r8) * SEQ + tcv * 64 + pc) = *(const u32x4*)(vtile + r8 * 72 + pc); }
#pragma unroll
            for (int i = 0; i < 8; ++i) {
                const int tl = trow + 8 * i;
                const float x3 = bf2f(xraw[tl * 64 + ch]), x2 = bf2f(xraw[(tl + 1) * 64 + ch]), x1 = bf2f(xraw[(tl + 2) * 64 + ch]), x0 = bf2f(xraw[(tl + 3) * 64 + ch]);
                const float xc = cw3 * x0 + cw2 * x1 + cw1 * x2 + cw0 * x3 + cb;
                xcf[tl * 64 + ch] = xc; xcb[tl * 72 + ch] = f2bf(xc);
            }
            LDS_BARRIER();
            {
                const int tt = wid & 3, which = wid >> 2;
                const bf16_t* WT = which ? WiT : WrT;
                const bf16x8 a0 = *(const bf16x8*)(xcb + (tt * 16 + lr) * 72 + quad * 8), a1 = *(const bf16x8*)(xcb + (tt * 16 + lr) * 72 + 32 + quad * 8);
#pragma unroll
                for (int jt = 0; jt < 4; ++jt) {
                    const bf16x8 b0 = *(const bf16x8*)(WT + (jt * 16 + lr) * 72 + quad * 8), b1 = *(const bf16x8*)(WT + (jt * 16 + lr) * 72 + 32 + quad * 8);
                    f32x4 cacc = (f32x4){0.f, 0.f, 0.f, 0.f};
                    cacc = __builtin_amdgcn_mfma_f32_16x16x32_bf16(a0, b0, cacc, 0, 0, 0);
                    cacc = __builtin_amdgcn_mfma_f32_16x16x32_bf16(a1, b1, cacc, 0, 0, 0);
                    const int j = jt * 16 + lr, cj = g * 64 + j;
                    if (which == 0) {
                        const float bias = brp[cj], lm = lam[cj];
                        const float sp = fmaxf(-lm, 0.f) + flog1p_small(fexp(-fabsf(lm)));
#pragma unroll
                        for (int jj = 0; jj < 4; ++jj) {
                            const int tl = tt * 16 + quad * 4 + jj;
                            const float r = sigmoidf_(cacc[jj] + bias);
                            const float la = -8.0f * r * sp;
                            abuf[tl * 64 + j] = fexp(la);
                            ubuf[tl * 64 + j] = __builtin_amdgcn_sqrtf(fneg_expm1(2.0f * la)) * xcf[tl * 64 + j];
                        }
                    } else {
                        const float bias = bip[cj];
#pragma unroll
                        for (int jj = 0; jj < 4; ++jj) { const int tl = tt * 16 + quad * 4 + jj; ibuf[tl * 64 + j] = sigmoidf_(cacc[jj] + bias); }
                    }
                }
            }
            LDS_BARRIER();
            if (wid == 0) {
#pragma unroll 8
                for (int tl = 0; tl < 64; ++tl) { hstate = abuf[tl * 64 + lane] * hstate + ubuf[tl * 64 + lane] * ibuf[tl * 64 + lane]; hbuf[tl * 64 + lane] = hstate; }
            } else {
                for (int e = tid - 64; e < 4096; e += 448) {
                    const float y = bf2f(yraw[e]);
                    gbuf[e] = 0.5f * y * (1.0f + ftanh(0.7978845608028654f * (y + 0.044715f * y * y * y)));
                }
            }
            LDS_BARRIER();
            {
                float o[8];
                const f32x4 h0 = *(const f32x4*)(hbuf + r8 * 64 + pc), h1 = *(const f32x4*)(hbuf + r8 * 64 + pc + 4);
                const f32x4 g0 = *(const f32x4*)(gbuf + r8 * 64 + pc), g1 = *(const f32x4*)(gbuf + r8 * 64 + pc + 4);
#pragma unroll
                for (int j = 0; j < 4; ++j) { o[j] = h0[j] * g0[j]; o[4 + j] = h1[j] * g1[j]; }
                *(u32x4*)(ya_out + (size_t)(b * SEQ + t0 + r8) * DMIX + g * 64 + pc) = pack8(o);
            }
        }
    }
    __syncthreads();
    return vt_it;
}

constexpr int RT = 16, REC = 456;
__device__ __forceinline__ float dpp_x1(float v) { return __int_as_float(__builtin_amdgcn_update_dpp(0, __float_as_int(v), 0xB1, 0xF, 0xF, true)); }
__device__ __forceinline__ float dpp_x2(float v) { return __int_as_float(__builtin_amdgcn_update_dpp(0, __float_as_int(v), 0x4E, 0xF, 0xF, true)); }
__device__ __forceinline__ void rwkv_phase(const int tid_, const int bid_, const int gdim_, unsigned char* lds, const bf16_t* __restrict__ h, const float* __restrict__ mu, const float* __restrict__ w0p, const float* __restrict__ w2p,
                           const float* __restrict__ a0p, const float* __restrict__ a2p, const float* __restrict__ g2p, const float* __restrict__ kkp, const float* __restrict__ kap,
                           const float* __restrict__ rkp, const float* __restrict__ gng, const float* __restrict__ gnb, bf16_t* __restrict__ yc) {
    bf16_t* W2T = (bf16_t*)lds;
    bf16_t* A2T = W2T + 64 * 72;
    bf16_t* G2T = A2T + 64 * 72;
    bf16_t* linb = G2T + 64 * 136;
    float* lo = (float*)(linb + 4 * 4 * 264);
    float* rec = lo + 4 * 4 * 192;
    float* obuf = rec + 2 * RT * REC;
    const int tid = tid_, lane = tid & 63, wid = __builtin_amdgcn_readfirstlane(tid >> 6);
    constexpr int NC = SEQ / RT;
    for (int item = bid_; item < BATCH * 8; item += gdim_) {
        const int b = item >> 3, hh = item & 7, hj = hh * 64 + lane;
        __syncthreads();
        for (int e = tid; e < 4096; e += 512) { const int i = e >> 6, j = e & 63; W2T[j * 72 + i] = f2bf(w2p[i * 512 + hh * 64 + j]); A2T[j * 72 + i] = f2bf(a2p[i * 512 + hh * 64 + j]); }
        for (int e = tid; e < 8192; e += 512) { const int i = e >> 6, j = e & 63; G2T[j * 136 + i] = f2bf(g2p[i * 512 + hh * 64 + j]); }
        __syncthreads();
        if (wid < 4) {
            const int r = lane >> 2, kq = lane & 3, row = wid * 16 + r;
            f32x2 S[8];
#pragma unroll
            for (int i = 0; i < 8; ++i) S[i] = (f32x2){0.f, 0.f};
            LDS_BARRIER();
            for (int c = 0; c < NC; ++c) {
                const float* R0 = rec + (c & 1) * RT * REC + kq * 16;
                float* ob = obuf + (c & 1) * RT * 64 + row;
                f32x4 dt[2][8], up[2][12]; float vv[2]; f32x2 scs[2];
#define RW_LOAD(buf, t) do { const float* Rk = R0 + (t) * REC; _Pragma("unroll") for (int i = 0; i < 4; ++i) { dt[buf][i] = *(const f32x4*)(Rk + 4 * i); dt[buf][4 + i] = *(const f32x4*)(Rk + 64 + 4 * i); } \
                    vv[buf] = Rk[320 - kq * 16 + row]; scs[buf] = *(const f32x2*)(Rk + 448 - kq * 16); \
                    _Pragma("unroll") for (int q = 0; q < 3; ++q) _Pragma("unroll") for (int i = 0; i < 4; ++i) up[buf][q * 4 + i] = *(const f32x4*)(Rk + 128 + q * 64 + 4 * i); } while (0)
                RW_LOAD(0, 0);
#pragma unroll
                for (int t = 0; t < RT; ++t) {
                    const int cb = t & 1;
                    if (t + 1 < RT) RW_LOAD(cb ^ 1, t + 1);
                    const float vval = vv[cb];
                    f32x2 sa0 = (f32x2){0.f, 0.f}, sa1 = (f32x2){0.f, 0.f}, yp0 = (f32x2){0.f, 0.f}, yp1 = (f32x2){0.f, 0.f};
#pragma unroll
                    for (int i = 0; i < 4; ++i) {
                        const f32x4 ah = dt[cb][i], wr = dt[cb][4 + i];
                        sa0 += S[2 * i] * (f32x2){ah[0], ah[1]}; sa1 += S[2 * i + 1] * (f32x2){ah[2], ah[3]};
                        yp0 += S[2 * i] * (f32x2){wr[0], wr[1]}; yp1 += S[2 * i + 1] * (f32x2){wr[2], wr[3]};
                    }
                    sa0 += sa1; yp0 += yp1;
                    float sa = sa0[0] + sa0[1], yp = yp0[0] + yp0[1];
                    sa += dpp_x1(sa); yp += dpp_x1(yp);
                    sa += dpp_x2(sa); yp += dpp_x2(yp);
                    if (kq == 0) ob[t * 64] = yp + sa * scs[cb][0] + vval * scs[cb][1];
                    const f32x2 sav = (f32x2){sa, sa}, vvv = (f32x2){vval, vval};
#pragma unroll
                    for (int i = 0; i < 4; ++i) {
                        const f32x4 dc = up[cb][i], bb = up[cb][4 + i], kp = up[cb][8 + i];
                        S[2 * i] = S[2 * i] * (f32x2){dc[0], dc[1]} + sav * (f32x2){bb[0], bb[1]} + vvv * (f32x2){kp[0], kp[1]};
                        S[2 * i + 1] = S[2 * i + 1] * (f32x2){dc[2], dc[3]} + sav * (f32x2){bb[2], bb[3]} + vvv * (f32x2){kp[2], kp[3]};
                    }
                }
#undef RW_LOAD
                LDS_BARRIER();
            }
        } else {
            const int p = wid - 4, lr = lane & 15, quad = lane >> 4;
            bf16_t* lb = linb + p * 4 * 264;
            float* lop = lo + p * 4 * 192;
            const float mu_r = mu[hj], mu_k = mu[512 + hj], mu_v = mu[1024 + hj];
            float mu_l[4];
#pragma unroll
            for (int q = 0; q < 4; ++q) mu_l[q] = mu[1536 + lane + 64 * q];
            const float w0 = w0p[hj], a0 = a0p[hj], k_k = kkp[hj], k_a = kap[hj], r_k = rkp[hj], gn_g = gng[hj], gn_b = gnb[hj];
            const bf16_t* hC = h + (size_t)b * SEQ * INC + COL_C;
            unsigned zraw[5][7];
#define RW_GLOAD(cn) do { _Pragma("unroll") for (int rw = 0; rw < 5; ++rw) { const int t = (cn) * RT + p * 4 + rw - 1; \
                    const bf16_t* ptr = hC + (size_t)(t < 0 ? 0 : t) * INC; \
                    zraw[rw][0] = ptr[hj]; zraw[rw][1] = ptr[512 + hj]; zraw[rw][2] = ptr[1024 + hj]; \
                    _Pragma("unroll") for (int q = 0; q < 4; ++q) zraw[rw][3 + q] = ptr[1536 + lane + 64 * q]; } } while (0)
            RW_GLOAD(0);
            for (int c = -1; c < NC; ++c) {
                const bool do_prep = (c + 1 < NC), do_post = (c >= 1);
                float cr[5], ck[5], cv[5], cl[5][4];
#pragma unroll
                for (int rw = 0; rw < 5; ++rw) { cr[rw] = bf2f(zraw[rw][0]); ck[rw] = bf2f(zraw[rw][1]); cv[rw] = bf2f(zraw[rw][2]);
#pragma unroll
                    for (int q = 0; q < 4; ++q) cl[rw][q] = bf2f(zraw[rw][3 + q]); }
                if (c == -1 && p == 0) { cr[0] = 0.f; ck[0] = 0.f; cv[0] = 0.f; cl[0][0] = 0.f; cl[0][1] = 0.f; cl[0][2] = 0.f; cl[0][3] = 0.f; }
                if (c + 2 < NC) RW_GLOAD(c + 2);
                if (do_post) {
                    const float* Rb = rec + ((c - 1) & 1) * RT * REC;
                    const float* ob = obuf + ((c - 1) & 1) * RT * 64;
                    float ov[4], sm[8];
#pragma unroll
                    for (int u = 0; u < 4; ++u) { ov[u] = ob[(p * 4 + u) * 64 + lane]; sm[2 * u] = ov[u]; sm[2 * u + 1] = ov[u] * ov[u]; }
                    wave_sum_n<8>(sm);
#pragma unroll
                    for (int u = 0; u < 4; ++u) {
                        const int tt = p * 4 + u, t = (c - 1) * RT + tt;
                        const float* R = Rb + tt * REC;
                        const float mean = sm[2 * u] * (1.0f / 64.0f), var = fmaxf(sm[2 * u + 1] * (1.0f / 64.0f) - mean * mean, 0.f);
                        float o = (ov[u] - mean) * __builtin_amdgcn_rsqf(var + GN_EPS) * gn_g + gn_b;
                        o += R[450] * R[320 + lane];
                        yc[(size_t)(b * SEQ + t) * DMIX + hj] = f2bf(o * R[384 + lane]);
                    }
                }
                if (do_prep) {
                    float rr[4], kx[4], vx[4];
#pragma unroll
                    for (int u = 0; u < 4; ++u) {
                        rr[u] = cr[u + 1] + (cr[u] - cr[u + 1]) * mu_r; kx[u] = ck[u + 1] + (ck[u] - ck[u + 1]) * mu_k; vx[u] = cv[u + 1] + (cv[u] - cv[u + 1]) * mu_v;
#pragma unroll
                        for (int q = 0; q < 4; ++q) {
                            const float z = cl[u + 1][q] + (cl[u][q] - cl[u + 1][q]) * mu_l[q];
                            const float val = (q == 0) ? ftanh(z) : (q == 1 ? z : sigmoidf_(z));
                            lb[u * 264 + lane + 64 * q] = f2bf(val);
                        }
                    }
                    asm volatile("s_waitcnt lgkmcnt(0)" ::: "memory");
                    bf16x8 af[8];
#pragma unroll
                    for (int k8 = 0; k8 < 8; ++k8) af[k8] = *(const bf16x8*)(lb + (lane & 3) * 264 + k8 * 32 + quad * 8);
#pragma unroll
                    for (int jt = 0; jt < 4; ++jt) {
                        f32x4 cw = (f32x4){0.f, 0.f, 0.f, 0.f}, ca = cw, cgm = cw;
#pragma unroll
                        for (int kh = 0; kh < 2; ++kh) {
                            cw = __builtin_amdgcn_mfma_f32_16x16x32_bf16(af[kh], *(const bf16x8*)(W2T + (jt * 16 + lr) * 72 + kh * 32 + quad * 8), cw, 0, 0, 0);
                            ca = __builtin_amdgcn_mfma_f32_16x16x32_bf16(af[2 + kh], *(const bf16x8*)(A2T + (jt * 16 + lr) * 72 + kh * 32 + quad * 8), ca, 0, 0, 0);
                        }
#pragma unroll
                        for (int kh = 0; kh < 4; ++kh)
                            cgm = __builtin_amdgcn_mfma_f32_16x16x32_bf16(af[4 + kh], *(const bf16x8*)(G2T + (jt * 16 + lr) * 136 + kh * 32 + quad * 8), cgm, 0, 0, 0);
                        if (quad == 0) {
#pragma unroll
                            for (int jj = 0; jj < 4; ++jj) { lop[jj * 192 + jt * 16 + lr] = cw[jj]; lop[jj * 192 + 64 + jt * 16 + lr] = ca[jj]; lop[jj * 192 + 128 + jt * 16 + lr] = cgm[jj]; }
                        }
                    }
                    asm volatile("s_waitcnt lgkmcnt(0)" ::: "memory");
                    float* Rb = rec + ((c + 1) & 1) * RT * REC;
                    float dcy[4], av[4], kqv[4], kpv[4], ggv[4], red[16];
#pragma unroll
                    for (int u = 0; u < 4; ++u) {
                        const float wl = w0 + lop[u * 192 + lane], ap = a0 + lop[u * 192 + 64 + lane]; ggv[u] = lop[u * 192 + 128 + lane];
                        const float z = -wl;
                        const float sp = fmaxf(z, 0.f) + flog(1.0f + fexp(-fabsf(z)));
                        dcy[u] = fexp(-fexp(-sp - 0.5f));
                        av[u] = sigmoidf_(ap);
                        kqv[u] = kx[u] * k_k;
                        kpv[u] = kx[u] * (1.0f + (av[u] - 1.0f) * k_a);
                        red[4 * u] = kqv[u] * kqv[u]; red[4 * u + 1] = kqv[u] * av[u] * rr[u]; red[4 * u + 2] = kpv[u] * rr[u]; red[4 * u + 3] = rr[u] * kpv[u] * r_k;
                    }
                    wave_sum_n<16>(red);
#pragma unroll
                    for (int u = 0; u < 4; ++u) {
                        const int tt = p * 4 + u;
                        const float inv = __builtin_amdgcn_rcpf(fmaxf(__builtin_amdgcn_sqrtf(red[4 * u]), 1e-12f));
                        const float kkn = kqv[u] * inv;
                        float* R = Rb + tt * REC;
                        R[lane] = -kkn; R[64 + lane] = dcy[u] * rr[u]; R[128 + lane] = dcy[u]; R[192 + lane] = kkn * av[u]; R[256 + lane] = kpv[u]; R[320 + lane] = vx[u]; R[384 + lane] = ggv[u];
                        if (lane == 0) { R[448] = red[4 * u + 1] * inv; R[449] = red[4 * u + 2]; R[450] = red[4 * u + 3]; }
                    }
                }
                LDS_BARRIER();
            }
#undef RW_GLOAD
            {
                const float* Rb = rec + ((NC - 1) & 1) * RT * REC;
                const float* ob = obuf + ((NC - 1) & 1) * RT * 64;
                float ov[4], sm[8];
#pragma unroll
                for (int u = 0; u < 4; ++u) { ov[u] = ob[(p * 4 + u) * 64 + lane]; sm[2 * u] = ov[u]; sm[2 * u + 1] = ov[u] * ov[u]; }
                wave_sum_n<8>(sm);
#pragma unroll
                for (int u = 0; u < 4; ++u) {
                    const int tt = p * 4 + u, t = (NC - 1) * RT + tt;
                    const float* R = Rb + tt * REC;
                    const float mean = sm[2 * u] * (1.0f / 64.0f), var = fmaxf(sm[2 * u + 1] * (1.0f / 64.0f) - mean * mean, 0.f);
                    float o = (ov[u] - mean) * __builtin_amdgcn_rsqf(var + GN_EPS) * gn_g + gn_b;
                    o += R[450] * R[320 + lane];
                    yc[(size_t)(b * SEQ + t) * DMIX + hj] = f2bf(o * R[384 + lane]);
                }
            }
        }
    }
    __syncthreads();
}

#define XB_TMO      128
#define XB_XCNT(j)  (256  + 64 * (j))
#define XB_XSUB(j)  (1280 + 64 * (j))
#define XB_XGEN(j)  (2304 + 64 * (j))
#define XB_TOP      3328
#define XB_TOPGEN   3392
#define XCD_BAR_WORDS 3456
#define XB_SPIN_CAP (1u << 18)
__device__ __forceinline__ unsigned xb_ld(unsigned* p)              { return __hip_atomic_load(p, __ATOMIC_RELAXED, __HIP_MEMORY_SCOPE_AGENT); }
__device__ __forceinline__ unsigned xb_add(unsigned* p, unsigned v) { return __hip_atomic_fetch_add(p, v, __ATOMIC_RELAXED, __HIP_MEMORY_SCOPE_AGENT); }
__device__ __forceinline__ unsigned xb_xcc_id() { return (unsigned)__builtin_amdgcn_s_getreg((3 << 11) | 20) & 0xFu; }
#define XB_SPIN(cond, bar) do { unsigned _sp = 0; while (cond) { __builtin_amdgcn_s_sleep(1); \
    if ((++_sp & 255u) == 0u) { if (xb_ld(&(bar)[XB_TMO])) break; if (_sp > XB_SPIN_CAP) { atomicAdd(&(bar)[XB_TMO], 1u); break; } } } } while (0)
struct XcdBarrier { unsigned* bar; unsigned x; volatile LAS unsigned* st; };
__device__ __forceinline__ XcdBarrier xcd_barrier_post(unsigned* bar, volatile LAS unsigned* st) {
    XcdBarrier b; b.bar = bar; b.x = xb_xcc_id(); b.st = st;
    if (threadIdx.x == 0) (void)xb_add(&bar[XB_XCNT(b.x)], 1u);
    return b;
}
__device__ __forceinline__ void xcd_barrier_complete(unsigned* bar, unsigned x, unsigned& nloc, unsigned& nx) {
    const unsigned G = gridDim.x;
    unsigned sum, cnt, mine, sp = 0u;
    for (;;) {
        sum = 0u; cnt = 0u; mine = 0u;
#pragma unroll
        for (unsigned j = 0; j < 16; ++j) { const unsigned c = xb_ld(&bar[XB_XCNT(j)]); sum += c; cnt += (c > 0u) ? 1u : 0u; mine = (j == x) ? c : mine; }
        if (sum == G) break;
        __builtin_amdgcn_s_sleep(1);
        if ((++sp & 255u) == 0u) { if (xb_ld(&bar[XB_TMO])) break; if (sp > XB_SPIN_CAP) { atomicAdd(&bar[XB_TMO], 1u); break; } }
    }
    nloc = mine > 0u ? mine : 1u; nx = cnt > 0u ? cnt : 1u;
}
__device__ __forceinline__ void xcd_barrier(const XcdBarrier& b, const int tid) {
    asm volatile("s_waitcnt vmcnt(0)" ::: "memory");
    __syncthreads();
    if (tid == 0) {
        unsigned* bar = b.bar;
        __builtin_amdgcn_s_waitcnt(0);
        unsigned nloc = b.st[0], nx = b.st[1];
        if (nloc == 0u) { xcd_barrier_complete(bar, b.x, nloc, nx); b.st[0] = nloc; b.st[1] = nx; }
        const unsigned old = xb_add(&bar[XB_XSUB(b.x)], 1u);
        const unsigned gen = old / nloc;
        if (old + 1u == (gen + 1u) * nloc) {
            __builtin_amdgcn_fence(__ATOMIC_RELEASE, "agent");
            asm volatile("s_waitcnt vmcnt(0)" ::: "memory");
            const unsigned og = xb_add(&bar[XB_TOP], 1u);
            const unsigned tg = og / nx;
            if (og + 1u == (tg + 1u) * nx) xb_add(&bar[XB_TOPGEN], 1u);
            else XB_SPIN(xb_ld(&bar[XB_TOPGEN]) == tg, bar);
            __builtin_amdgcn_fence(__ATOMIC_ACQUIRE, "agent");
            xb_add(&bar[XB_XGEN(b.x)], 1u);
            asm volatile("s_waitcnt vmcnt(0)" ::: "memory");
        } else {
            XB_SPIN(xb_ld(&bar[XB_XGEN(b.x)]) == gen, bar);
            __builtin_amdgcn_fence(__ATOMIC_ACQUIRE, "agent");
            asm volatile("s_waitcnt vmcnt(0)" ::: "memory");
        }
    }
    __syncthreads();
}

constexpr int NPH = 12;
__global__ void __launch_bounds__(512, 2) mega(Params P, int ph_lo, int ph_hi) {
    extern __shared__ __attribute__((aligned(16))) unsigned char shm[];
    LAS unsigned char* lds = (LAS unsigned char*)shm;
    cg::grid_group grid = cg::this_grid();
    const int swid = __builtin_amdgcn_readfirstlane((int)threadIdx.x >> 6);
    volatile LAS unsigned* xst = (volatile LAS unsigned*)(lds + 131072);
    if (threadIdx.x < 2) xst[threadIdx.x] = 0u;
    __syncthreads();
    const XcdBarrier xbar = xcd_barrier_post((unsigned*)(P.ws + WS_BAR), xst);
    unsigned char* ws = P.ws;
    bf16_t* xb = (bf16_t*)(ws + WS_XB);
    bf16_t* wt = (bf16_t*)(ws + WS_WT);
    bf16_t* pb = (bf16_t*)(ws + WS_PB);
    bf16_t* hbuf = (bf16_t*)(ws + WS_H);
    bf16_t* vt = (bf16_t*)(ws + WS_VT);
    bf16_t* pq = hbuf;
    bf16_t* ubuf = hbuf;
    bf16_t* plb = (bf16_t*)(ws + WS_H + 512 * MiB);
    bf16_t* ybase = (bf16_t*)P.out;
    bf16_t* mb = plb;
    for (int ph = ph_lo; ph < ph_hi; ++ph) {
        const int l = ph / NPH, k = ph % NPH;
        const int njobs = (k == 1 || k == 5 || k == 6 || k == 9 || k == 10) ? 1 : (k == 4 ? 4 : (k == 8 ? 2 : 0));
        for (int rep = 0; rep < ((k == REPK) ? REPN : 1); ++rep) {
        int bid_ = blockIdx.x, gdim_ = gridDim.x; asm volatile("" : "+s"(bid_)); asm volatile("" : "+s"(gdim_)); int z_ = 0; asm volatile("" : "+s"(z_));
        int tid_ = (swid << 6) + (int)__builtin_amdgcn_mbcnt_hi(~0u, __builtin_amdgcn_mbcnt_lo(~0u, (unsigned)z_)); asm volatile("" : "+v"(tid_));
        if (njobs) {
            for (int n = 0; n < njobs; ++n) {
                pg8::Epi E; E.mode = 0; E.act = 0; E.ob = nullptr; E.ldo = 0; E.bias = nullptr; E.io2 = nullptr; E.resf = nullptr; E.aux = nullptr;
                pg8::Gemm g; g.M = MTOK; g.A = xb; g.lda = D; g.K = D; g.Bt = wt; g.ldb = D; g.N = D;
                int merge = 0;
                if (k == 1) { E.ob = hbuf; E.ldo = INC; g.Bt = wt + WO_IN; g.N = INC; }
                else if (k == 4) { E.ob = pq + (size_t)n * D; E.ldo = 4 * D; g.A = ybase + (size_t)n * MTOK * DMIX; g.lda = DMIX; g.K = DMIX; g.Bt = wt + WO_B + (size_t)n * D * DMIX; g.ldb = DMIX; }
                else if (k == 5) { E.mode = 3; E.ob = pq; E.ldo = 4 * D; E.bias = P.in[25 + z_] + (size_t)l * 4 * D; E.io2 = mb; g.Bt = wt + WO_G; g.N = 4 * D; merge = 1; }
                else if (k == 6) { E.mode = 2; E.io2 = xb; if (l == 0) E.resf = P.in[0 + z_]; g.A = mb; g.Bt = wt + WO_OUT4; }
                else if (k == 8 && n == 0) { E.act = 1; E.ob = ubuf; E.ldo = DFF; g.Bt = wt + WO_FF1; g.N = DFF; }
                else if (k == 8) { E.ob = plb; E.ldo = D; g.A = pb; g.lda = DPLE; g.K = DPLE; g.Bt = wt + WO_PLE; g.ldb = DPLE; }
                else if (k == 9) { E.mode = 1; E.ob = plb; E.ldo = D; E.bias = P.in[33 + z_] + (size_t)l * D; g.Bt = wt + WO_PLEG; }
                else { E.mode = 2; E.io2 = xb; E.aux = plb; g.A = ubuf; g.lda = DFF; g.K = DFF; g.Bt = wt + WO_FF2; g.ldb = DFF; }
                pg8::StaticOrder S; S.init(g.M, g.N, gdim_, bid_, merge);
                pg8::gemm_phase(tid_, lds, g, S, E);
                __syncthreads();
            }
        } else if (k == 0) {
            float* tile = (float*)shm;
            tconv(tid_, bid_, gdim_, tile, P.in[2 + z_] + (size_t)l * D * INC, D, INC, wt + WO_IN, D);
            for (int n = 0; n < 4; ++n) tconv(tid_, bid_, gdim_, tile, P.in[24 + z_] + ((size_t)l * 4 + n) * D * D, D, D, wt + WO_G + (size_t)n * D * D, D);
            for (int n = 0; n < 4; ++n) tconv(tid_, bid_, gdim_, tile, P.in[23 + z_] + ((size_t)l * 4 + n) * DMIX * D, DMIX, D, wt + WO_B + (size_t)n * D * DMIX, DMIX);
            tconv(tid_, bid_, gdim_, tile, P.in[26 + z_] + (size_t)l * D * D, D, D, wt + WO_OUT4, D);
            tconv(tid_, bid_, gdim_, tile, P.in[29 + z_] + (size_t)l * D * DFF, D, DFF, wt + WO_FF1, D);
            tconv(tid_, bid_, gdim_, tile, P.in[30 + z_] + (size_t)l * DFF * D, DFF, D, wt + WO_FF2, DFF);
            tconv(tid_, bid_, gdim_, tile, P.in[31 + z_] + (size_t)l * DPLE * D, DPLE, D, wt + WO_PLE, DPLE);
            tconv(tid_, bid_, gdim_, tile, P.in[32 + z_] + (size_t)l * D * D, D, D, wt + WO_PLEG, D);
            econv(tid_, bid_, gdim_, P.in[1 + z_] + (size_t)l * MTOK * DPLE, pb, (size_t)MTOK * DPLE);
            if (l == 0) econv(tid_, bid_, gdim_, P.in[0 + z_], xb, (size_t)MTOK * D);
        } else if (k == 2) {
            int vt_next = bid_;
            for (int r2 = 0; r2 < REP_LRU; ++r2) { int t2_ = tid_, b2_ = bid_; asm volatile("" : "+v"(t2_)); asm volatile("" : "+s"(b2_));
            vt_next = lru_phase(t2_, b2_, gdim_, shm, hbuf, P.in[3 + z_] + (size_t)l * 4 * DMIX, P.in[4 + z_] + (size_t)l * DMIX, P.in[5 + z_] + (size_t)l * 8 * 4096, P.in[6 + z_] + (size_t)l * DMIX,
                      P.in[7 + z_] + (size_t)l * 8 * 4096, P.in[8 + z_] + (size_t)l * DMIX, P.in[9 + z_] + (size_t)l * DMIX, ybase, vt);
            }
            for (int r2 = 0; r2 < REP_RWKV; ++r2) { int t2_ = tid_, b2_ = bid_; asm volatile("" : "+v"(t2_)); asm volatile("" : "+s"(b2_));
            rwkv_phase(t2_, b2_, gdim_, shm, hbuf, P.in[11 + z_] + (size_t)l * 1792, P.in[12 + z_] + (size_t)l * DMIX, P.in[13 + z_] + (size_t)l * 64 * DMIX, P.in[14 + z_] + (size_t)l * DMIX,
                       P.in[15 + z_] + (size_t)l * 64 * DMIX, P.in[16 + z_] + (size_t)l * 128 * DMIX, P.in[17 + z_] + (size_t)l * DMIX, P.in[18 + z_] + (size_t)l * DMIX,
                       P.in[19 + z_] + (size_t)l * DMIX, P.in[20 + z_] + (size_t)l * DMIX, P.in[21 + z_] + (size_t)l * DMIX, ybase + (size_t)2 * MTOK * DMIX);
            }
            for (int r2 = 0; r2 < REP_SV; ++r2) { int t2_ = tid_, b2_ = bid_; asm volatile("" : "+v"(t2_)); asm volatile("" : "+s"(b2_));
            sconv_phase(t2_, b2_, gdim_, hbuf, P.in[10 + z_] + (size_t)l * 3 * DMIX, ybase + (size_t)1 * MTOK * DMIX);
            vtrans_phase(t2_, vt_next, gdim_, (bf16_t*)shm, hbuf, vt);
            }
        } else if (k == 3) {
            attn_phase(tid_, bid_, gdim_, shm, hbuf, vt, P.in[22 + z_], ybase + (size_t)3 * MTOK * DMIX);
        } else if (k == 7) {
            ln_phase(tid_, bid_, gdim_, xb, P.in[27 + z_] + (size_t)l * D, P.in[28 + z_] + (size_t)l * D, nullptr);
        } else {
            ln_phase(tid_, bid_, gdim_, xb, P.in[34 + z_] + (size_t)l * D, P.in[35 + z_] + (size_t)l * D, l == DEPTH - 1 ? P.out : nullptr);
        }
        }
        if (ph + 1 < ph_hi) { if (ph == ph_lo) { asm volatile("s_waitcnt vmcnt(0) lgkmcnt(0)" ::: "memory"); grid.sync(); } else { int zb_ = 0; asm volatile("" : "+s"(zb_)); const int tb_ = (swid << 6) + (int)__builtin_amdgcn_mbcnt_hi(~0u, __builtin_amdgcn_mbcnt_lo(~0u, (unsigned)zb_)); xcd_barrier(xbar, tb_); } }
    }
}

extern "C" void kernel_launch(void* const* d_in, const int* in_sizes, int n_in, void* d_out, int out_size, void* d_ws, size_t ws_size, hipStream_t stream) {
    static int grid = 0;
    if (grid == 0) {
        int dev = 0, cus = 0, per_cu = 0;
        hipGetDevice(&dev);
        hipDeviceGetAttribute(&cus, hipDeviceAttributeMultiprocessorCount, dev);
        hipFuncSetAttribute((const void*)mega, hipFuncAttributeMaxDynamicSharedMemorySize, LDS_BYTES);
        hipOccupancyMaxActiveBlocksPerMultiprocessor(&per_cu, (const void*)mega, 512, LDS_BYTES);
        if (per_cu < 1) { fprintf(stderr, "kernel_launch: occupancy query says %d blocks/CU\n", per_cu); per_cu = 1; }
        (void)hipGetLastError();
        grid = cus * 1;
        if (n_in != 36 || ws_size < 1013 * MiB) fprintf(stderr, "kernel_launch: unexpected n_in %d / ws_size %zu\n", n_in, ws_size);
    }
    (void)hipMemsetAsync((char*)d_ws + WS_BAR, 0, XCD_BAR_WORDS * sizeof(unsigned), stream);
    Params p{};
    for (int i = 0; i < 36; ++i) p.in[i] = (const float*)d_in[i];
    p.out = (float*)d_out; p.ws = (unsigned char*)d_ws;
#if ONE_LAUNCH
    int lo = 0, hi = DEPTH * NPH;
    void* args[] = {&p, &lo, &hi};
    hipError_t e = hipLaunchCooperativeKernel((const void*)mega, dim3(grid), dim3(512), args, LDS_BYTES, stream);
    if (e != hipSuccess) fprintf(stderr, "cooperative launch failed: %s (grid %d)\n", hipGetErrorString(e), grid);
#else
    for (int ph = 0; ph < DEPTH * NPH; ++ph) hipLaunchKernelGGL(mega, dim3(grid), dim3(512), LDS_BYTES, stream, p, ph, ph + 1);
#endif
}
```

```cpp
#include <hip/hip_runtime.h>
#include <hip/hip_cooperative_groups.h>
#include <cstdio>
#include <cstdint>
namespace cg = cooperative_groups;

#ifndef REPK
#define REPK -1
#endif
#ifndef REPN
#define REPN 1
#endif
#ifndef REP_LRU
#define REP_LRU 1
#endif
#ifndef REP_RWKV
#define REP_RWKV 1
#endif
#ifndef REP_SV
#define REP_SV 1
#endif
#ifndef ONE_LAUNCH
#define ONE_LAUNCH 1
#endif

#define LAS __attribute__((address_space(3)))
typedef unsigned short bf16_t;
typedef short bf16x8 __attribute__((ext_vector_type(8)));
typedef short bf16x4 __attribute__((ext_vector_type(4)));
typedef float f32x4 __attribute__((ext_vector_type(4)));
typedef float f32x2 __attribute__((ext_vector_type(2)));
typedef unsigned u32x4 __attribute__((ext_vector_type(4)));
typedef unsigned u32x2 __attribute__((ext_vector_type(2)));

constexpr int D = 1024, BATCH = 32, SEQ = 2048, DEPTH = 2, MTOK = BATCH * SEQ;
constexpr int DMIX = 512, INC = 5888, DFF = 4096, DPLE = 256;
constexpr int COL_A = 0, COL_B = 1024, COL_C = 2560, COL_D = 4352;
constexpr float ALPHA = 1.4142135623730951f;
constexpr float LN_EPS = 1e-5f, GN_EPS = 64e-5f;

constexpr size_t MiB = 1ull << 20;
constexpr size_t WS_XB = 0, WS_WT = 128 * MiB, WS_PB = 180 * MiB, WS_H = 212 * MiB, WS_VT = 948 * MiB;
constexpr size_t WO_IN = 0, WO_G = 6029312, WO_B = WO_G + 4194304, WO_OUT4 = WO_B + 2097152, WO_FF1 = WO_OUT4 + 4194304,
                 WO_FF2 = WO_FF1 + 4194304, WO_PLE = WO_FF2 + 4194304, WO_PLEG = WO_PLE + 262144;
constexpr int LDS_BYTES = 131072 + 16 + 9216;
constexpr size_t WS_BAR = 1012 * MiB;

struct Params {
    const float* in[36];
    float* out;
    unsigned char* ws;
};

__device__ __forceinline__ float bf2f(unsigned v) { return __uint_as_float(v << 16); }
typedef __bf16 bf16x2_t __attribute__((ext_vector_type(2)));
__device__ __forceinline__ unsigned cvt_pk_bf16(float lo, float hi) { f32x2 v = {lo, hi}; bf16x2_t b = __builtin_convertvector(v, bf16x2_t); unsigned r; __builtin_memcpy(&r, &b, 4); return r; }
__device__ __forceinline__ bf16_t f2bf(float f) { return (bf16_t)(cvt_pk_bf16(f, 0.f) & 0xffffu); }
__device__ __forceinline__ float fexp(float x) { return __builtin_amdgcn_exp2f(x * 1.4426950408889634f); }
__device__ __forceinline__ float flog(float x) { return __builtin_amdgcn_logf(x) * 0.6931471805599453f; }
__device__ __forceinline__ float ftanh(float x) { return 1.0f - 2.0f * __builtin_amdgcn_rcpf(1.0f + fexp(2.0f * x)); }
__device__ __forceinline__ float flog1p_small(float x) { return flog(1.0f + x); }
__device__ __forceinline__ float fneg_expm1(float t) { return 1.0f - fexp(t); }
__device__ __forceinline__ float sigmoidf_(float x) { return __builtin_amdgcn_rcpf(1.0f + fexp(-x)); }
__device__ __forceinline__ float wave_sum(float v) {
    v += __int_as_float(__builtin_amdgcn_update_dpp(0, __float_as_int(v), 0xB1, 0xF, 0xF, true));
    v += __int_as_float(__builtin_amdgcn_update_dpp(0, __float_as_int(v), 0x4E, 0xF, 0xF, true));
    v += __int_as_float(__builtin_amdgcn_update_dpp(0, __float_as_int(v), 0x141, 0xF, 0xF, true));
    v += __int_as_float(__builtin_amdgcn_update_dpp(0, __float_as_int(v), 0x140, 0xF, 0xF, true));
    const float s0 = __int_as_float(__builtin_amdgcn_readlane(__float_as_int(v), 0)), s1 = __int_as_float(__builtin_amdgcn_readlane(__float_as_int(v), 16));
    const float s2 = __int_as_float(__builtin_amdgcn_readlane(__float_as_int(v), 32)), s3 = __int_as_float(__builtin_amdgcn_readlane(__float_as_int(v), 48));
    return (s0 + s1) + (s2 + s3);
}
template <int N> __device__ __forceinline__ void wave_sum_n(float (&v)[N]) {
#pragma unroll
    for (int i = 0; i < N; ++i) v[i] += __int_as_float(__builtin_amdgcn_update_dpp(0, __float_as_int(v[i]), 0xB1, 0xF, 0xF, true));
#pragma unroll
    for (int i = 0; i < N; ++i) v[i] += __int_as_float(__builtin_amdgcn_update_dpp(0, __float_as_int(v[i]), 0x4E, 0xF, 0xF, true));
#pragma unroll
    for (int i = 0; i < N; ++i) v[i] += __int_as_float(__builtin_amdgcn_update_dpp(0, __float_as_int(v[i]), 0x141, 0xF, 0xF, true));
#pragma unroll
    for (int i = 0; i < N; ++i) v[i] += __int_as_float(__builtin_amdgcn_update_dpp(0, __float_as_int(v[i]), 0x140, 0xF, 0xF, true));
#pragma unroll
    for (int i = 0; i < N; ++i) v[i] += __int_as_float(__builtin_amdgcn_update_dpp(0, __float_as_int(v[i]), 0x142, 0xA, 0xF, false));
#pragma unroll
    for (int i = 0; i < N; ++i) v[i] += __int_as_float(__builtin_amdgcn_update_dpp(0, __float_as_int(v[i]), 0x143, 0xC, 0xF, false));
#pragma unroll
    for (int i = 0; i < N; ++i) v[i] = __int_as_float(__builtin_amdgcn_readlane(__float_as_int(v[i]), 63));
}
__device__ __forceinline__ float shflx(float v, int lane, int m) { return __int_as_float(__builtin_amdgcn_ds_bpermute((lane ^ m) << 2, __float_as_int(v))); }
__device__ __forceinline__ void unpack8(u32x4 u, float* f) {
#pragma unroll
    for (int i = 0; i < 4; ++i) { f[2 * i] = __uint_as_float(u[i] << 16); f[2 * i + 1] = __uint_as_float(u[i] & 0xffff0000u); }
}
__device__ __forceinline__ u32x4 pack8(const float* f) {
    u32x4 u;
#pragma unroll
    for (int i = 0; i < 4; ++i) u[i] = cvt_pk_bf16(f[2 * i], f[2 * i + 1]);
    return u;
}

namespace pg8 {
constexpr int BM = 256, BK = 64, HALF = 128, HTB = HALF * BK * 2, STAGE_BYTES = 8 * HTB, NXCD = 8, WGM = 8;
__host__ __device__ __forceinline__ int lds_byte(int r, int c) { const int st = (r >> 4) * 2 + (c >> 5), rr = r & 15, cc = c & 31, ob = rr * 64 + cc * 2; return st * 1024 + (ob ^ (((ob >> 9) & 1) << 5)); }
__host__ __device__ __forceinline__ void stage_rc(int b, int& R, int& C) { const int st = b / 1024, sb = b % 1024, swz = sb ^ (((sb >> 9) & 1) << 5); R = (st >> 1) * 16 + swz / 64; C = (st & 1) * 32 + (swz % 64) / 2; }
__host__ __device__ __forceinline__ int perm32(int rho) { const int n = rho >> 4, i = rho & 15; return 8 * (i >> 2) + 4 * n + (i & 3); }
struct Unit { int pm, pn; };
struct Gemm { const bf16_t* A; const bf16_t* Bt; int M, N, K, lda, ldb; };
struct StaticOrder {
    int nM, nN, nwg, G, c, merge;
    __device__ void init(int M, int N, int G_, int c_, int merge_) { merge = merge_; nM = M / BM; nN = (merge_ ? N / 4 : N) / BM; nwg = nM * nN; G = G_; c = c_; }
    __device__ bool next(int i, Unit& u) const {
        int n = 0; if (merge) { n = i & 3; i >>= 2; }
        const long L = (long)i * G + c; if (L >= nwg) return false;
        int wgid = (int)L; { const int q = nwg / NXCD, r = nwg % NXCD, xcd = wgid % NXCD, off = wgid / NXCD; wgid = (xcd < r ? xcd * (q + 1) : r * (q + 1) + (xcd - r) * q) + off; }
        const int nig = WGM * nN, gid = wgid / nig, fm = gid * WGM, gsz = (nM - fm) < WGM ? (nM - fm) : WGM;
        u.pm = fm + ((wgid % nig) % gsz); u.pn = (wgid % nig) / gsz + n * nN; return true;
    }
};

struct Epi {
    int mode;
    int act;
    bf16_t* ob; int ldo;
    const float* bias;
    bf16_t* io2;
    const float* resf;
    const bf16_t* aux;
    __device__ __forceinline__ void operator()(const f32x4 (&acc)[2][2][4][2], const Unit& u, int wr, int wc, int fr, int fq, LAS unsigned char* dump) const {
        int row0 = u.pm * BM + wr * 64 + fr, col0 = u.pn * BM + wc * 32 + 8 * fq;
        asm volatile("" : "+v"(row0), "+v"(col0));
        float bv[2][8];
        if (mode == 1 || mode == 3) {
#pragma unroll
            for (int bj = 0; bj < 2; ++bj) { const f32x4 b0 = *(const f32x4*)(bias + col0 + bj * HALF), b1 = *(const f32x4*)(bias + col0 + bj * HALF + 4);
#pragma unroll
                for (int j = 0; j < 4; ++j) { bv[bj][j] = b0[j]; bv[bj][4 + j] = b1[j]; } }
        }
        if (mode != 0) {
#pragma unroll
            for (int ai = 0; ai < 2; ++ai)
#pragma unroll
                for (int m = 0; m < 4; ++m)
#pragma unroll
                    for (int bj = 0; bj < 2; ++bj) {
                        const size_t row = (size_t)(row0 + ai * HALF + m * 16); const int col = col0 + bj * HALF;
                        const void* p0 = (mode == 2) ? (resf ? (const void*)(resf + row * D + col) : (const void*)(io2 + row * D + col)) : (const void*)(ob + row * ldo + col);
                        __builtin_amdgcn_global_load_lds((const unsigned*)p0, (LAS unsigned*)dump, 16, 0, 0);
                        if (mode == 2 && aux) __builtin_amdgcn_global_load_lds((const unsigned*)(aux + row * D + col), (LAS unsigned*)dump, 16, 0, 0);
                    }
        }
#pragma unroll
        for (int aim = 0; aim < 4; ++aim) {
            const int ai = aim >> 1, mh = aim & 1;
            u32x4 L0[4], L1[4];
            if (mode != 0) {
#pragma unroll
                for (int m2 = 0; m2 < 2; ++m2)
#pragma unroll
                    for (int bj = 0; bj < 2; ++bj) {
                        const int m = mh * 2 + m2;
                        const size_t row = (size_t)(row0 + ai * HALF + m * 16); const int col = col0 + bj * HALF, e = m2 * 2 + bj;
                        if (mode == 1) L0[e] = *(const u32x4*)(ob + row * ldo + col);
                        else if (mode == 3) { L0[e] = *(const u32x4*)(ob + row * ldo + col);
                            if (col >= D) L1[e] = *(const u32x4*)(io2 + row * D + (col & (D - 1))); }
                        else { if (resf) { L0[e] = *(const u32x4*)(resf + row * D + col); L1[e] = *(const u32x4*)(resf + row * D + col + 4); }
                               else { L0[e] = *(const u32x4*)(io2 + row * D + col); if (aux) L1[e] = *(const u32x4*)(aux + row * D + col); } }
                    }
            }
#pragma unroll
            for (int m2 = 0; m2 < 2; ++m2)
#pragma unroll
                for (int bj = 0; bj < 2; ++bj) {
                    const int m = mh * 2 + m2;
                    const size_t row = (size_t)(row0 + ai * HALF + m * 16); const int col = col0 + bj * HALF, e = m2 * 2 + bj;
                    float v[8];
#pragma unroll
                    for (int j = 0; j < 4; ++j) { v[j] = acc[ai][bj][m][0][j]; v[4 + j] = acc[ai][bj][m][1][j]; }
                    if (mode == 0) {
                        if (act == 1) {
#pragma unroll
                            for (int j = 0; j < 8; ++j) { const float t = fmaxf(v[j], 0.f); v[j] = t * t; }
                        }
                        *(u32x4*)(ob + row * ldo + col) = pack8(v);
                    } else if (mode == 1) {
                        float a[8]; unpack8(L0[e], a);
#pragma unroll
                        for (int j = 0; j < 8; ++j) v[j] = sigmoidf_(v[j] + bv[bj][j]) * a[j];
                        *(u32x4*)(ob + row * ldo + col) = pack8(v);
                    } else if (mode == 3) {
                        float a[8]; unpack8(L0[e], a);
#pragma unroll
                        for (int j = 0; j < 8; ++j) v[j] = sigmoidf_(v[j] + bv[bj][j]) * a[j];
                        if (col >= D) { float q[8]; unpack8(L1[e], q);
#pragma unroll
                            for (int j = 0; j < 8; ++j) v[j] += q[j]; }
                        *(u32x4*)(io2 + row * D + (col & (D - 1))) = pack8(v);
                    } else {
                        float r[8];
                        if (resf) {
#pragma unroll
                            for (int j = 0; j < 4; ++j) { r[j] = __uint_as_float(L0[e][j]); r[4 + j] = __uint_as_float(L1[e][j]); } }
                        else unpack8(L0[e], r);
#pragma unroll
                        for (int j = 0; j < 8; ++j) v[j] += ALPHA * r[j];
                        if (aux) { float a[8]; unpack8(L1[e], a);
#pragma unroll
                            for (int j = 0; j < 8; ++j) v[j] += a[j]; }
                        *(u32x4*)(io2 + row * D + col) = pack8(v);
                    }
                }
        }
    }
};

__device__ __forceinline__ void gemm_phase(const int tid, LAS unsigned char* lds, const Gemm g, const StaticOrder& S, const Epi& E) {
    const int wid = __builtin_amdgcn_readfirstlane(tid >> 6), lane = tid & 63, wr = wid >> 2, wc = wid & 3, fr = lane & 15, fq = lane >> 4;
    const int K = g.K, nt = K / BK;
    unsigned voffA, voffB;
    { int R, C; stage_rc(tid * 16, R, C); const int Rb = (R & ~31) + perm32(R & 31); voffA = (unsigned)(R * g.lda + C) * 2u; voffB = (unsigned)(Rb * g.ldb + C) * 2u; }
    const size_t p2A = (size_t)64 * g.lda * 2, p2B = (size_t)64 * g.ldb * 2;
    const size_t kstep = (size_t)(BK * 2);
    const size_t hstepA = (size_t)HALF * g.lda * 2, hstepB = (size_t)HALF * g.ldb * 2;
    const size_t tstepA = 2 * hstepA, tstepB = 2 * hstepB;
    const unsigned ldsw = (unsigned)wid * 1024u;
    const int aoff = lds_byte(wr * 64 + fr, fq * 8), boff = lds_byte(wc * 32 + fr, fq * 8);
#define XA voffA
#define XB voffB
#define p2XA p2A
#define p2XB p2B
#define PG8_SA(b, h) (((b) * 2 + (h)) * HTB)
#define PG8_SB(b, h) ((4 + (b) * 2 + (h)) * HTB)
#define PG8_STAGE(bufoff, gbase, voff) do { \
        __builtin_amdgcn_global_load_lds((const unsigned*)((const char*)(gbase) + (voff)), (LAS unsigned*)(lds + (bufoff) + ldsw), 16, 0, 0); \
        __builtin_amdgcn_global_load_lds((const unsigned*)((const char*)(gbase) + p2##voff + (voff)), (LAS unsigned*)(lds + (bufoff) + ldsw + 8192), 16, 0, 0); } while (0)
#define PG8_LDA(dst, b, h) do { _Pragma("unroll") for (int m = 0; m < 4; ++m) _Pragma("unroll") for (int k = 0; k < 2; ++k) dst[m][k] = *(const LAS bf16x8*)(lds + PG8_SA(b, h) + aoff + m * 2048 + k * 1024); } while (0)
#define PG8_LDB(dst, b, h) do { _Pragma("unroll") for (int n = 0; n < 2; ++n) _Pragma("unroll") for (int k = 0; k < 2; ++k) dst[n][k] = *(const LAS bf16x8*)(lds + PG8_SB(b, h) + boff + n * 2048 + k * 1024); } while (0)
#define PG8_MMA(ai, bj, At, Bt) do { __builtin_amdgcn_s_setprio(1); _Pragma("unroll") for (int m = 0; m < 4; ++m) _Pragma("unroll") for (int n = 0; n < 2; ++n) _Pragma("unroll") for (int k = 0; k < 2; ++k) \
        acc[ai][bj][m][n] = __builtin_amdgcn_mfma_f32_16x16x32_bf16(Bt[n][k], At[m][k], acc[ai][bj][m][n], 0, 0, 0); __builtin_amdgcn_s_setprio(0); } while (0)
#define PG8_WAIT_V(n) asm volatile("s_waitcnt vmcnt(" #n ")" ::: "memory")
#define PG8_WAIT_L(n) asm volatile("s_waitcnt lgkmcnt(" #n ")" ::: "memory")
#define PG8_BAR __builtin_amdgcn_s_barrier()
#define PG8_SCHED __builtin_amdgcn_sched_barrier(0)
    Unit cur, nxt; int ui = 0;
    if (!S.next(0, cur)) return;
    f32x4 acc[2][2][4][2];
    bf16x8 At[4][2], B0[2][2], B1[2][2];
    const char* cA = (const char*)g.A + (size_t)cur.pm * tstepA; const char* cB = (const char*)g.Bt + (size_t)cur.pn * tstepB;
    PG8_STAGE(PG8_SB(0, 0), cB, XB); PG8_STAGE(PG8_SB(0, 1), cB + hstepB, XB); PG8_STAGE(PG8_SA(0, 0), cA, XA); PG8_STAGE(PG8_SA(0, 1), cA + hstepA, XA);
    if (wr == 1) PG8_BAR;
    PG8_WAIT_V(2); PG8_BAR;
    PG8_STAGE(PG8_SB(1, 0), cB + kstep, XB); PG8_STAGE(PG8_SA(1, 0), cA + kstep, XA); PG8_STAGE(PG8_SB(1, 1), cB + hstepB + kstep, XB);
    PG8_WAIT_V(6); PG8_BAR;
    PG8_SCHED;
#pragma unroll
    for (int a = 0; a < 2; ++a)
#pragma unroll
        for (int b = 0; b < 2; ++b)
#pragma unroll
            for (int m = 0; m < 4; ++m)
#pragma unroll
                for (int n = 0; n < 2; ++n) acc[a][b][m][n] = (f32x4){0.f, 0.f, 0.f, 0.f};
    for (;;) {
        const bool has_next = S.next(ui + 1, nxt);
        const char* nA = has_next ? (const char*)g.A + (size_t)nxt.pm * tstepA : cA; const char* nB = has_next ? (const char*)g.Bt + (size_t)nxt.pn * tstepB : cB;
        for (int t = 0; t < nt; t += 2) {
            const bool last = (t == nt - 2);
            const char* a1 = cA + (size_t)(t + 1) * kstep;
            const char* a2 = last ? nA : cA + (size_t)(t + 2) * kstep; const char* b2 = last ? nB : cB + (size_t)(t + 2) * kstep;
            const char* a3 = a2 + kstep; const char* b3 = b2 + kstep;
            PG8_LDB(B0, 0, 0); PG8_LDB(B1, 0, 1); PG8_SCHED; PG8_LDA(At, 0, 0); PG8_STAGE(PG8_SA(1, 1), a1 + hstepA, XA);
            PG8_WAIT_V(8); PG8_WAIT_L(0); PG8_BAR; PG8_MMA(0, 0, At, B0); PG8_MMA(0, 1, At, B1); PG8_BAR; PG8_SCHED;
            PG8_LDA(At, 0, 1); PG8_STAGE(PG8_SB(0, 0), b2, XB); PG8_STAGE(PG8_SB(0, 1), b2 + hstepB, XB); PG8_STAGE(PG8_SA(0, 0), a2, XA);
            PG8_WAIT_V(8); PG8_WAIT_L(0); PG8_BAR; PG8_MMA(1, 0, At, B0); PG8_MMA(1, 1, At, B1); PG8_BAR; PG8_SCHED;
            PG8_LDB(B0, 1, 0); PG8_LDB(B1, 1, 1); PG8_SCHED; PG8_LDA(At, 1, 0); PG8_STAGE(PG8_SA(0, 1), a2 + hstepA, XA);
            PG8_WAIT_V(8); PG8_WAIT_L(0); PG8_BAR; PG8_MMA(0, 0, At, B0); PG8_MMA(0, 1, At, B1); PG8_BAR; PG8_SCHED;
            PG8_LDA(At, 1, 1); PG8_STAGE(PG8_SB(1, 0), b3, XB); PG8_STAGE(PG8_SB(1, 1), b3 + hstepB, XB); PG8_STAGE(PG8_SA(1, 0), a3, XA);
            PG8_WAIT_V(8); PG8_WAIT_L(0); PG8_BAR; PG8_MMA(1, 0, At, B0); PG8_MMA(1, 1, At, B1); PG8_BAR; PG8_SCHED;
        }
        if (wr == 0) PG8_BAR;
        E(acc, cur, wr, wc, fr, fq, lds + 131088 + ldsw);
        if (!has_next) break;
#pragma unroll
        for (int a = 0; a < 2; ++a)
#pragma unroll
            for (int b = 0; b < 2; ++b)
#pragma unroll
                for (int m = 0; m < 4; ++m)
#pragma unroll
                    for (int n = 0; n < 2; ++n) acc[a][b][m][n] = (f32x4){0.f, 0.f, 0.f, 0.f};
        cur = nxt; cA = nA; cB = nB; ++ui;
        if (wr == 1) PG8_BAR;
    }
    PG8_WAIT_V(0);
    PG8_BAR;
#undef PG8_SA
#undef PG8_SB
#undef PG8_STAGE
#undef PG8_LDA
#undef PG8_LDB
#undef PG8_MMA
#undef PG8_WAIT_V
#undef PG8_WAIT_L
#undef PG8_BAR
#undef PG8_SCHED
}
}

#define LDS_BARRIER() do { asm volatile("s_waitcnt lgkmcnt(0)" ::: "memory"); __builtin_amdgcn_s_barrier(); asm volatile("" ::: "memory"); } while (0)

__device__ __forceinline__ void tconv(const int tid_, const int bid_, const int gdim_, float* tile, const float* __restrict__ src, int K, int N, bf16_t* __restrict__ dst, int ldd) {
    const int tn = N / 64, nt = (K / 64) * tn;
    const int r = tid_ >> 3, c = (tid_ & 7) * 8;
    int t = bid_;
    f32x4 a, b;
    if (t < nt) { const f32x4* s = (const f32x4*)(src + (size_t)((t / tn) * 64 + r) * N + (t % tn) * 64 + c); a = s[0]; b = s[1]; }
    for (; t < nt; t += gdim_) {
        const int k0 = (t / tn) * 64, n0 = (t % tn) * 64;
#pragma unroll
        for (int j = 0; j < 4; ++j) { tile[r * 65 + c + j] = a[j]; tile[r * 65 + c + 4 + j] = b[j]; }
        const int t2 = t + gdim_;
        if (t2 < nt) { const f32x4* s = (const f32x4*)(src + (size_t)((t2 / tn) * 64 + r) * N + (t2 % tn) * 64 + c); a = s[0]; b = s[1]; }
        LDS_BARRIER();
        float v[8];
#pragma unroll
        for (int j = 0; j < 8; ++j) v[j] = tile[(c + j) * 65 + r];
        *(u32x4*)(dst + (size_t)(n0 + r) * ldd + k0 + c) = pack8(v);
        LDS_BARRIER();
    }
}
__device__ __forceinline__ void econv(const int tid_, const int bid_, const int gdim_, const float* __restrict__ src, bf16_t* __restrict__ dst, int n) {
    const int nth = gdim_ * 512 * 8;
    for (int i = (bid_ * 512 + tid_) * 8; i < n; i += nth) {
        const f32x4 a = *(const f32x4*)(src + i), b = *(const f32x4*)(src + i + 4);
        float v[8] = {a[0], a[1], a[2], a[3], b[0], b[1], b[2], b[3]};
        *(u32x4*)(dst + i) = pack8(v);
    }
}

__device__ __forceinline__ void ln_phase(const int tid_, const int bid_, const int gdim_, bf16_t* xio, const float* __restrict__ g, const float* __restrict__ b, float* outf) {
    const int lane = tid_ & 63, wid = tid_ >> 6;
    const int nw = gdim_ * 8;
    float gg[16], bb[16];
#pragma unroll
    for (int i = 0; i < 2; ++i)
#pragma unroll
        for (int j = 0; j < 8; ++j) { gg[i * 8 + j] = g[i * 512 + lane * 8 + j]; bb[i * 8 + j] = b[i * 512 + lane * 8 + j]; }
    for (int row = bid_ * 8 + wid; row < MTOK; row += nw) {
        bf16_t* p = xio + (size_t)row * D + lane * 8;
        float v[16]; unpack8(*(const u32x4*)p, v); unpack8(*(const u32x4*)(p + 512), v + 8);
        float s = 0.f;
#pragma unroll
        for (int j = 0; j < 16; ++j) s += v[j];
        const float mean = wave_sum(s) * (1.0f / D);
        float q = 0.f;
#pragma unroll
        for (int j = 0; j < 16; ++j) { const float d = v[j] - mean; q += d * d; }
        const float rstd = __builtin_amdgcn_rsqf(wave_sum(q) * (1.0f / D) + LN_EPS);
#pragma unroll
        for (int j = 0; j < 16; ++j) v[j] = (v[j] - mean) * rstd * gg[j] + bb[j];
        if (!outf) { *(u32x4*)p = pack8(v); *(u32x4*)(p + 512) = pack8(v + 8); }
        else { float* o = outf + (size_t)row * D + lane * 8;
            *(f32x4*)o = (f32x4){v[0], v[1], v[2], v[3]}; *(f32x4*)(o + 4) = (f32x4){v[4], v[5], v[6], v[7]};
            *(f32x4*)(o + 512) = (f32x4){v[8], v[9], v[10], v[11]}; *(f32x4*)(o + 516) = (f32x4){v[12], v[13], v[14], v[15]}; }
    }
}

__device__ __forceinline__ void sconv_phase(const int tid_, const int bid_, const int gdim_, const bf16_t* __restrict__ h, const float* __restrict__ w  , bf16_t* __restrict__ yb) {
    const size_t nth = (size_t)gdim_ * 512;
    for (size_t idx = (size_t)bid_ * 512 + tid_; idx < (size_t)MTOK * 64; idx += nth) {
        const int tok = (int)(idx >> 6), c8 = (int)(idx & 63) * 8, t = tok & (SEQ - 1);
        float acc[8];
#pragma unroll
        for (int j = 0; j < 8; ++j) acc[j] = 0.f;
#pragma unroll
        for (int k = 0; k < 3; ++k) {
            const int tt = t - 2 + k;
            if (tt >= 0) {
                const bf16_t* row = h + (size_t)(tok - 2 + k) * INC + COL_B;
                float cgv[8], xh[8]; unpack8(*(const u32x4*)(row + 512 + c8), cgv); unpack8(*(const u32x4*)(row + 1024 + c8), xh);
                const f32x4 w0 = *(const f32x4*)(w + k * 512 + c8), w1 = *(const f32x4*)(w + k * 512 + c8 + 4);
#pragma unroll
                for (int j = 0; j < 4; ++j) { acc[j] += w0[j] * (cgv[j] * xh[j]); acc[4 + j] += w1[j] * (cgv[4 + j] * xh[4 + j]); }
            }
        }
        float bg[8]; unpack8(*(const u32x4*)(h + (size_t)tok * INC + COL_B + c8), bg);
#pragma unroll
        for (int j = 0; j < 8; ++j) acc[j] *= bg[j];
        *(u32x4*)(yb + (size_t)tok * DMIX + c8) = pack8(acc);
    }
}

__device__ __forceinline__ void vtrans_phase(const int tid_, const int it0, const int gdim_, bf16_t* tile  , const bf16_t* __restrict__ h, bf16_t* __restrict__ vt) {
    const int r = tid_ >> 3, c = (tid_ & 7) * 8;
    int it = it0;
    u32x4 u;
    if (it < BATCH * 8 * 32) { const int bh = it >> 5, tc = it & 31; u = *(const u32x4*)(h + (size_t)((bh >> 3) * SEQ + tc * 64 + r) * INC + COL_D + 1024 + (bh & 7) * 64 + c); }
    for (; it < BATCH * 8 * 32; it += gdim_) {
        const int bh = it >> 5, tc = it & 31;
#pragma unroll
        for (int j = 0; j < 4; ++j) { tile[(c + 2 * j) * 72 + r] = (bf16_t)(u[j] & 0xffffu); tile[(c + 2 * j + 1) * 72 + r] = (bf16_t)(u[j] >> 16); }
        const int i2 = it + gdim_;
        if (i2 < BATCH * 8 * 32) { const int bh2 = i2 >> 5, tc2 = i2 & 31; u = *(const u32x4*)(h + (size_t)((bh2 >> 3) * SEQ + tc2 * 64 + r) * INC + COL_D + 1024 + (bh2 & 7) * 64 + c); }
        LDS_BARRIER();
        *(u32x4*)(vt + (size_t)(bh * 64 + r) * SEQ + tc * 64 + c) = *(const u32x4*)(tile + r * 72 + c);
        LDS_BARRIER();
    }
}

__device__ __forceinline__ void attn_phase(const int tid_, const int bid_, const int gdim_, unsigned char* ldsb, const bf16_t* __restrict__ h, const bf16_t* __restrict__ vt, const float* __restrict__ rel_bias, bf16_t* __restrict__ yd) {
    constexpr float L2E = 1.4426950408889634f;
    float* rb = (float*)(ldsb + 131088);
    for (int i = tid_; i < 8 * 257; i += 512) rb[i] = rel_bias[i] * L2E;
    __syncthreads();
    const int lane = tid_ & 63, wid = __builtin_amdgcn_readfirstlane(tid_ >> 6), lr = lane & 15, quad = lane >> 4;
    const int nw = gdim_ * 8;
    unsigned char* wl = ldsb + wid * 16384;
    const int krow = lane >> 3, kchunk = (lane & 7) ^ (krow & 7);
    const int vrow = lane >> 2, vchunk = (lane & 3) ^ ((vrow >> 2) & 3);
    int koff[2][2], voff[4];
#pragma unroll
    for (int tt = 0; tt < 2; ++tt)
#pragma unroll
        for (int dh = 0; dh < 2; ++dh) { const int row = (lr >> 2) * 8 + tt * 4 + (lr & 3); koff[tt][dh] = row * 128 + (((dh * 4 + quad) ^ (row & 7)) * 16); }
#pragma unroll
    for (int dt = 0; dt < 4; ++dt) { const int d = dt * 16 + lr; voff[dt] = 4096 + d * 64 + ((quad ^ ((d >> 2) & 3)) * 16); }
    int it = 0;
    const int vbid = (bid_ & 7) * (gdim_ >> 3) + (bid_ >> 3);
    for (int item0 = vbid * 8 + wid; item0 < BATCH * 8 * 32; item0 += nw, ++it) {
        const int c = ((item0 & 31) + 8 * it) & 31, hh = (item0 >> 5) & 7, b = item0 >> 8;
        const int q0 = c * 64;
        const bf16_t* hb = h + (size_t)b * SEQ * INC + COL_D + hh * 64;
        bf16x8 qf[4][2];
        asm volatile("s_waitcnt lgkmcnt(0)" ::: "memory");
        {
            const bf16_t* qg = hb + (size_t)(q0 + krow) * INC + kchunk * 8;
#pragma unroll
            for (int i = 0; i < 8; ++i) __builtin_amdgcn_global_load_lds((const unsigned*)(qg + (size_t)i * 8 * INC), (LAS unsigned*)(wl + 8192 + i * 1024), 16, 0, 0);
        }
        const bf16_t* vb = vt + (size_t)((b * 8 + hh) * 64) * SEQ;
        const float* rbh = rb + hh * 257;
        const float cb2 = rbh[256];
        f32x4 oacc[4][4];
#pragma unroll
        for (int qi = 0; qi < 4; ++qi)
#pragma unroll
            for (int dt = 0; dt < 4; ++dt) oacc[qi][dt] = (f32x4){0.f, 0.f, 0.f, 0.f};
        float mrun[4] = {-1e30f, -1e30f, -1e30f, -1e30f}, lsum[4] = {0.f, 0.f, 0.f, 0.f};
        const int kstart = (c > 8 ? c - 8 : 0) * 64, kend = c * 64 + 64;
        const bf16_t* kg = hb + 512 + (size_t)krow * INC + kchunk * 8;
        const bf16_t* vg = vb + (size_t)vrow * SEQ + vchunk * 8;
#define AT_LOAD(buf, kt) do { _Pragma("unroll") for (int i = 0; i < 4; ++i) \
                __builtin_amdgcn_global_load_lds((const unsigned*)(kg + (size_t)((kt) + i * 8) * INC), (LAS unsigned*)(wl + (buf) * 8192 + i * 1024), 16, 0, 0); \
            _Pragma("unroll") for (int i = 0; i < 4; ++i) \
                __builtin_amdgcn_global_load_lds((const unsigned*)(vg + (size_t)i * 16 * SEQ + (kt)), (LAS unsigned*)(wl + (buf) * 8192 + 4096 + i * 1024), 16, 0, 0); } while (0)
#define AT_COMPUTE(buf, kt) do { \
            const bool far_ = ((kt) + 31 + 128 <= q0); \
            const unsigned char* bb_ = wl + (buf) * 8192; \
            bf16x8 kf[2][2], vf[4]; \
            _Pragma("unroll") for (int tt = 0; tt < 2; ++tt) _Pragma("unroll") for (int dh = 0; dh < 2; ++dh) kf[tt][dh] = *(const bf16x8*)(bb_ + koff[tt][dh]); \
            _Pragma("unroll") for (int dt = 0; dt < 4; ++dt) vf[dt] = *(const bf16x8*)(bb_ + voff[dt]); \
            _Pragma("unroll") for (int qi = 0; qi < 4; ++qi) { \
                f32x4 s[2]; \
                _Pragma("unroll") for (int tt = 0; tt < 2; ++tt) { f32x4 a = (f32x4){0.f, 0.f, 0.f, 0.f}; \
                    a = __builtin_amdgcn_mfma_f32_16x16x32_bf16(kf[tt][0], qf[qi][0], a, 0, 0, 0); \
                    a = __builtin_amdgcn_mfma_f32_16x16x32_bf16(kf[tt][1], qf[qi][1], a, 0, 0, 0); s[tt] = a; } \
                float mx = -1e30f; \
                if (far_) { _Pragma("unroll") for (int tt = 0; tt < 2; ++tt) _Pragma("unroll") for (int j = 0; j < 4; ++j) { const float v = s[tt][j] * (0.125f * L2E) + cb2; s[tt][j] = v; mx = fmaxf(mx, v); } } \
                else { const int qpos = q0 + qi * 16 + lr; float bz[8]; \
                    _Pragma("unroll") for (int tt = 0; tt < 2; ++tt) _Pragma("unroll") for (int j = 0; j < 4; ++j) { \
                        int rel = qpos - ((kt) + quad * 8 + tt * 4 + j); rel = rel > 128 ? 128 : (rel < -128 ? -128 : rel); bz[tt * 4 + j] = rbh[rel + 128]; } \
                    _Pragma("unroll") for (int tt = 0; tt < 2; ++tt) _Pragma("unroll") for (int j = 0; j < 4; ++j) { \
                        const float v = s[tt][j] * (0.125f * L2E) + bz[tt * 4 + j]; s[tt][j] = v; mx = fmaxf(mx, v); } } \
                mx = fmaxf(mx, shflx(mx, lane, 16)); mx = fmaxf(mx, shflx(mx, lane, 32)); \
                const float mnew = fmaxf(mrun[qi], mx), sc = __builtin_amdgcn_exp2f(mrun[qi] - mnew); \
                mrun[qi] = mnew; \
                float ps = 0.f; float pv[8]; \
                _Pragma("unroll") for (int tt = 0; tt < 2; ++tt) _Pragma("unroll") for (int j = 0; j < 4; ++j) { const float p = __builtin_amdgcn_exp2f(s[tt][j] - mnew); pv[tt * 4 + j] = p; ps += p; } \
                lsum[qi] = lsum[qi] * sc + ps; \
                const u32x4 pu = pack8(pv); bf16x8 pf; __builtin_memcpy(&pf, &pu, 16); \
                _Pragma("unroll") for (int dt = 0; dt < 4; ++dt) { \
                    f32x4 o = oacc[qi][dt]; \
                    _Pragma("unroll") for (int j = 0; j < 4; ++j) o[j] *= sc; \
                    oacc[qi][dt] = __builtin_amdgcn_mfma_f32_16x16x32_bf16(vf[dt], pf, o, 0, 0, 0); } \
            } } while (0)
        AT_LOAD(0, kstart);
        asm volatile("s_waitcnt vmcnt(8)" ::: "memory");
#pragma unroll
        for (int qi = 0; qi < 4; ++qi)
#pragma unroll
            for (int dh = 0; dh < 2; ++dh) { const int row = qi * 16 + lr; qf[qi][dh] = *(const bf16x8*)(wl + 8192 + row * 128 + (((dh * 4 + quad) ^ (row & 7)) * 16)); }
        asm volatile("s_waitcnt lgkmcnt(0)" ::: "memory");
        for (int kt0 = kstart; kt0 < kend; kt0 += 64) {
            AT_LOAD(1, kt0 + 32);
            asm volatile("s_waitcnt vmcnt(8)" ::: "memory");
            AT_COMPUTE(0, kt0);
            if (kt0 + 64 < kend) { AT_LOAD(0, kt0 + 64); asm volatile("s_waitcnt vmcnt(8)" ::: "memory"); }
            else asm volatile("s_waitcnt vmcnt(0)" ::: "memory");
            AT_COMPUTE(1, kt0 + 32);
        }
#undef AT_LOAD
#undef AT_COMPUTE
#pragma unroll
        for (int qi = 0; qi < 4; ++qi) {
            float l = lsum[qi]; l += shflx(l, lane, 16); l += shflx(l, lane, 32);
            const float inv = __builtin_amdgcn_rcpf(l);
#pragma unroll
            for (int dt = 0; dt < 4; ++dt) {
                u32x2 pk; pk[0] = cvt_pk_bf16(oacc[qi][dt][0] * inv, oacc[qi][dt][1] * inv); pk[1] = cvt_pk_bf16(oacc[qi][dt][2] * inv, oacc[qi][dt][3] * inv);
                *(u32x2*)(wl + (qi * 16 + lr) * 136 + (dt * 16 + quad * 4) * 2) = pk;
            }
        }
        asm volatile("" ::: "memory");
#pragma unroll
        for (int i = 0; i < 8; ++i) {
            const int row = i * 8 + krow;
            *(u32x4*)(yd + (size_t)(b * SEQ + q0 + row) * DMIX + hh * 64 + (lane & 7) * 8) = *(const u32x4*)(wl + row * 136 + (lane & 7) * 16);
        }
    }
    __syncthreads();
}

__device__ __forceinline__ int lru_phase(const int tid_, const int bid_, const int gdim_, unsigned char* lds, const bf16_t* __restrict__ h, const float* __restrict__ conv_w, const float* __restrict__ conv_b,
                          const float* __restrict__ wrp, const float* __restrict__ brp, const float* __restrict__ wip, const float* __restrict__ bip,
                          const float* __restrict__ lam, bf16_t* __restrict__ ya_out, bf16_t* __restrict__ vt, const float* __restrict__ scw  , bf16_t* __restrict__ yb_out) {
    bf16_t* vtile = (bf16_t*)(lds + 131088);
    bf16_t* WrT = (bf16_t*)lds;
    bf16_t* WiT = WrT + 64 * 72;
    bf16_t* xcb = WiT + 64 * 72;
    bf16_t* xraw = xcb + 64 * 72;
    bf16_t* yraw = xraw + 67 * 64 + 64;
    float* xcf = (float*)(yraw + 64 * 64);
    float* abuf = xcf + 4096;
    float* ubuf = abuf + 4096;
    float* ibuf = ubuf + 4096;
    float* hbuf = ibuf + 4096;
    float* gbuf = xcf;
    const int tid = tid_, lane = tid & 63, wid = tid >> 6, lr = lane & 15, quad = lane >> 4;
    const int sc_nth = gdim_ * 512; int sc_idx = bid_ * 512 + tid;
    int vt_it = bid_; u32x4 vt_u = (u32x4){0u, 0u, 0u, 0u};
    if (vt_it < BATCH * 8 * 32) { const int bh = vt_it >> 5, tcv = vt_it & 31; vt_u = *(const u32x4*)(h + (size_t)((bh >> 3) * SEQ + tcv * 64 + (tid >> 3)) * INC + COL_D + 1024 + (bh & 7) * 64 + (tid & 7) * 8); }
    for (int item = bid_; item < BATCH * 8; item += gdim_) {
        const int b = item >> 3, g = item & 7;
        __syncthreads();
        for (int e = tid; e < 4096; e += 512) { const int i = e >> 6, j = e & 63;
            WrT[j * 72 + i] = f2bf(wrp[(size_t)g * 4096 + e]); WiT[j * 72 + i] = f2bf(wip[(size_t)g * 4096 + e]); }
        const int ch = tid & 63, trow = tid >> 6;
        const int cg_ = g * 64 + ch;
        const float cw0 = conv_w[cg_], cw1 = conv_w[512 + cg_], cw2 = conv_w[1024 + cg_], cw3 = conv_w[1536 + cg_], cb = conv_b[cg_];
        const int r8 = tid >> 3, pc = (tid & 7) * 8;
        const bf16_t* hrow = h + (size_t)(b * SEQ + r8) * INC + COL_A + g * 64 + pc;
        u32x4 xa16 = *(const u32x4*)hrow, ya16 = *(const u32x4*)(hrow + 512), prev16 = (u32x4){0u, 0u, 0u, 0u};
        float hstate = 0.f;
        for (int tc = 0; tc < SEQ / 64; ++tc) {
            const int t0 = tc * 64;
            *(u32x4*)(xraw + (3 + r8) * 64 + pc) = xa16; *(u32x4*)(yraw + r8 * 64 + pc) = ya16;
            if (r8 >= 61) *(u32x4*)(xraw + (r8 - 61) * 64 + pc) = prev16;
            prev16 = xa16;
            if (tc + 1 < SEQ / 64) { const bf16_t* nx = hrow + (size_t)(t0 + 64) * INC; xa16 = *(const u32x4*)nx; ya16 = *(const u32x4*)(nx + 512); }
            const bool sc_ok = sc_idx < MTOK * 64;
            const int sc_tok = sc_idx >> 6, sc_c8 = (sc_idx & 63) * 8, sc_t = sc_tok & (SEQ - 1);
            u32x4 sc_bg, sc_c[3], sc_x[3];
            if (sc_ok) {
                sc_bg = *(const u32x4*)(h + (size_t)sc_tok * INC + COL_B + sc_c8);
#pragma unroll
                for (int k = 0; k < 3; ++k) { const bf16_t* row = h + (size_t)(sc_tok - (sc_t - 2 + k >= 0 ? 2 - k : 0)) * INC + COL_B; sc_c[k] = *(const u32x4*)(row + 512 + sc_c8); sc_x[k] = *(const u32x4*)(row + 1024 + sc_c8); }
            }
            const int vt_cur = vt_it;
            if (vt_cur < BATCH * 8 * 32) {
#pragma unroll
                for (int j = 0; j < 4; ++j) { vtile[(pc + 2 * j) * 72 + r8] = (bf16_t)(vt_u[j] & 0xffffu); vtile[(pc + 2 * j + 1) * 72 + r8] = (bf16_t)(vt_u[j] >> 16); }
                vt_it += gdim_;
                if (vt_it < BATCH * 8 * 32) { const int bh = vt_it >> 5, tcv = vt_it & 31; vt_u = *(const u32x4*)(h + (size_t)((bh >> 3) * SEQ + tcv * 64 + r8) * INC + COL_D + 1024 + (bh & 7) * 64 + pc); }
            }
            LDS_BARRIER();
            if (vt_cur < BATCH * 8 * 32) { const int bh = vt_cur >> 5, tcv = vt_cur & 31;
                *(u32x4*)(vt + (size_t)(bh * 64 + r8) * SEQ + tcv * 64 + pc) = *(const u32x4*)(vtile + r8 * 72 + pc); }
#pragma unroll
            for (int i = 0; i < 8; ++i) {
                const int tl = trow + 8 * i;
                const float x3 = bf2f(xraw[tl * 64 + ch]), x2 = bf2f(xraw[(tl + 1) * 64 + ch]), x1 = bf2f(xraw[(tl + 2) * 64 + ch]), x0 = bf2f(xraw[(tl + 3) * 64 + ch]);
                const float xc = cw3 * x0 + cw2 * x1 + cw1 * x2 + cw0 * x3 + cb;
                xcf[tl * 64 + ch] = xc; xcb[tl * 72 + ch] = f2bf(xc);
            }
            LDS_BARRIER();
            {
                const int tt = wid & 3, which = wid >> 2;
                const bf16_t* WT = which ? WiT : WrT;
                const bf16x8 a0 = *(const bf16x8*)(xcb + (tt * 16 + lr) * 72 + quad * 8), a1 = *(const bf16x8*)(xcb + (tt * 16 + lr) * 72 + 32 + quad * 8);
#pragma unroll
                for (int jt = 0; jt < 4; ++jt) {
                    const bf16x8 b0 = *(const bf16x8*)(WT + (jt * 16 + lr) * 72 + quad * 8), b1 = *(const bf16x8*)(WT + (jt * 16 + lr) * 72 + 32 + quad * 8);
                    f32x4 cacc = (f32x4){0.f, 0.f, 0.f, 0.f};
                    cacc = __builtin_amdgcn_mfma_f32_16x16x32_bf16(a0, b0, cacc, 0, 0, 0);
                    cacc = __builtin_amdgcn_mfma_f32_16x16x32_bf16(a1, b1, cacc, 0, 0, 0);
                    const int j = jt * 16 + lr, cj = g * 64 + j;
                    if (which == 0) {
                        const float bias = brp[cj], lm = lam[cj];
                        const float sp = fmaxf(-lm, 0.f) + flog1p_small(fexp(-fabsf(lm)));
#pragma unroll
                        for (int jj = 0; jj < 4; ++jj) {
                            const int tl = tt * 16 + quad * 4 + jj;
                            const float r = sigmoidf_(cacc[jj] + bias);
                            const float la = -8.0f * r * sp;
                            abuf[tl * 64 + j] = fexp(la);
                            ubuf[tl * 64 + j] = __builtin_amdgcn_sqrtf(fneg_expm1(2.0f * la)) * xcf[tl * 64 + j];
                        }
                    } else {
                        const float bias = bip[cj];
#pragma unroll
                        for (int jj = 0; jj < 4; ++jj) { const int tl = tt * 16 + quad * 4 + jj; ibuf[tl * 64 + j] = sigmoidf_(cacc[jj] + bias); }
                    }
                }
            }
            LDS_BARRIER();
            if (wid == 0) {
#pragma unroll 8
                for (int tl = 0; tl < 64; ++tl) { hstate = abuf[tl * 64 + lane] * hstate + ubuf[tl * 64 + lane] * ibuf[tl * 64 + lane]; hbuf[tl * 64 + lane] = hstate; }
            } else {
                for (int e = tid - 64; e < 4096; e += 448) {
                    const float y = bf2f(yraw[e]);
                    gbuf[e] = 0.5f * y * (1.0f + ftanh(0.7978845608028654f * (y + 0.044715f * y * y * y)));
                }
            }
            LDS_BARRIER();
            {
                float o[8];
                const f32x4 h0 = *(const f32x4*)(hbuf + r8 * 64 + pc), h1 = *(const f32x4*)(hbuf + r8 * 64 + pc + 4);
                const f32x4 g0 = *(const f32x4*)(gbuf + r8 * 64 + pc), g1 = *(const f32x4*)(gbuf + r8 * 64 + pc + 4);
#pragma unroll
                for (int j = 0; j < 4; ++j) { o[j] = h0[j] * g0[j]; o[4 + j] = h1[j] * g1[j]; }
                *(u32x4*)(ya_out + (size_t)(b * SEQ + t0 + r8) * DMIX + g * 64 + pc) = pack8(o);
            }
            if (sc_ok) {
                float acc[8], bg[8];
#pragma unroll
                for (int j = 0; j < 8; ++j) acc[j] = 0.f;
#pragma unroll
                for (int k = 0; k < 3; ++k) {
                    const float mk = (sc_t - 2 + k >= 0) ? 1.f : 0.f;
                    float cgv[8], xh[8]; unpack8(sc_c[k], cgv); unpack8(sc_x[k], xh);
                    const f32x4 w0 = *(const f32x4*)(scw + k * 512 + sc_c8), w1 = *(const f32x4*)(scw + k * 512 + sc_c8 + 4);
#pragma unroll
                    for (int j = 0; j < 4; ++j) { acc[j] += (mk * w0[j]) * (cgv[j] * xh[j]); acc[4 + j] += (mk * w1[j]) * (cgv[4 + j] * xh[4 + j]); }
                }
                unpack8(sc_bg, bg);
#pragma unroll
                for (int j = 0; j < 8; ++j) acc[j] *= bg[j];
                *(u32x4*)(yb_out + (size_t)sc_tok * DMIX + sc_c8) = pack8(acc);
            }
            sc_idx += sc_nth;
        }
    }
    for (; sc_idx < MTOK * 64; sc_idx += sc_nth) {
        const int tok = sc_idx >> 6, c8 = (sc_idx & 63) * 8, t = tok & (SEQ - 1);
        float acc[8], bg[8];
#pragma unroll
        for (int j = 0; j < 8; ++j) acc[j] = 0.f;
#pragma unroll
        for (int k = 0; k < 3; ++k) {
            if (t - 2 + k >= 0) {
                const bf16_t* row = h + (size_t)(tok - 2 + k) * INC + COL_B;
                float cgv[8], xh[8]; unpack8(*(const u32x4*)(row + 512 + c8), cgv); unpack8(*(const u32x4*)(row + 1024 + c8), xh);
                const f32x4 w0 = *(const f32x4*)(scw + k * 512 + c8), w1 = *(const f32x4*)(scw + k * 512 + c8 + 4);
#pragma unroll
                for (int j = 0; j < 4; ++j) { acc[j] += w0[j] * (cgv[j] * xh[j]); acc[4 + j] += w1[j] * (cgv[4 + j] * xh[4 + j]); }
            }
        }
        unpack8(*(const u32x4*)(h + (size_t)tok * INC + COL_B + c8), bg);
#pragma unroll
        for (int j = 0; j < 8; ++j) acc[j] *= bg[j];
        *(u32x4*)(yb_out + (size_t)tok * DMIX + c8) = pack8(acc);
    }
    __syncthreads();
    return vt_it;
}

constexpr int RT = 16, REC = 456;
__device__ __forceinline__ float dpp_x1(float v) { return __int_as_float(__builtin_amdgcn_update_dpp(0, __float_as_int(v), 0xB1, 0xF, 0xF, true)); }
__device__ __forceinline__ float dpp_x2(float v) { return __int_as_float(__builtin_amdgcn_update_dpp(0, __float_as_int(v), 0x4E, 0xF, 0xF, true)); }
__device__ __forceinline__ void rwkv_phase(const int tid_, const int bid_, const int gdim_, unsigned char* lds, const bf16_t* __restrict__ h, const float* __restrict__ mu, const float* __restrict__ w0p, const float* __restrict__ w2p,
                           const float* __restrict__ a0p, const float* __restrict__ a2p, const float* __restrict__ g2p, const float* __restrict__ kkp, const float* __restrict__ kap,
                           const float* __restrict__ rkp, const float* __restrict__ gng, const float* __restrict__ gnb, bf16_t* __restrict__ yc) {
    bf16_t* W2T = (bf16_t*)lds;
    bf16_t* A2T = W2T + 64 * 72;
    bf16_t* G2T = A2T + 64 * 72;
    bf16_t* linb = G2T + 64 * 136;
    float* lo = (float*)(linb + 4 * 4 * 264);
    float* rec = lo + 4 * 4 * 192;
    float* obuf = rec + 2 * RT * REC;
    const int tid = tid_, lane = tid & 63, wid = __builtin_amdgcn_readfirstlane(tid >> 6);
    constexpr int NC = SEQ / RT;
    for (int item = bid_; item < BATCH * 8; item += gdim_) {
        const int b = item >> 3, hh = item & 7, hj = hh * 64 + lane;
        __syncthreads();
        for (int e = tid; e < 4096; e += 512) { const int i = e >> 6, j = e & 63; W2T[j * 72 + i] = f2bf(w2p[i * 512 + hh * 64 + j]); A2T[j * 72 + i] = f2bf(a2p[i * 512 + hh * 64 + j]); }
        for (int e = tid; e < 8192; e += 512) { const int i = e >> 6, j = e & 63; G2T[j * 136 + i] = f2bf(g2p[i * 512 + hh * 64 + j]); }
        __syncthreads();
        if (wid < 4) {
            const int r = lane >> 2, kq = lane & 3, row = wid * 16 + r;
            f32x2 S[8];
#pragma unroll
            for (int i = 0; i < 8; ++i) S[i] = (f32x2){0.f, 0.f};
            LDS_BARRIER();
            for (int c = 0; c < NC; ++c) {
                const float* R0 = rec + (c & 1) * RT * REC + kq * 16;
                float* ob = obuf + (c & 1) * RT * 64 + row;
                f32x4 dt[2][8], up[2][12]; float vv[2]; f32x2 scs[2];
#define RW_LOAD(buf, t) do { const float* Rk = R0 + (t) * REC; _Pragma("unroll") for (int i = 0; i < 4; ++i) { dt[buf][i] = *(const f32x4*)(Rk + 4 * i); dt[buf][4 + i] = *(const f32x4*)(Rk + 64 + 4 * i); } \
                    vv[buf] = Rk[320 - kq * 16 + row]; scs[buf] = *(const f32x2*)(Rk + 448 - kq * 16); \
                    _Pragma("unroll") for (int q = 0; q < 3; ++q) _Pragma("unroll") for (int i = 0; i < 4; ++i) up[buf][q * 4 + i] = *(const f32x4*)(Rk + 128 + q * 64 + 4 * i); } while (0)
                RW_LOAD(0, 0);
#pragma unroll
                for (int t = 0; t < RT; ++t) {
                    const int cb = t & 1;
                    if (t + 1 < RT) RW_LOAD(cb ^ 1, t + 1);
                    const float vval = vv[cb];
                    f32x2 sa0 = (f32x2){0.f, 0.f}, sa1 = (f32x2){0.f, 0.f}, yp0 = (f32x2){0.f, 0.f}, yp1 = (f32x2){0.f, 0.f};
#pragma unroll
                    for (int i = 0; i < 4; ++i) {
                        const f32x4 ah = dt[cb][i], wr = dt[cb][4 + i];
                        sa0 += S[2 * i] * (f32x2){ah[0], ah[1]}; sa1 += S[2 * i + 1] * (f32x2){ah[2], ah[3]};
                        yp0 += S[2 * i] * (f32x2){wr[0], wr[1]}; yp1 += S[2 * i + 1] * (f32x2){wr[2], wr[3]};
                    }
                    sa0 += sa1; yp0 += yp1;
                    float sa = sa0[0] + sa0[1], yp = yp0[0] + yp0[1];
                    sa += dpp_x1(sa); yp += dpp_x1(yp);
                    sa += dpp_x2(sa); yp += dpp_x2(yp);
                    if (kq == 0) ob[t * 64] = yp + sa * scs[cb][0] + vval * scs[cb][1];
                    const f32x2 sav = (f32x2){sa, sa}, vvv = (f32x2){vval, vval};
#pragma unroll
                    for (int i = 0; i < 4; ++i) {
                        const f32x4 dc = up[cb][i], bb = up[cb][4 + i], kp = up[cb][8 + i];
                        S[2 * i] = S[2 * i] * (f32x2){dc[0], dc[1]} + sav * (f32x2){bb[0], bb[1]} + vvv * (f32x2){kp[0], kp[1]};
                        S[2 * i + 1] = S[2 * i + 1] * (f32x2){dc[2], dc[3]} + sav * (f32x2){bb[2], bb[3]} + vvv * (f32x2){kp[2], kp[3]};
                    }
                }
#undef RW_LOAD
                LDS_BARRIER();
            }
        } else {
            const int p = wid - 4, lr = lane & 15, quad = lane >> 4;
            bf16_t* lb = linb + p * 4 * 264;
            float* lop = lo + p * 4 * 192;
            const float mu_r = mu[hj], mu_k = mu[512 + hj], mu_v = mu[1024 + hj];
            float mu_l[4];
#pragma unroll
            for (int q = 0; q < 4; ++q) mu_l[q] = mu[1536 + lane + 64 * q];
            const float w0 = w0p[hj], a0 = a0p[hj], k_k = kkp[hj], k_a = kap[hj], r_k = rkp[hj], gn_g = gng[hj], gn_b = gnb[hj];
            const bf16_t* hC = h + (size_t)b * SEQ * INC + COL_C;
            unsigned zraw[5][7];
#define RW_GLOAD(cn) do { _Pragma("unroll") for (int rw = 0; rw < 5; ++rw) { const int t = (cn) * RT + p * 4 + rw - 1; \
                    const bf16_t* ptr = hC + (size_t)(t < 0 ? 0 : t) * INC; \
                    zraw[rw][0] = ptr[hj]; zraw[rw][1] = ptr[512 + hj]; zraw[rw][2] = ptr[1024 + hj]; \
                    _Pragma("unroll") for (int q = 0; q < 4; ++q) zraw[rw][3 + q] = ptr[1536 + lane + 64 * q]; } } while (0)
            RW_GLOAD(0);
            for (int c = -1; c < NC; ++c) {
                const bool do_prep = (c + 1 < NC), do_post = (c >= 1);
                float cr[5], ck[5], cv[5], cl[5][4];
#pragma unroll
                for (int rw = 0; rw < 5; ++rw) { cr[rw] = bf2f(zraw[rw][0]); ck[rw] = bf2f(zraw[rw][1]); cv[rw] = bf2f(zraw[rw][2]);
#pragma unroll
                    for (int q = 0; q < 4; ++q) cl[rw][q] = bf2f(zraw[rw][3 + q]); }
                if (c == -1 && p == 0) { cr[0] = 0.f; ck[0] = 0.f; cv[0] = 0.f; cl[0][0] = 0.f; cl[0][1] = 0.f; cl[0][2] = 0.f; cl[0][3] = 0.f; }
                if (c + 2 < NC) RW_GLOAD(c + 2);
                if (do_post) {
                    const float* Rb = rec + ((c - 1) & 1) * RT * REC;
                    const float* ob = obuf + ((c - 1) & 1) * RT * 64;
                    float ov[4], sm[8];
#pragma unroll
                    for (int u = 0; u < 4; ++u) { ov[u] = ob[(p * 4 + u) * 64 + lane]; sm[2 * u] = ov[u]; sm[2 * u + 1] = ov[u] * ov[u]; }
                    wave_sum_n<8>(sm);
#pragma unroll
                    for (int u = 0; u < 4; ++u) {
                        const int tt = p * 4 + u, t = (c - 1) * RT + tt;
                        const float* R = Rb + tt * REC;
                        const float mean = sm[2 * u] * (1.0f / 64.0f), var = fmaxf(sm[2 * u + 1] * (1.0f / 64.0f) - mean * mean, 0.f);
                        float o = (ov[u] - mean) * __builtin_amdgcn_rsqf(var + GN_EPS) * gn_g + gn_b;
                        o += R[450] * R[320 + lane];
                        yc[(size_t)(b * SEQ + t) * DMIX + hj] = f2bf(o * R[384 + lane]);
                    }
                }
                if (do_prep) {
                    float rr[4], kx[4], vx[4];
#pragma unroll
                    for (int u = 0; u < 4; ++u) {
                        rr[u] = cr[u + 1] + (cr[u] - cr[u + 1]) * mu_r; kx[u] = ck[u + 1] + (ck[u] - ck[u + 1]) * mu_k; vx[u] = cv[u + 1] + (cv[u] - cv[u + 1]) * mu_v;
#pragma unroll
                        for (int q = 0; q < 4; ++q) {
                            const float z = cl[u + 1][q] + (cl[u][q] - cl[u + 1][q]) * mu_l[q];
                            const float val = (q == 0) ? ftanh(z) : (q == 1 ? z : sigmoidf_(z));
                            lb[u * 264 + lane + 64 * q] = f2bf(val);
                        }
                    }
                    asm volatile("s_waitcnt lgkmcnt(0)" ::: "memory");
                    bf16x8 af[8];
#pragma unroll
                    for (int k8 = 0; k8 < 8; ++k8) af[k8] = *(const bf16x8*)(lb + (lane & 3) * 264 + k8 * 32 + quad * 8);
#pragma unroll
                    for (int jt = 0; jt < 4; ++jt) {
                        f32x4 cw = (f32x4){0.f, 0.f, 0.f, 0.f}, ca = cw, cgm = cw;
#pragma unroll
                        for (int kh = 0; kh < 2; ++kh) {
                            cw = __builtin_amdgcn_mfma_f32_16x16x32_bf16(af[kh], *(const bf16x8*)(W2T + (jt * 16 + lr) * 72 + kh * 32 + quad * 8), cw, 0, 0, 0);
                            ca = __builtin_amdgcn_mfma_f32_16x16x32_bf16(af[2 + kh], *(const bf16x8*)(A2T + (jt * 16 + lr) * 72 + kh * 32 + quad * 8), ca, 0, 0, 0);
                        }
#pragma unroll
                        for (int kh = 0; kh < 4; ++kh)
                            cgm = __builtin_amdgcn_mfma_f32_16x16x32_bf16(af[4 + kh], *(const bf16x8*)(G2T + (jt * 16 + lr) * 136 + kh * 32 + quad * 8), cgm, 0, 0, 0);
                        if (quad == 0) {
#pragma unroll
                            for (int jj = 0; jj < 4; ++jj) { lop[jj * 192 + jt * 16 + lr] = cw[jj]; lop[jj * 192 + 64 + jt * 16 + lr] = ca[jj]; lop[jj * 192 + 128 + jt * 16 + lr] = cgm[jj]; }
                        }
                    }
                    asm volatile("s_waitcnt lgkmcnt(0)" ::: "memory");
                    float* Rb = rec + ((c + 1) & 1) * RT * REC;
                    float dcy[4], av[4], kqv[4], kpv[4], ggv[4], red[16];
#pragma unroll
                    for (int u = 0; u < 4; ++u) {
                        const float wl = w0 + lop[u * 192 + lane], ap = a0 + lop[u * 192 + 64 + lane]; ggv[u] = lop[u * 192 + 128 + lane];
                        const float z = -wl;
                        const float sp = fmaxf(z, 0.f) + flog(1.0f + fexp(-fabsf(z)));
                        dcy[u] = fexp(-fexp(-sp - 0.5f));
                        av[u] = sigmoidf_(ap);
                        kqv[u] = kx[u] * k_k;
                        kpv[u] = kx[u] * (1.0f + (av[u] - 1.0f) * k_a);
                        red[4 * u] = kqv[u] * kqv[u]; red[4 * u + 1] = kqv[u] * av[u] * rr[u]; red[4 * u + 2] = kpv[u] * rr[u]; red[4 * u + 3] = rr[u] * kpv[u] * r_k;
                    }
                    wave_sum_n<16>(red);
#pragma unroll
                    for (int u = 0; u < 4; ++u) {
                        const int tt = p * 4 + u;
                        const float inv = __builtin_amdgcn_rcpf(fmaxf(__builtin_amdgcn_sqrtf(red[4 * u]), 1e-12f));
                        const float kkn = kqv[u] * inv;
                        float* R = Rb + tt * REC;
                        R[lane] = -kkn; R[64 + lane] = dcy[u] * rr[u]; R[128 + lane] = dcy[u]; R[192 + lane] = kkn * av[u]; R[256 + lane] = kpv[u]; R[320 + lane] = vx[u]; R[384 + lane] = ggv[u];
                        if (lane == 0) { R[448] = red[4 * u + 1] * inv; R[449] = red[4 * u + 2]; R[450] = red[4 * u + 3]; }
                    }
                }
                LDS_BARRIER();
            }
#undef RW_GLOAD
            {
                const float* Rb = rec + ((NC - 1) & 1) * RT * REC;
                const float* ob = obuf + ((NC - 1) & 1) * RT * 64;
                float ov[4], sm[8];
#pragma unroll
                for (int u = 0; u < 4; ++u) { ov[u] = ob[(p * 4 + u) * 64 + lane]; sm[2 * u] = ov[u]; sm[2 * u + 1] = ov[u] * ov[u]; }
                wave_sum_n<8>(sm);
#pragma unroll
                for (int u = 0; u < 4; ++u) {
                    const int tt = p * 4 + u, t = (NC - 1) * RT + tt;
                    const float* R = Rb + tt * REC;
                    const float mean = sm[2 * u] * (1.0f / 64.0f), var = fmaxf(sm[2 * u + 1] * (1.0f / 64.0f) - mean * mean, 0.f);
                    float o = (ov[u] - mean) * __builtin_amdgcn_rsqf(var + GN_EPS) * gn_g + gn_b;
                    o += R[450] * R[320 + lane];
                    yc[(size_t)(b * SEQ + t) * DMIX + hj] = f2bf(o * R[384 + lane]);
                }
            }
        }
    }
    __syncthreads();
}

#define XB_TMO      128
#define XB_XCNT(j)  (256  + 64 * (j))
#define XB_XSUB(j)  (1280 + 64 * (j))
#define XB_XGEN(j)  (2304 + 64 * (j))
#define XB_TOP      3328
#define XB_TOPGEN   3392
#define XCD_BAR_WORDS 3456
#define XB_SPIN_CAP (1u << 18)
__device__ __forceinline__ unsigned xb_ld(unsigned* p)              { return __hip_atomic_load(p, __ATOMIC_RELAXED, __HIP_MEMORY_SCOPE_AGENT); }
__device__ __forceinline__ unsigned xb_add(unsigned* p, unsigned v) { return __hip_atomic_fetch_add(p, v, __ATOMIC_RELAXED, __HIP_MEMORY_SCOPE_AGENT); }
__device__ __forceinline__ unsigned xb_xcc_id() { return (unsigned)__builtin_amdgcn_s_getreg((3 << 11) | 20) & 0xFu; }
#define XB_SPIN(cond, bar) do { unsigned _sp = 0; while (cond) { __builtin_amdgcn_s_sleep(1); \
    if ((++_sp & 255u) == 0u) { if (xb_ld(&(bar)[XB_TMO])) break; if (_sp > XB_SPIN_CAP) { atomicAdd(&(bar)[XB_TMO], 1u); break; } } } } while (0)
struct XcdBarrier { unsigned* bar; unsigned x; volatile LAS unsigned* st; };
__device__ __forceinline__ XcdBarrier xcd_barrier_post(unsigned* bar, volatile LAS unsigned* st) {
    XcdBarrier b; b.bar = bar; b.x = xb_xcc_id(); b.st = st;
    if (threadIdx.x == 0) (void)xb_add(&bar[XB_XCNT(b.x)], 1u);
    return b;
}
__device__ __forceinline__ void xcd_barrier_complete(unsigned* bar, unsigned x, unsigned& nloc, unsigned& nx) {
    const unsigned G = gridDim.x;
    unsigned sum, cnt, mine, sp = 0u;
    for (;;) {
        sum = 0u; cnt = 0u; mine = 0u;
#pragma unroll
        for (unsigned j = 0; j < 16; ++j) { const unsigned c = xb_ld(&bar[XB_XCNT(j)]); sum += c; cnt += (c > 0u) ? 1u : 0u; mine = (j == x) ? c : mine; }
        if (sum == G) break;
        __builtin_amdgcn_s_sleep(1);
        if ((++sp & 255u) == 0u) { if (xb_ld(&bar[XB_TMO])) break; if (sp > XB_SPIN_CAP) { atomicAdd(&bar[XB_TMO], 1u); break; } }
    }
    nloc = mine > 0u ? mine : 1u; nx = cnt > 0u ? cnt : 1u;
}
__device__ __forceinline__ void xcd_barrier(const XcdBarrier& b, const int tid) {
    asm volatile("s_waitcnt vmcnt(0)" ::: "memory");
    __syncthreads();
    if (tid == 0) {
        unsigned* bar = b.bar;
        __builtin_amdgcn_s_waitcnt(0);
        unsigned nloc = b.st[0], nx = b.st[1];
        if (nloc == 0u) { xcd_barrier_complete(bar, b.x, nloc, nx); b.st[0] = nloc; b.st[1] = nx; }
        const unsigned old = xb_add(&bar[XB_XSUB(b.x)], 1u);
        const unsigned gen = old / nloc;
        if (old + 1u == (gen + 1u) * nloc) {
            __builtin_amdgcn_fence(__ATOMIC_RELEASE, "agent");
            asm volatile("s_waitcnt vmcnt(0)" ::: "memory");
            const unsigned og = xb_add(&bar[XB_TOP], 1u);
            const unsigned tg = og / nx;
            if (og + 1u == (tg + 1u) * nx) xb_add(&bar[XB_TOPGEN], 1u);
            else XB_SPIN(xb_ld(&bar[XB_TOPGEN]) == tg, bar);
            __builtin_amdgcn_fence(__ATOMIC_ACQUIRE, "agent");
            xb_add(&bar[XB_XGEN(b.x)], 1u);
            asm volatile("s_waitcnt vmcnt(0)" ::: "memory");
        } else {
            XB_SPIN(xb_ld(&bar[XB_XGEN(b.x)]) == gen, bar);
            __builtin_amdgcn_fence(__ATOMIC_ACQUIRE, "agent");
            asm volatile("s_waitcnt vmcnt(0)" ::: "memory");
        }
    }
    __syncthreads();
}

constexpr int NPH = 12;
__global__ void __launch_bounds__(512, 2) mega(Params P, int ph_lo, int ph_hi) {
    extern __shared__ __attribute__((aligned(16))) unsigned char shm[];
    LAS unsigned char* lds = (LAS unsigned char*)shm;
    cg::grid_group grid = cg::this_grid();
    const int swid = __builtin_amdgcn_readfirstlane((int)threadIdx.x >> 6);
    volatile LAS unsigned* xst = (volatile LAS unsigned*)(lds + 131072);
    if (threadIdx.x < 2) xst[threadIdx.x] = 0u;
    __syncthreads();
    const XcdBarrier xbar = xcd_barrier_post((unsigned*)(P.ws + WS_BAR), xst);
    unsigned char* ws = P.ws;
    bf16_t* xb = (bf16_t*)(ws + WS_XB);
    bf16_t* wt = (bf16_t*)(ws + WS_WT);
    bf16_t* pb = (bf16_t*)(ws + WS_PB);
    bf16_t* hbuf = (bf16_t*)(ws + WS_H);
    bf16_t* vt = (bf16_t*)(ws + WS_VT);
    bf16_t* pq = hbuf;
    bf16_t* ubuf = hbuf;
    bf16_t* plb = (bf16_t*)(ws + WS_H + 512 * MiB);
    bf16_t* ybase = (bf16_t*)P.out;
    bf16_t* mb = plb;
    for (int ph = ph_lo; ph < ph_hi; ++ph) {
        const int l = ph / NPH, k = ph % NPH;
        const int njobs = (k == 1 || k == 5 || k == 6 || k == 9 || k == 10) ? 1 : (k == 4 ? 4 : (k == 8 ? 2 : 0));
        for (int rep = 0; rep < ((k == REPK) ? REPN : 1); ++rep) {
        int bid_ = blockIdx.x, gdim_ = gridDim.x; asm volatile("" : "+s"(bid_)); asm volatile("" : "+s"(gdim_)); int z_ = 0; asm volatile("" : "+s"(z_));
        int tid_ = (swid << 6) + (int)__builtin_amdgcn_mbcnt_hi(~0u, __builtin_amdgcn_mbcnt_lo(~0u, (unsigned)z_)); asm volatile("" : "+v"(tid_));
        if (njobs) {
            for (int n = 0; n < njobs; ++n) {
                pg8::Epi E; E.mode = 0; E.act = 0; E.ob = nullptr; E.ldo = 0; E.bias = nullptr; E.io2 = nullptr; E.resf = nullptr; E.aux = nullptr;
                pg8::Gemm g; g.M = MTOK; g.A = xb; g.lda = D; g.K = D; g.Bt = wt; g.ldb = D; g.N = D;
                int merge = 0;
                if (k == 1) { E.ob = hbuf; E.ldo = INC; g.Bt = wt + WO_IN; g.N = INC; }
                else if (k == 4) { E.ob = pq + (size_t)n * D; E.ldo = 4 * D; g.A = ybase + (size_t)n * MTOK * DMIX; g.lda = DMIX; g.K = DMIX; g.Bt = wt + WO_B + (size_t)n * D * DMIX; g.ldb = DMIX; }
                else if (k == 5) { E.mode = 3; E.ob = pq; E.ldo = 4 * D; E.bias = P.in[25 + z_] + (size_t)l * 4 * D; E.io2 = mb; g.Bt = wt + WO_G; g.N = 4 * D; merge = 1; }
                else if (k == 6) { E.mode = 2; E.io2 = xb; if (l == 0) E.resf = P.in[0 + z_]; g.A = mb; g.Bt = wt + WO_OUT4; }
                else if (k == 8 && n == 0) { E.act = 1; E.ob = ubuf; E.ldo = DFF; g.Bt = wt + WO_FF1; g.N = DFF; }
                else if (k == 8) { E.ob = plb; E.ldo = D; g.A = pb; g.lda = DPLE; g.K = DPLE; g.Bt = wt + WO_PLE; g.ldb = DPLE; }
                else if (k == 9) { E.mode = 1; E.ob = plb; E.ldo = D; E.bias = P.in[33 + z_] + (size_t)l * D; g.Bt = wt + WO_PLEG; }
                else { E.mode = 2; E.io2 = xb; E.aux = plb; g.A = ubuf; g.lda = DFF; g.K = DFF; g.Bt = wt + WO_FF2; g.ldb = DFF; }
                pg8::StaticOrder S; S.init(g.M, g.N, gdim_, bid_, merge);
                pg8::gemm_phase(tid_, lds, g, S, E);
                __syncthreads();
            }
        } else if (k == 0) {
            float* tile = (float*)shm;
            tconv(tid_, bid_, gdim_, tile, P.in[2 + z_] + (size_t)l * D * INC, D, INC, wt + WO_IN, D);
            for (int n = 0; n < 4; ++n) tconv(tid_, bid_, gdim_, tile, P.in[24 + z_] + ((size_t)l * 4 + n) * D * D, D, D, wt + WO_G + (size_t)n * D * D, D);
            for (int n = 0; n < 4; ++n) tconv(tid_, bid_, gdim_, tile, P.in[23 + z_] + ((size_t)l * 4 + n) * DMIX * D, DMIX, D, wt + WO_B + (size_t)n * D * DMIX, DMIX);
            tconv(tid_, bid_, gdim_, tile, P.in[26 + z_] + (size_t)l * D * D, D, D, wt + WO_OUT4, D);
            tconv(tid_, bid_, gdim_, tile, P.in[29 + z_] + (size_t)l * D * DFF, D, DFF, wt + WO_FF1, D);
            tconv(tid_, bid_, gdim_, tile, P.in[30 + z_] + (size_t)l * DFF * D, DFF, D, wt + WO_FF2, DFF);
            tconv(tid_, bid_, gdim_, tile, P.in[31 + z_] + (size_t)l * DPLE * D, DPLE, D, wt + WO_PLE, DPLE);
            tconv(tid_, bid_, gdim_, tile, P.in[32 + z_] + (size_t)l * D * D, D, D, wt + WO_PLEG, D);
            econv(tid_, bid_, gdim_, P.in[1 + z_] + (size_t)l * MTOK * DPLE, pb, MTOK * DPLE);
            if (l == 0) econv(tid_, bid_, gdim_, P.in[0 + z_], xb, MTOK * D);
        } else if (k == 2) {
            int vt_next = bid_;
            for (int r2 = 0; r2 < REP_LRU; ++r2) { int t2_ = tid_, b2_ = bid_; asm volatile("" : "+v"(t2_)); asm volatile("" : "+s"(b2_));
            vt_next = lru_phase(t2_, b2_, gdim_, shm, hbuf, P.in[3 + z_] + (size_t)l * 4 * DMIX, P.in[4 + z_] + (size_t)l * DMIX, P.in[5 + z_] + (size_t)l * 8 * 4096, P.in[6 + z_] + (size_t)l * DMIX,
                      P.in[7 + z_] + (size_t)l * 8 * 4096, P.in[8 + z_] + (size_t)l * DMIX, P.in[9 + z_] + (size_t)l * DMIX, ybase, vt, P.in[10 + z_] + (size_t)l * 3 * DMIX, ybase + (size_t)1 * MTOK * DMIX);
            }
            for (int r2 = 0; r2 < REP_RWKV; ++r2) { int t2_ = tid_, b2_ = bid_; asm volatile("" : "+v"(t2_)); asm volatile("" : "+s"(b2_));
            rwkv_phase(t2_, b2_, gdim_, shm, hbuf, P.in[11 + z_] + (size_t)l * 1792, P.in[12 + z_] + (size_t)l * DMIX, P.in[13 + z_] + (size_t)l * 64 * DMIX, P.in[14 + z_] + (size_t)l * DMIX,
                       P.in[15 + z_] + (size_t)l * 64 * DMIX, P.in[16 + z_] + (size_t)l * 128 * DMIX, P.in[17 + z_] + (size_t)l * DMIX, P.in[18 + z_] + (size_t)l * DMIX,
                       P.in[19 + z_] + (size_t)l * DMIX, P.in[20 + z_] + (size_t)l * DMIX, P.in[21 + z_] + (size_t)l * DMIX, ybase + (size_t)2 * MTOK * DMIX);
            }
            for (int r2 = 0; r2 < REP_SV; ++r2) { int t2_ = tid_, b2_ = bid_; asm volatile("" : "+v"(t2_)); asm volatile("" : "+s"(b2_));
            vtrans_phase(t2_, vt_next, gdim_, (bf16_t*)shm, hbuf, vt);
            }
        } else if (k == 3) {
            attn_phase(tid_, bid_, gdim_, shm, hbuf, vt, P.in[22 + z_], ybase + (size_t)3 * MTOK * DMIX);
        } else if (k == 7) {
            ln_phase(tid_, bid_, gdim_, xb, P.in[27 + z_] + (size_t)l * D, P.in[28 + z_] + (size_t)l * D, nullptr);
        } else {
            ln_phase(tid_, bid_, gdim_, xb, P.in[34 + z_] + (size_t)l * D, P.in[35 + z_] + (size_t)l * D, l == DEPTH - 1 ? P.out : nullptr);
        }
        }
        if (ph + 1 < ph_hi) { if (ph == ph_lo) { asm volatile("s_waitcnt vmcnt(0) lgkmcnt(0)" ::: "memory"); grid.sync(); } else { int zb_ = 0; asm volatile("" : "+s"(zb_)); const int tb_ = (swid << 6) + (int)__builtin_amdgcn_mbcnt_hi(~0u, __builtin_amdgcn_mbcnt_lo(~0u, (unsigned)zb_)); xcd_barrier(xbar, tb_); } }
    }
}

extern "C" void kernel_launch(void* const* d_in, const int* in_sizes, int n_in, void* d_out, int out_size, void* d_ws, size_t ws_size, hipStream_t stream) {
    static int grid = 0;
    if (grid == 0) {
        int dev = 0, cus = 0, per_cu = 0;
        hipGetDevice(&dev);
        hipDeviceGetAttribute(&cus, hipDeviceAttributeMultiprocessorCount, dev);
        hipFuncSetAttribute((const void*)mega, hipFuncAttributeMaxDynamicSharedMemorySize, LDS_BYTES);
        hipOccupancyMaxActiveBlocksPerMultiprocessor(&per_cu, (const void*)mega, 512, LDS_BYTES);
        if (per_cu < 1) { fprintf(stderr, "kernel_launch: occupancy query says %d blocks/CU\n", per_cu); per_cu = 1; }
        (void)hipGetLastError();
        grid = cus * 1;
        if (n_in != 36 || ws_size < 1013 * MiB) fprintf(stderr, "kernel_launch: unexpected n_in %d / ws_size %zu\n", n_in, ws_size);
    }
    (void)hipMemsetAsync((char*)d_ws + WS_BAR, 0, XCD_BAR_WORDS * sizeof(unsigned), stream);
    Params p{};
    for (int i = 0; i < 36; ++i) p.in[i] = (const float*)d_in[i];
    p.out = (float*)d_out; p.ws = (unsigned char*)d_ws;
#if ONE_LAUNCH
    int lo = 0, hi = DEPTH * NPH;
    void* args[] = {&p, &lo, &hi};
    hipError_t e = hipLaunchCooperativeKernel((const void*)mega, dim3(grid), dim3(512), args, LDS_BYTES, stream);
    if (e != hipSuccess) fprintf(stderr, "cooperative launch failed: %s (grid %d)\n", hipGetErrorString(e), grid);
#else
    for (int ph = 0; ph < DEPTH * NPH; ++ph) hipLaunchKernelGGL(mega, dim3(grid), dim3(512), LDS_BYTES, stream, p, ph, ph + 1);
#endif
}
```

```cpp
#include <hip/hip_runtime.h>
#include <hip/hip_cooperative_groups.h>
#include <cstdio>
#include <cstdint>
namespace cg = cooperative_groups;

#ifndef REPK
#define REPK -1
#endif
#ifndef REPN
#define REPN 1
#endif
#ifndef REP_LRU
#define REP_LRU 1
#endif
#ifndef REP_RWKV
#define REP_RWKV 1
#endif
#ifndef REP_SV
#define REP_SV 1
#endif
#ifndef ONE_LAUNCH
#define ONE_LAUNCH 1
#endif

#define LAS __attribute__((address_space(3)))
typedef unsigned short bf16_t;
typedef short bf16x8 __attribute__((ext_vector_type(8)));
typedef short bf16x4 __attribute__((ext_vector_type(4)));
typedef float f32x4 __attribute__((ext_vector_type(4)));
typedef float f32x2 __attribute__((ext_vector_type(2)));
typedef unsigned u32x4 __attribute__((ext_vector_type(4)));
typedef unsigned u32x2 __attribute__((ext_vector_type(2)));

constexpr int D = 1024, BATCH = 32, SEQ = 2048, DEPTH = 2, MTOK = BATCH * SEQ;
constexpr int DMIX = 512, INC = 5888, DFF = 4096, DPLE = 256;
constexpr int COL_A = 0, COL_B = 1024, COL_C = 2560, COL_D = 4352;
constexpr float ALPHA = 1.4142135623730951f;
constexpr float LN_EPS = 1e-5f, GN_EPS = 64e-5f;

constexpr size_t MiB = 1ull << 20;
constexpr size_t WS_XB = 0, WS_WT = 128 * MiB, WS_PB = 180 * MiB, WS_H = 212 * MiB, WS_VT = 948 * MiB;
constexpr size_t WO_IN = 0, WO_G = 6029312, WO_B = WO_G + 4194304, WO_OUT4 = WO_B + 2097152, WO_FF1 = WO_OUT4 + 4194304,
                 WO_FF2 = WO_FF1 + 4194304, WO_PLE = WO_FF2 + 4194304, WO_PLEG = WO_PLE + 262144;
constexpr int LDS_BYTES = 131072 + 16 + 9216;
constexpr size_t WS_BAR = 1012 * MiB;

struct Params {
    const float* in[36];
    float* out;
    unsigned char* ws;
};

__device__ __forceinline__ float bf2f(unsigned v) { return __uint_as_float(v << 16); }
typedef __bf16 bf16x2_t __attribute__((ext_vector_type(2)));
__device__ __forceinline__ unsigned cvt_pk_bf16(float lo, float hi) { f32x2 v = {lo, hi}; bf16x2_t b = __builtin_convertvector(v, bf16x2_t); unsigned r; __builtin_memcpy(&r, &b, 4); return r; }
__device__ __forceinline__ bf16_t f2bf(float f) { return (bf16_t)(cvt_pk_bf16(f, 0.f) & 0xffffu); }
__device__ __forceinline__ float fexp(float x) { return __builtin_amdgcn_exp2f(x * 1.4426950408889634f); }
__device__ __forceinline__ float flog(float x) { return __builtin_amdgcn_logf(x) * 0.6931471805599453f; }
__device__ __forceinline__ float ftanh(float x) { return 1.0f - 2.0f * __builtin_amdgcn_rcpf(1.0f + fexp(2.0f * x)); }
__device__ __forceinline__ float flog1p_small(float x) { return flog(1.0f + x); }
__device__ __forceinline__ float fneg_expm1(float t) { return 1.0f - fexp(t); }
__device__ __forceinline__ float sigmoidf_(float x) { return __builtin_amdgcn_rcpf(1.0f + fexp(-x)); }
__device__ __forceinline__ float wave_sum(float v) {
    v += __int_as_float(__builtin_amdgcn_update_dpp(0, __float_as_int(v), 0xB1, 0xF, 0xF, true));
    v += __int_as_float(__builtin_amdgcn_update_dpp(0, __float_as_int(v), 0x4E, 0xF, 0xF, true));
    v += __int_as_float(__builtin_amdgcn_update_dpp(0, __float_as_int(v), 0x141, 0xF, 0xF, true));
    v += __int_as_float(__builtin_amdgcn_update_dpp(0, __float_as_int(v), 0x140, 0xF, 0xF, true));
    const float s0 = __int_as_float(__builtin_amdgcn_readlane(__float_as_int(v), 0)), s1 = __int_as_float(__builtin_amdgcn_readlane(__float_as_int(v), 16));
    const float s2 = __int_as_float(__builtin_amdgcn_readlane(__float_as_int(v), 32)), s3 = __int_as_float(__builtin_amdgcn_readlane(__float_as_int(v), 48));
    return (s0 + s1) + (s2 + s3);
}
template <int N> __device__ __forceinline__ void wave_sum_n(float (&v)[N]) {
#pragma unroll
    for (int i = 0; i < N; ++i) v[i] += __int_as_float(__builtin_amdgcn_update_dpp(0, __float_as_int(v[i]), 0xB1, 0xF, 0xF, true));
#pragma unroll
    for (int i = 0; i < N; ++i) v[i] += __int_as_float(__builtin_amdgcn_update_dpp(0, __float_as_int(v[i]), 0x4E, 0xF, 0xF, true));
#pragma unroll
    for (int i = 0; i < N; ++i) v[i] += __int_as_float(__builtin_amdgcn_update_dpp(0, __float_as_int(v[i]), 0x141, 0xF, 0xF, true));
#pragma unroll
    for (int i = 0; i < N; ++i) v[i] += __int_as_float(__builtin_amdgcn_update_dpp(0, __float_as_int(v[i]), 0x140, 0xF, 0xF, true));
#pragma unroll
    for (int i = 0; i < N; ++i) v[i] += __int_as_float(__builtin_amdgcn_update_dpp(0, __float_as_int(v[i]), 0x142, 0xA, 0xF, false));
#pragma unroll
    for (int i = 0; i < N; ++i) v[i] += __int_as_float(__builtin_amdgcn_update_dpp(0, __float_as_int(v[i]), 0x143, 0xC, 0xF, false));
#pragma unroll
    for (int i = 0; i < N; ++i) v[i] = __int_as_float(__builtin_amdgcn_readlane(__float_as_int(v[i]), 63));
}
__device__ __forceinline__ float shflx(float v, int lane, int m) { return __int_as_float(__builtin_amdgcn_ds_bpermute((lane ^ m) << 2, __float_as_int(v))); }
__device__ __forceinline__ void unpack8(u32x4 u, float* f) {
#pragma unroll
    for (int i = 0; i < 4; ++i) { f[2 * i] = __uint_as_float(u[i] << 16); f[2 * i + 1] = __uint_as_float(u[i] & 0xffff0000u); }
}
__device__ __forceinline__ u32x4 pack8(const float* f) {
    u32x4 u;
#pragma unroll
    for (int i = 0; i < 4; ++i) u[i] = cvt_pk_bf16(f[2 * i], f[2 * i + 1]);
    return u;
}

namespace pg8 {
constexpr int BM = 256, BK = 64, HALF = 128, HTB = HALF * BK * 2, STAGE_BYTES = 8 * HTB, NXCD = 8, WGM = 8;
__host__ __device__ __forceinline__ int lds_byte(int r, int c) { const int st = (r >> 4) * 2 + (c >> 5), rr = r & 15, cc = c & 31, ob = rr * 64 + cc * 2; return st * 1024 + (ob ^ (((ob >> 9) & 1) << 5)); }
__host__ __device__ __forceinline__ void stage_rc(int b, int& R, int& C) { const int st = b / 1024, sb = b % 1024, swz = sb ^ (((sb >> 9) & 1) << 5); R = (st >> 1) * 16 + swz / 64; C = (st & 1) * 32 + (swz % 64) / 2; }
__host__ __device__ __forceinline__ int perm32(int rho) { const int n = rho >> 4, i = rho & 15; return 8 * (i >> 2) + 4 * n + (i & 3); }
struct Unit { int pm, pn; };
struct Gemm { const bf16_t* A; const bf16_t* Bt; int M, N, K, lda, ldb; };
struct StaticOrder {
    int nM, nN, nwg, G, c, merge;
    __device__ void init(int M, int N, int G_, int c_, int merge_) { merge = merge_; nM = M / BM; nN = (merge_ ? N / 4 : N) / BM; nwg = nM * nN; G = G_; c = c_; }
    __device__ bool next(int i, Unit& u) const {
        int n = 0; if (merge) { n = i & 3; i >>= 2; }
        const long L = (long)i * G + c; if (L >= nwg) return false;
        int wgid = (int)L; { const int q = nwg / NXCD, r = nwg % NXCD, xcd = wgid % NXCD, off = wgid / NXCD; wgid = (xcd < r ? xcd * (q + 1) : r * (q + 1) + (xcd - r) * q) + off; }
        const int nig = WGM * nN, gid = wgid / nig, fm = gid * WGM, gsz = (nM - fm) < WGM ? (nM - fm) : WGM;
        u.pm = fm + ((wgid % nig) % gsz); u.pn = (wgid % nig) / gsz + n * nN; return true;
    }
};

struct Epi {
    int mode;
    int act;
    bf16_t* ob; int ldo;
    const float* bias;
    bf16_t* io2;
    const float* resf;
    const bf16_t* aux;
    __device__ __forceinline__ void operator()(const f32x4 (&acc)[2][2][4][2], const Unit& u, int wr, int wc, int fr, int fq, LAS unsigned char* dump) const {
        int row0 = u.pm * BM + wr * 64 + fr, col0 = u.pn * BM + wc * 32 + 8 * fq;
        asm volatile("" : "+v"(row0), "+v"(col0));
        float bv[2][8];
        if (mode == 1 || mode == 3) {
#pragma unroll
            for (int bj = 0; bj < 2; ++bj) { const f32x4 b0 = *(const f32x4*)(bias + col0 + bj * HALF), b1 = *(const f32x4*)(bias + col0 + bj * HALF + 4);
#pragma unroll
                for (int j = 0; j < 4; ++j) { bv[bj][j] = b0[j]; bv[bj][4 + j] = b1[j]; } }
        }
        if (mode != 0) {
#pragma unroll
            for (int ai = 0; ai < 2; ++ai)
#pragma unroll
                for (int m = 0; m < 4; ++m)
#pragma unroll
                    for (int bj = 0; bj < 2; ++bj) {
                        const size_t row = (size_t)(row0 + ai * HALF + m * 16); const int col = col0 + bj * HALF;
                        const void* p0 = (mode == 2) ? (resf ? (const void*)(resf + row * D + col) : (const void*)(io2 + row * D + col)) : (const void*)(ob + row * ldo + col);
                        __builtin_amdgcn_global_load_lds((const unsigned*)p0, (LAS unsigned*)dump, 16, 0, 0);
                        if (mode == 2 && aux) __builtin_amdgcn_global_load_lds((const unsigned*)(aux + row * D + col), (LAS unsigned*)dump, 16, 0, 0);
                    }
        }
#pragma unroll
        for (int aim = 0; aim < 4; ++aim) {
            const int ai = aim >> 1, mh = aim & 1;
            u32x4 L0[4], L1[4];
            if (mode != 0) {
#pragma unroll
                for (int m2 = 0; m2 < 2; ++m2)
#pragma unroll
                    for (int bj = 0; bj < 2; ++bj) {
                        const int m = mh * 2 + m2;
                        const size_t row = (size_t)(row0 + ai * HALF + m * 16); const int col = col0 + bj * HALF, e = m2 * 2 + bj;
                        if (mode == 1) L0[e] = *(const u32x4*)(ob + row * ldo + col);
                        else if (mode == 3) { L0[e] = *(const u32x4*)(ob + row * ldo + col);
                            if (col >= D) L1[e] = *(const u32x4*)(io2 + row * D + (col & (D - 1))); }
                        else { if (resf) { L0[e] = *(const u32x4*)(resf + row * D + col); L1[e] = *(const u32x4*)(resf + row * D + col + 4); }
                               else { L0[e] = *(const u32x4*)(io2 + row * D + col); if (aux) L1[e] = *(const u32x4*)(aux + row * D + col); } }
                    }
            }
#pragma unroll
            for (int m2 = 0; m2 < 2; ++m2)
#pragma unroll
                for (int bj = 0; bj < 2; ++bj) {
                    const int m = mh * 2 + m2;
                    const size_t row = (size_t)(row0 + ai * HALF + m * 16); const int col = col0 + bj * HALF, e = m2 * 2 + bj;
                    float v[8];
#pragma unroll
                    for (int j = 0; j < 4; ++j) { v[j] = acc[ai][bj][m][0][j]; v[4 + j] = acc[ai][bj][m][1][j]; }
                    if (mode == 0) {
                        if (act == 1) {
#pragma unroll
                            for (int j = 0; j < 8; ++j) { const float t = fmaxf(v[j], 0.f); v[j] = t * t; }
                        }
                        *(u32x4*)(ob + row * ldo + col) = pack8(v);
                    } else if (mode == 1) {
                        float a[8]; unpack8(L0[e], a);
#pragma unroll
                        for (int j = 0; j < 8; ++j) v[j] = sigmoidf_(v[j] + bv[bj][j]) * a[j];
                        *(u32x4*)(ob + row * ldo + col) = pack8(v);
                    } else if (mode == 3) {
                        float a[8]; unpack8(L0[e], a);
#pragma unroll
                        for (int j = 0; j < 8; ++j) v[j] = sigmoidf_(v[j] + bv[bj][j]) * a[j];
                        if (col >= D) { float q[8]; unpack8(L1[e], q);
#pragma unroll
                            for (int j = 0; j < 8; ++j) v[j] += q[j]; }
                        *(u32x4*)(io2 + row * D + (col & (D - 1))) = pack8(v);
                    } else {
                        float r[8];
                        if (resf) {
#pragma unroll
                            for (int j = 0; j < 4; ++j) { r[j] = __uint_as_float(L0[e][j]); r[4 + j] = __uint_as_float(L1[e][j]); } }
                        else unpack8(L0[e], r);
#pragma unroll
                        for (int j = 0; j < 8; ++j) v[j] += ALPHA * r[j];
                        if (aux) { float a[8]; unpack8(L1[e], a);
#pragma unroll
                            for (int j = 0; j < 8; ++j) v[j] += a[j]; }
                        *(u32x4*)(io2 + row * D + col) = pack8(v);
                    }
                }
        }
    }
};

__device__ __forceinline__ void gemm_phase(const int tid, LAS unsigned char* lds, const Gemm g, const StaticOrder& S, const Epi& E) {
    const int wid = __builtin_amdgcn_readfirstlane(tid >> 6), lane = tid & 63, wr = wid >> 2, wc = wid & 3, fr = lane & 15, fq = lane >> 4;
    const int K = g.K, nt = K / BK;
    unsigned voffA, voffB;
    { int R, C; stage_rc(tid * 16, R, C); const int Rb = (R & ~31) + perm32(R & 31); voffA = (unsigned)(R * g.lda + C) * 2u; voffB = (unsigned)(Rb * g.ldb + C) * 2u; }
    const size_t p2A = (size_t)64 * g.lda * 2, p2B = (size_t)64 * g.ldb * 2;
    const size_t kstep = (size_t)(BK * 2);
    const size_t hstepA = (size_t)HALF * g.lda * 2, hstepB = (size_t)HALF * g.ldb * 2;
    const size_t tstepA = 2 * hstepA, tstepB = 2 * hstepB;
    const unsigned ldsw = (unsigned)wid * 1024u;
    const int aoff = lds_byte(wr * 64 + fr, fq * 8), boff = lds_byte(wc * 32 + fr, fq * 8);
#define XA voffA
#define XB voffB
#define p2XA p2A
#define p2XB p2B
#define PG8_SA(b, h) (((b) * 2 + (h)) * HTB)
#define PG8_SB(b, h) ((4 + (b) * 2 + (h)) * HTB)
#define PG8_STAGE(bufoff, gbase, voff) do { \
        __builtin_amdgcn_global_load_lds((const unsigned*)((const char*)(gbase) + (voff)), (LAS unsigned*)(lds + (bufoff) + ldsw), 16, 0, 0); \
        __builtin_amdgcn_global_load_lds((const unsigned*)((const char*)(gbase) + p2##voff + (voff)), (LAS unsigned*)(lds + (bufoff) + ldsw + 8192), 16, 0, 0); } while (0)
#define PG8_LDA(dst, b, h) do { _Pragma("unroll") for (int m = 0; m < 4; ++m) _Pragma("unroll") for (int k = 0; k < 2; ++k) dst[m][k] = *(const LAS bf16x8*)(lds + PG8_SA(b, h) + aoff + m * 2048 + k * 1024); } while (0)
#define PG8_LDB(dst, b, h) do { _Pragma("unroll") for (int n = 0; n < 2; ++n) _Pragma("unroll") for (int k = 0; k < 2; ++k) dst[n][k] = *(const LAS bf16x8*)(lds + PG8_SB(b, h) + boff + n * 2048 + k * 1024); } while (0)
#define PG8_MMA(ai, bj, At, Bt) do { __builtin_amdgcn_s_setprio(1); _Pragma("unroll") for (int m = 0; m < 4; ++m) _Pragma("unroll") for (int n = 0; n < 2; ++n) _Pragma("unroll") for (int k = 0; k < 2; ++k) \
        acc[ai][bj][m][n] = __builtin_amdgcn_mfma_f32_16x16x32_bf16(Bt[n][k], At[m][k], acc[ai][bj][m][n], 0, 0, 0); __builtin_amdgcn_s_setprio(0); } while (0)
#define PG8_WAIT_V(n) asm volatile("s_waitcnt vmcnt(" #n ")" ::: "memory")
#define PG8_WAIT_L(n) asm volatile("s_waitcnt lgkmcnt(" #n ")" ::: "memory")
#define PG8_BAR __builtin_amdgcn_s_barrier()
#define PG8_SCHED __builtin_amdgcn_sched_barrier(0)
    Unit cur, nxt; int ui = 0;
    if (!S.next(0, cur)) return;
    f32x4 acc[2][2][4][2];
    bf16x8 At[4][2], B0[2][2], B1[2][2];
    const char* cA = (const char*)g.A + (size_t)cur.pm * tstepA; const char* cB = (const char*)g.Bt + (size_t)cur.pn * tstepB;
    PG8_STAGE(PG8_SB(0, 0), cB, XB); PG8_STAGE(PG8_SB(0, 1), cB + hstepB, XB); PG8_STAGE(PG8_SA(0, 0), cA, XA); PG8_STAGE(PG8_SA(0, 1), cA + hstepA, XA);
    if (wr == 1) PG8_BAR;
    PG8_WAIT_V(2); PG8_BAR;
    PG8_STAGE(PG8_SB(1, 0), cB + kstep, XB); PG8_STAGE(PG8_SA(1, 0), cA + kstep, XA); PG8_STAGE(PG8_SB(1, 1), cB + hstepB + kstep, XB);
    PG8_WAIT_V(6); PG8_BAR;
    PG8_SCHED;
#pragma unroll
    for (int a = 0; a < 2; ++a)
#pragma unroll
        for (int b = 0; b < 2; ++b)
#pragma unroll
            for (int m = 0; m < 4; ++m)
#pragma unroll
                for (int n = 0; n < 2; ++n) acc[a][b][m][n] = (f32x4){0.f, 0.f, 0.f, 0.f};
    for (;;) {
        const bool has_next = S.next(ui + 1, nxt);
        const char* nA = has_next ? (const char*)g.A + (size_t)nxt.pm * tstepA : cA; const char* nB = has_next ? (const char*)g.Bt + (size_t)nxt.pn * tstepB : cB;
        for (int t = 0; t < nt; t += 2) {
            const bool last = (t == nt - 2);
            const char* a1 = cA + (size_t)(t + 1) * kstep;
            const char* a2 = last ? nA : cA + (size_t)(t + 2) * kstep; const char* b2 = last ? nB : cB + (size_t)(t + 2) * kstep;
            const char* a3 = a2 + kstep; const char* b3 = b2 + kstep;
            PG8_LDB(B0, 0, 0); PG8_LDB(B1, 0, 1); PG8_SCHED; PG8_LDA(At, 0, 0); PG8_STAGE(PG8_SA(1, 1), a1 + hstepA, XA);
            PG8_WAIT_V(8); PG8_WAIT_L(0); PG8_BAR; PG8_MMA(0, 0, At, B0); PG8_MMA(0, 1, At, B1); PG8_BAR; PG8_SCHED;
            PG8_LDA(At, 0, 1); PG8_STAGE(PG8_SB(0, 0), b2, XB); PG8_STAGE(PG8_SB(0, 1), b2 + hstepB, XB); PG8_STAGE(PG8_SA(0, 0), a2, XA);
            PG8_WAIT_V(8); PG8_WAIT_L(0); PG8_BAR; PG8_MMA(1, 0, At, B0); PG8_MMA(1, 1, At, B1); PG8_BAR; PG8_SCHED;
            PG8_LDB(B0, 1, 0); PG8_LDB(B1, 1, 1); PG8_SCHED; PG8_LDA(At, 1, 0); PG8_STAGE(PG8_SA(0, 1), a2 + hstepA, XA);
            PG8_WAIT_V(8); PG8_WAIT_L(0); PG8_BAR; PG8_MMA(0, 0, At, B0); PG8_MMA(0, 1, At, B1); PG8_BAR; PG8_SCHED;
            PG8_LDA(At, 1, 1); PG8_STAGE(PG8_SB(1, 0), b3, XB); PG8_STAGE(PG8_SB(1, 1), b3 + hstepB, XB); PG8_STAGE(PG8_SA(1, 0), a3, XA);
            PG8_WAIT_V(8); PG8_WAIT_L(0); PG8_BAR; PG8_MMA(1, 0, At, B0); PG8_MMA(1, 1, At, B1); PG8_BAR; PG8_SCHED;
        }
        if (wr == 0) PG8_BAR;
        E(acc, cur, wr, wc, fr, fq, lds + 131088 + ldsw);
        if (!has_next) break;
#pragma unroll
        for (int a = 0; a < 2; ++a)
#pragma unroll
            for (int b = 0; b < 2; ++b)
#pragma unroll
                for (int m = 0; m < 4; ++m)
#pragma unroll
                    for (int n = 0; n < 2; ++n) acc[a][b][m][n] = (f32x4){0.f, 0.f, 0.f, 0.f};
        cur = nxt; cA = nA; cB = nB; ++ui;
        if (wr == 1) PG8_BAR;
    }
    PG8_WAIT_V(0);
    PG8_BAR;
#undef PG8_SA
#undef PG8_SB
#undef PG8_STAGE
#undef PG8_LDA
#undef PG8_LDB
#undef PG8_MMA
#undef PG8_WAIT_V
#undef PG8_WAIT_L
#undef PG8_BAR
#undef PG8_SCHED
}
}

#define LDS_BARRIER() do { asm volatile("s_waitcnt lgkmcnt(0)" ::: "memory"); __builtin_amdgcn_s_barrier(); asm volatile("" ::: "memory"); } while (0)

__device__ __forceinline__ void tconv(const int tid_, const int bid_, const int gdim_, float* tile, const float* __restrict__ src, int K, int N, bf16_t* __restrict__ dst, int ldd) {
    const int tn = N / 64, nt = (K / 64) * tn;
    const int r = tid_ >> 3, c = (tid_ & 7) * 8;
    int t = bid_;
    f32x4 a, b;
    if (t < nt) { const f32x4* s = (const f32x4*)(src + (size_t)((t / tn) * 64 + r) * N + (t % tn) * 64 + c); a = s[0]; b = s[1]; }
    for (; t < nt; t += gdim_) {
        const int k0 = (t / tn) * 64, n0 = (t % tn) * 64;
#pragma unroll
        for (int j = 0; j < 4; ++j) { tile[r * 65 + c + j] = a[j]; tile[r * 65 + c + 4 + j] = b[j]; }
        const int t2 = t + gdim_;
        if (t2 < nt) { const f32x4* s = (const f32x4*)(src + (size_t)((t2 / tn) * 64 + r) * N + (t2 % tn) * 64 + c); a = s[0]; b = s[1]; }
        LDS_BARRIER();
        float v[8];
#pragma unroll
        for (int j = 0; j < 8; ++j) v[j] = tile[(c + j) * 65 + r];
        *(u32x4*)(dst + (size_t)(n0 + r) * ldd + k0 + c) = pack8(v);
        LDS_BARRIER();
    }
}
__device__ __forceinline__ void econv(const int tid_, const int bid_, const int gdim_, const float* __restrict__ src, bf16_t* __restrict__ dst, int n) {
    const int nth = gdim_ * 512 * 8;
    for (int i = (bid_ * 512 + tid_) * 8; i < n; i += nth) {
        const f32x4 a = *(const f32x4*)(src + i), b = *(const f32x4*)(src + i + 4);
        float v[8] = {a[0], a[1], a[2], a[3], b[0], b[1], b[2], b[3]};
        *(u32x4*)(dst + i) = pack8(v);
    }
}

__device__ __forceinline__ void ln_phase(const int tid_, const int bid_, const int gdim_, bf16_t* xio, const float* __restrict__ g, const float* __restrict__ b, float* outf) {
    const int lane = tid_ & 63, wid = tid_ >> 6;
    const int nw = gdim_ * 8;
    float gg[16], bb[16];
#pragma unroll
    for (int i = 0; i < 2; ++i)
#pragma unroll
        for (int j = 0; j < 8; ++j) { gg[i * 8 + j] = g[i * 512 + lane * 8 + j]; bb[i * 8 + j] = b[i * 512 + lane * 8 + j]; }
    for (int row = bid_ * 8 + wid; row < MTOK; row += nw) {
        bf16_t* p = xio + (size_t)row * D + lane * 8;
        float v[16]; unpack8(*(const u32x4*)p, v); unpack8(*(const u32x4*)(p + 512), v + 8);
        float s = 0.f;
#pragma unroll
        for (int j = 0; j < 16; ++j) s += v[j];
        const float mean = wave_sum(s) * (1.0f / D);
        float q = 0.f;
#pragma unroll
        for (int j = 0; j < 16; ++j) { const float d = v[j] - mean; q += d * d; }
        const float rstd = __builtin_amdgcn_rsqf(wave_sum(q) * (1.0f / D) + LN_EPS);
#pragma unroll
        for (int j = 0; j < 16; ++j) v[j] = (v[j] - mean) * rstd * gg[j] + bb[j];
        if (!outf) { *(u32x4*)p = pack8(v); *(u32x4*)(p + 512) = pack8(v + 8); }
        else { float* o = outf + (size_t)row * D + lane * 8;
            *(f32x4*)o = (f32x4){v[0], v[1], v[2], v[3]}; *(f32x4*)(o + 4) = (f32x4){v[4], v[5], v[6], v[7]};
            *(f32x4*)(o + 512) = (f32x4){v[8], v[9], v[10], v[11]}; *(f32x4*)(o + 516) = (f32x4){v[12], v[13], v[14], v[15]}; }
    }
}

__device__ __forceinline__ void sconv_phase(const int tid_, const int bid_, const int gdim_, const bf16_t* __restrict__ h, const float* __restrict__ w  , bf16_t* __restrict__ yb) {
    const size_t nth = (size_t)gdim_ * 512;
    for (size_t idx = (size_t)bid_ * 512 + tid_; idx < (size_t)MTOK * 64; idx += nth) {
        const int tok = (int)(idx >> 6), c8 = (int)(idx & 63) * 8, t = tok & (SEQ - 1);
        float acc[8];
#pragma unroll
        for (int j = 0; j < 8; ++j) acc[j] = 0.f;
#pragma unroll
        for (int k = 0; k < 3; ++k) {
            const int tt = t - 2 + k;
            if (tt >= 0) {
                const bf16_t* row = h + (size_t)(tok - 2 + k) * INC + COL_B;
                float cgv[8], xh[8]; unpack8(*(const u32x4*)(row + 512 + c8), cgv); unpack8(*(const u32x4*)(row + 1024 + c8), xh);
                const f32x4 w0 = *(const f32x4*)(w + k * 512 + c8), w1 = *(const f32x4*)(w + k * 512 + c8 + 4);
#pragma unroll
                for (int j = 0; j < 4; ++j) { acc[j] += w0[j] * (cgv[j] * xh[j]); acc[4 + j] += w1[j] * (cgv[4 + j] * xh[4 + j]); }
            }
        }
        float bg[8]; unpack8(*(const u32x4*)(h + (size_t)tok * INC + COL_B + c8), bg);
#pragma unroll
        for (int j = 0; j < 8; ++j) acc[j] *= bg[j];
        *(u32x4*)(yb + (size_t)tok * DMIX + c8) = pack8(acc);
    }
}

__device__ __forceinline__ void vtrans_phase(const int tid_, const int it0, const int gdim_, bf16_t* tile  , const bf16_t* __restrict__ h, bf16_t* __restrict__ vt) {
    const int r = tid_ >> 3, c = (tid_ & 7) * 8;
    int it = it0;
    u32x4 u;
    if (it < BATCH * 8 * 32) { const int bh = it >> 5, tc = it & 31; u = *(const u32x4*)(h + (size_t)((bh >> 3) * SEQ + tc * 64 + r) * INC + COL_D + 1024 + (bh & 7) * 64 + c); }
    for (; it < BATCH * 8 * 32; it += gdim_) {
        const int bh = it >> 5, tc = it & 31;
#pragma unroll
        for (int j = 0; j < 4; ++j) { tile[(c + 2 * j) * 72 + r] = (bf16_t)(u[j] & 0xffffu); tile[(c + 2 * j + 1) * 72 + r] = (bf16_t)(u[j] >> 16); }
        const int i2 = it + gdim_;
        if (i2 < BATCH * 8 * 32) { const int bh2 = i2 >> 5, tc2 = i2 & 31; u = *(const u32x4*)(h + (size_t)((bh2 >> 3) * SEQ + tc2 * 64 + r) * INC + COL_D + 1024 + (bh2 & 7) * 64 + c); }
        LDS_BARRIER();
        *(u32x4*)(vt + (size_t)(bh * 64 + r) * SEQ + tc * 64 + c) = *(const u32x4*)(tile + r * 72 + c);
        LDS_BARRIER();
    }
}

__device__ __forceinline__ void attn_phase(const int tid_, const int bid_, const int gdim_, unsigned char* ldsb, const bf16_t* __restrict__ h, const bf16_t* __restrict__ vt, const float* __restrict__ rel_bias, bf16_t* __restrict__ yd) {
    constexpr float L2E = 1.4426950408889634f;
    float* rb = (float*)(ldsb + 131088);
    for (int i = tid_; i < 8 * 257; i += 512) rb[i] = rel_bias[i] * L2E;
    __syncthreads();
    const int lane = tid_ & 63, wid = __builtin_amdgcn_readfirstlane(tid_ >> 6), lr = lane & 15, quad = lane >> 4;
    const int nw = gdim_ * 8;
    unsigned char* wl = ldsb + wid * 16384;
    const int krow = lane >> 3, kchunk = (lane & 7) ^ (krow & 7);
    const int vrow = lane >> 2, vchunk = (lane & 3) ^ ((vrow >> 2) & 3);
    int koff[2][2], voff[4];
#pragma unroll
    for (int tt = 0; tt < 2; ++tt)
#pragma unroll
        for (int dh = 0; dh < 2; ++dh) { const int row = (lr >> 2) * 8 + tt * 4 + (lr & 3); koff[tt][dh] = row * 128 + (((dh * 4 + quad) ^ (row & 7)) * 16); }
#pragma unroll
    for (int dt = 0; dt < 4; ++dt) { const int d = dt * 16 + lr; voff[dt] = 4096 + d * 64 + ((quad ^ ((d >> 2) & 3)) * 16); }
    int it = 0;
    const int vbid = (bid_ & 7) * (gdim_ >> 3) + (bid_ >> 3);
    for (int item0 = vbid * 8 + wid; item0 < BATCH * 8 * 32; item0 += nw, ++it) {
        const int c = ((item0 & 31) + 8 * it) & 31, hh = (item0 >> 5) & 7, b = item0 >> 8;
        const int q0 = c * 64;
        const bf16_t* hb = h + (size_t)b * SEQ * INC + COL_D + hh * 64;
        bf16x8 qf[4][2];
        asm volatile("s_waitcnt lgkmcnt(0)" ::: "memory");
        {
            const bf16_t* qg = hb + (size_t)(q0 + krow) * INC + kchunk * 8;
#pragma unroll
            for (int i = 0; i < 8; ++i) __builtin_amdgcn_global_load_lds((const unsigned*)(qg + (size_t)i * 8 * INC), (LAS unsigned*)(wl + 8192 + i * 1024), 16, 0, 0);
        }
        const bf16_t* vb = vt + (size_t)((b * 8 + hh) * 64) * SEQ;
        const float* rbh = rb + hh * 257;
        const float cb2 = rbh[256];
        f32x4 oacc[4][4];
#pragma unroll
        for (int qi = 0; qi < 4; ++qi)
#pragma unroll
            for (int dt = 0; dt < 4; ++dt) oacc[qi][dt] = (f32x4){0.f, 0.f, 0.f, 0.f};
        float mrun[4] = {-1e30f, -1e30f, -1e30f, -1e30f}, lsum[4] = {0.f, 0.f, 0.f, 0.f};
        const int kstart = (c > 8 ? c - 8 : 0) * 64, kend = c * 64 + 64;
        const bf16_t* kg = hb + 512 + (size_t)krow * INC + kchunk * 8;
        const bf16_t* vg = vb + (size_t)vrow * SEQ + vchunk * 8;
#define AT_LOAD(buf, kt) do { _Pragma("unroll") for (int i = 0; i < 4; ++i) \
                __builtin_amdgcn_global_load_lds((const unsigned*)(kg + (size_t)((kt) + i * 8) * INC), (LAS unsigned*)(wl + (buf) * 8192 + i * 1024), 16, 0, 0); \
            _Pragma("unroll") for (int i = 0; i < 4; ++i) \
                __builtin_amdgcn_global_load_lds((const unsigned*)(vg + (size_t)i * 16 * SEQ + (kt)), (LAS unsigned*)(wl + (buf) * 8192 + 4096 + i * 1024), 16, 0, 0); } while (0)
#define AT_COMPUTE(buf, kt) do { \
            const bool far_ = ((kt) + 31 + 128 <= q0); \
            const unsigned char* bb_ = wl + (buf) * 8192; \
            bf16x8 kf[2][2], vf[4]; \
            _Pragma("unroll") for (int tt = 0; tt < 2; ++tt) _Pragma("unroll") for (int dh = 0; dh < 2; ++dh) kf[tt][dh] = *(const bf16x8*)(bb_ + koff[tt][dh]); \
            _Pragma("unroll") for (int dt = 0; dt < 4; ++dt) vf[dt] = *(const bf16x8*)(bb_ + voff[dt]); \
            _Pragma("unroll") for (int qi = 0; qi < 4; ++qi) { \
                f32x4 s[2]; \
                _Pragma("unroll") for (int tt = 0; tt < 2; ++tt) { f32x4 a = (f32x4){0.f, 0.f, 0.f, 0.f}; \
                    a = __builtin_amdgcn_mfma_f32_16x16x32_bf16(kf[tt][0], qf[qi][0], a, 0, 0, 0); \
                    a = __builtin_amdgcn_mfma_f32_16x16x32_bf16(kf[tt][1], qf[qi][1], a, 0, 0, 0); s[tt] = a; } \
                float mx = -1e30f; \
                if (far_) { _Pragma("unroll") for (int tt = 0; tt < 2; ++tt) _Pragma("unroll") for (int j = 0; j < 4; ++j) { const float v = s[tt][j] * (0.125f * L2E) + cb2; s[tt][j] = v; mx = fmaxf(mx, v); } } \
                else { const int qpos = q0 + qi * 16 + lr; float bz[8]; \
                    _Pragma("unroll") for (int tt = 0; tt < 2; ++tt) _Pragma("unroll") for (int j = 0; j < 4; ++j) { \
                        int rel = qpos - ((kt) + quad * 8 + tt * 4 + j); rel = rel > 128 ? 128 : (rel < -128 ? -128 : rel); bz[tt * 4 + j] = rbh[rel + 128]; } \
                    _Pragma("unroll") for (int tt = 0; tt < 2; ++tt) _Pragma("unroll") for (int j = 0; j < 4; ++j) { \
                        const float v = s[tt][j] * (0.125f * L2E) + bz[tt * 4 + j]; s[tt][j] = v; mx = fmaxf(mx, v); } } \
                mx = fmaxf(mx, shflx(mx, lane, 16)); mx = fmaxf(mx, shflx(mx, lane, 32)); \
                const float mnew = fmaxf(mrun[qi], mx), sc = __builtin_amdgcn_exp2f(mrun[qi] - mnew); \
                mrun[qi] = mnew; \
                float ps = 0.f; float pv[8]; \
                _Pragma("unroll") for (int tt = 0; tt < 2; ++tt) _Pragma("unroll") for (int j = 0; j < 4; ++j) { const float p = __builtin_amdgcn_exp2f(s[tt][j] - mnew); pv[tt * 4 + j] = p; ps += p; } \
                lsum[qi] = lsum[qi] * sc + ps; \
                const u32x4 pu = pack8(pv); bf16x8 pf; __builtin_memcpy(&pf, &pu, 16); \
                _Pragma("unroll") for (int dt = 0; dt < 4; ++dt) { \
                    f32x4 o = oacc[qi][dt]; \
                    _Pragma("unroll") for (int j = 0; j < 4; ++j) o[j] *= sc; \
                    oacc[qi][dt] = __builtin_amdgcn_mfma_f32_16x16x32_bf16(vf[dt], pf, o, 0, 0, 0); } \
            } } while (0)
        AT_LOAD(0, kstart);
        asm volatile("s_waitcnt vmcnt(8)" ::: "memory");
#pragma unroll
        for (int qi = 0; qi < 4; ++qi)
#pragma unroll
            for (int dh = 0; dh < 2; ++dh) { const int row = qi * 16 + lr; qf[qi][dh] = *(const bf16x8*)(wl + 8192 + row * 128 + (((dh * 4 + quad) ^ (row & 7)) * 16)); }
        asm volatile("s_waitcnt lgkmcnt(0)" ::: "memory");
        for (int kt0 = kstart; kt0 < kend; kt0 += 64) {
            AT_LOAD(1, kt0 + 32);
            asm volatile("s_waitcnt vmcnt(8)" ::: "memory");
            AT_COMPUTE(0, kt0);
            if (kt0 + 64 < kend) { AT_LOAD(0, kt0 + 64); asm volatile("s_waitcnt vmcnt(8)" ::: "memory"); }
            else asm volatile("s_waitcnt vmcnt(0)" ::: "memory");
            AT_COMPUTE(1, kt0 + 32);
        }
#undef AT_LOAD
#undef AT_COMPUTE
#pragma unroll
        for (int qi = 0; qi < 4; ++qi) {
            float l = lsum[qi]; l += shflx(l, lane, 16); l += shflx(l, lane, 32);
            const float inv = __builtin_amdgcn_rcpf(l);
#pragma unroll
            for (int dt = 0; dt < 4; ++dt) {
                u32x2 pk; pk[0] = cvt_pk_bf16(oacc[qi][dt][0] * inv, oacc[qi][dt][1] * inv); pk[1] = cvt_pk_bf16(oacc[qi][dt][2] * inv, oacc[qi][dt][3] * inv);
                *(u32x2*)(wl + (qi * 16 + lr) * 136 + (dt * 16 + quad * 4) * 2) = pk;
            }
        }
        asm volatile("" ::: "memory");
#pragma unroll
        for (int i = 0; i < 8; ++i) {
            const int row = i * 8 + krow;
            *(u32x4*)(yd + (size_t)(b * SEQ + q0 + row) * DMIX + hh * 64 + (lane & 7) * 8) = *(const u32x4*)(wl + row * 136 + (lane & 7) * 16);
        }
    }
    __syncthreads();
}

__device__ __forceinline__ int lru_phase(const int tid_, const int bid_, const int gdim_, unsigned char* lds, const bf16_t* __restrict__ h, const float* __restrict__ conv_w, const float* __restrict__ conv_b,
                          const float* __restrict__ wrp, const float* __restrict__ brp, const float* __restrict__ wip, const float* __restrict__ bip,
                          const float* __restrict__ lam, bf16_t* __restrict__ ya_out, bf16_t* __restrict__ vt, const float* __restrict__ scw  , bf16_t* __restrict__ yb_out) {
    bf16_t* vtile = (bf16_t*)(lds + 131088);
    bf16_t* WrT = (bf16_t*)lds;
    bf16_t* WiT = WrT + 64 * 72;
    bf16_t* xcb = WiT + 64 * 72;
    bf16_t* xraw = xcb + 64 * 72;
    bf16_t* yraw = xraw + 67 * 64 + 64;
    float* xcf = (float*)(yraw + 64 * 64);
    float* abuf = xcf + 4096;
    float* ubuf = abuf + 4096;
    float* ibuf = ubuf + 4096;
    float* hbuf = ibuf + 4096;
    float* gbuf = xcf;
    const int tid = tid_, lane = tid & 63, wid = tid >> 6, lr = lane & 15, quad = lane >> 4;
    const int sc_nth = gdim_ * 512; int sc_idx = bid_ * 512 + tid;
    int vt_it = bid_; u32x4 vt_u = (u32x4){0u, 0u, 0u, 0u};
    if (vt_it < BATCH * 8 * 32) { const int bh = vt_it >> 5, tcv = vt_it & 31; vt_u = *(const u32x4*)(h + (size_t)((bh >> 3) * SEQ + tcv * 64 + (tid >> 3)) * INC + COL_D + 1024 + (bh & 7) * 64 + (tid & 7) * 8); }
    for (int item = bid_; item < BATCH * 8; item += gdim_) {
        const int b = item >> 3, g = item & 7;
        __syncthreads();
        for (int e = tid; e < 4096; e += 512) { const int i = e >> 6, j = e & 63;
            WrT[j * 72 + i] = f2bf(wrp[(size_t)g * 4096 + e]); WiT[j * 72 + i] = f2bf(wip[(size_t)g * 4096 + e]); }
        const int ch = tid & 63, trow = tid >> 6;
        const int cg_ = g * 64 + ch;
        const float cw0 = conv_w[cg_], cw1 = conv_w[512 + cg_], cw2 = conv_w[1024 + cg_], cw3 = conv_w[1536 + cg_], cb = conv_b[cg_];
        const int r8 = tid >> 3, pc = (tid & 7) * 8;
        const bf16_t* hrow = h + (size_t)(b * SEQ + r8) * INC + COL_A + g * 64 + pc;
        u32x4 xa16 = *(const u32x4*)hrow, ya16 = *(const u32x4*)(hrow + 512), prev16 = (u32x4){0u, 0u, 0u, 0u};
        float hstate = 0.f;
        for (int tc = 0; tc < SEQ / 64; ++tc) {
            const int t0 = tc * 64;
            *(u32x4*)(xraw + (3 + r8) * 64 + pc) = xa16; *(u32x4*)(yraw + r8 * 64 + pc) = ya16;
            if (r8 >= 61) *(u32x4*)(xraw + (r8 - 61) * 64 + pc) = prev16;
            prev16 = xa16;
            if (tc + 1 < SEQ / 64) { const bf16_t* nx = hrow + (size_t)(t0 + 64) * INC; xa16 = *(const u32x4*)nx; ya16 = *(const u32x4*)(nx + 512); }
            const bool sc_ok = sc_idx < MTOK * 64;
            const int sc_tok = sc_idx >> 6, sc_c8 = (sc_idx & 63) * 8, sc_t = sc_tok & (SEQ - 1);
            u32x4 sc_bg, sc_c[3], sc_x[3];
            if (sc_ok) {
                sc_bg = *(const u32x4*)(h + (size_t)sc_tok * INC + COL_B + sc_c8);
#pragma unroll
                for (int k = 0; k < 3; ++k) { const bf16_t* row = h + (size_t)(sc_tok - (sc_t - 2 + k >= 0 ? 2 - k : 0)) * INC + COL_B; sc_c[k] = *(const u32x4*)(row + 512 + sc_c8); sc_x[k] = *(const u32x4*)(row + 1024 + sc_c8); }
            }
            const int vt_cur = vt_it;
            if (vt_cur < BATCH * 8 * 32) {
#pragma unroll
                for (int j = 0; j < 4; ++j) { vtile[(pc + 2 * j) * 72 + r8] = (bf16_t)(vt_u[j] & 0xffffu); vtile[(pc + 2 * j + 1) * 72 + r8] = (bf16_t)(vt_u[j] >> 16); }
                vt_it += gdim_;
                if (vt_it < BATCH * 8 * 32) { const int bh = vt_it >> 5, tcv = vt_it & 31; vt_u = *(const u32x4*)(h + (size_t)((bh >> 3) * SEQ + tcv * 64 + r8) * INC + COL_D + 1024 + (bh & 7) * 64 + pc); }
            }
            LDS_BARRIER();
            if (vt_cur < BATCH * 8 * 32) { const int bh = vt_cur >> 5, tcv = vt_cur & 31;
                *(u32x4*)(vt + (size_t)(bh * 64 + r8) * SEQ + tcv * 64 + pc) = *(const u32x4*)(vtile + r8 * 72 + pc); }
#pragma unroll
            for (int i = 0; i < 8; ++i) {
                const int tl = trow + 8 * i;
                const float x3 = bf2f(xraw[tl * 64 + ch]), x2 = bf2f(xraw[(tl + 1) * 64 + ch]), x1 = bf2f(xraw[(tl + 2) * 64 + ch]), x0 = bf2f(xraw[(tl + 3) * 64 + ch]);
                const float xc = cw3 * x0 + cw2 * x1 + cw1 * x2 + cw0 * x3 + cb;
                xcf[tl * 64 + ch] = xc; xcb[tl * 72 + ch] = f2bf(xc);
            }
            LDS_BARRIER();
            {
                const int tt = wid & 3, which = wid >> 2;
                const bf16_t* WT = which ? WiT : WrT;
                const bf16x8 a0 = *(const bf16x8*)(xcb + (tt * 16 + lr) * 72 + quad * 8), a1 = *(const bf16x8*)(xcb + (tt * 16 + lr) * 72 + 32 + quad * 8);
#pragma unroll
                for (int jt = 0; jt < 4; ++jt) {
                    const bf16x8 b0 = *(const bf16x8*)(WT + (jt * 16 + lr) * 72 + quad * 8), b1 = *(const bf16x8*)(WT + (jt * 16 + lr) * 72 + 32 + quad * 8);
                    f32x4 cacc = (f32x4){0.f, 0.f, 0.f, 0.f};
                    cacc = __builtin_amdgcn_mfma_f32_16x16x32_bf16(a0, b0, cacc, 0, 0, 0);
                    cacc = __builtin_amdgcn_mfma_f32_16x16x32_bf16(a1, b1, cacc, 0, 0, 0);
                    const int j = jt * 16 + lr, cj = g * 64 + j;
                    if (which == 0) {
                        const float bias = brp[cj], lm = lam[cj];
                        const float sp = fmaxf(-lm, 0.f) + flog1p_small(fexp(-fabsf(lm)));
#pragma unroll
                        for (int jj = 0; jj < 4; ++jj) {
                            const int tl = tt * 16 + quad * 4 + jj;
                            const float r = sigmoidf_(cacc[jj] + bias);
                            const float la = -8.0f * r * sp;
                            abuf[tl * 64 + j] = fexp(la);
                            ubuf[tl * 64 + j] = __builtin_amdgcn_sqrtf(fneg_expm1(2.0f * la)) * xcf[tl * 64 + j];
                        }
                    } else {
                        const float bias = bip[cj];
#pragma unroll
                        for (int jj = 0; jj < 4; ++jj) { const int tl = tt * 16 + quad * 4 + jj; ibuf[tl * 64 + j] = sigmoidf_(cacc[jj] + bias); }
                    }
                }
            }
            LDS_BARRIER();
            if (wid == 0) {
#pragma unroll 8
                for (int tl = 0; tl < 64; ++tl) { hstate = abuf[tl * 64 + lane] * hstate + ubuf[tl * 64 + lane] * ibuf[tl * 64 + lane]; hbuf[tl * 64 + lane] = hstate; }
            } else {
                for (int e = tid - 64; e < 4096; e += 448) {
                    const float y = bf2f(yraw[e]);
                    gbuf[e] = 0.5f * y * (1.0f + ftanh(0.7978845608028654f * (y + 0.044715f * y * y * y)));
                }
            }
            LDS_BARRIER();
            {
                float o[8];
                const f32x4 h0 = *(const f32x4*)(hbuf + r8 * 64 + pc), h1 = *(const f32x4*)(hbuf + r8 * 64 + pc + 4);
                const f32x4 g0 = *(const f32x4*)(gbuf + r8 * 64 + pc), g1 = *(const f32x4*)(gbuf + r8 * 64 + pc + 4);
#pragma unroll
                for (int j = 0; j < 4; ++j) { o[j] = h0[j] * g0[j]; o[4 + j] = h1[j] * g1[j]; }
                *(u32x4*)(ya_out + (size_t)(b * SEQ + t0 + r8) * DMIX + g * 64 + pc) = pack8(o);
            }
            if (sc_ok) {
                float acc[8], bg[8];
#pragma unroll
                for (int j = 0; j < 8; ++j) acc[j] = 0.f;
#pragma unroll
                for (int k = 0; k < 3; ++k) {
                    const float mk = (sc_t - 2 + k >= 0) ? 1.f : 0.f;
                    float cgv[8], xh[8]; unpack8(sc_c[k], cgv); unpack8(sc_x[k], xh);
                    const f32x4 w0 = *(const f32x4*)(scw + k * 512 + sc_c8), w1 = *(const f32x4*)(scw + k * 512 + sc_c8 + 4);
#pragma unroll
                    for (int j = 0; j < 4; ++j) { acc[j] += (mk * w0[j]) * (cgv[j] * xh[j]); acc[4 + j] += (mk * w1[j]) * (cgv[4 + j] * xh[4 + j]); }
                }
                unpack8(sc_bg, bg);
#pragma unroll
                for (int j = 0; j < 8; ++j) acc[j] *= bg[j];
                *(u32x4*)(yb_out + (size_t)sc_tok * DMIX + sc_c8) = pack8(acc);
            }
            sc_idx += sc_nth;
        }
    }
    for (; sc_idx < MTOK * 64; sc_idx += sc_nth) {
        const int tok = sc_idx >> 6, c8 = (sc_idx & 63) * 8, t = tok & (SEQ - 1);
        float acc[8], bg[8];
#pragma unroll
        for (int j = 0; j < 8; ++j) acc[j] = 0.f;
#pragma unroll
        for (int k = 0; k < 3; ++k) {
            if (t - 2 + k >= 0) {
                const bf16_t* row = h + (size_t)(tok - 2 + k) * INC + COL_B;
                float cgv[8], xh[8]; unpack8(*(const u32x4*)(row + 512 + c8), cgv); unpack8(*(const u32x4*)(row + 1024 + c8), xh);
                const f32x4 w0 = *(const f32x4*)(scw + k * 512 + c8), w1 = *(const f32x4*)(scw + k * 512 + c8 + 4);
#pragma unroll
                for (int j = 0; j < 4; ++j) { acc[j] += w0[j] * (cgv[j] * xh[j]); acc[4 + j] += w1[j] * (cgv[4 + j] * xh[4 + j]); }
            }
        }
        unpack8(*(const u32x4*)(h + (size_t)tok * INC + COL_B + c8), bg);
#pragma unroll
        for (int j = 0; j < 8; ++j) acc[j] *= bg[j];
        *(u32x4*)(yb_out + (size_t)tok * DMIX + c8) = pack8(acc);
    }
    __syncthreads();
    return vt_it;
}

constexpr int RT = 16, REC = 456;
__device__ __forceinline__ float dpp_x1(float v) { return __int_as_float(__builtin_amdgcn_update_dpp(0, __float_as_int(v), 0xB1, 0xF, 0xF, true)); }
__device__ __forceinline__ float dpp_x2(float v) { return __int_as_float(__builtin_amdgcn_update_dpp(0, __float_as_int(v), 0x4E, 0xF, 0xF, true)); }
__device__ __forceinline__ void rwkv_phase(const int tid_, const int bid_, const int gdim_, unsigned char* lds, const bf16_t* __restrict__ h, const float* __restrict__ mu, const float* __restrict__ w0p, const float* __restrict__ w2p,
                           const float* __restrict__ a0p, const float* __restrict__ a2p, const float* __restrict__ g2p, const float* __restrict__ kkp, const float* __restrict__ kap,
                           const float* __restrict__ rkp, const float* __restrict__ gng, const float* __restrict__ gnb, bf16_t* __restrict__ yc) {
    bf16_t* W2T = (bf16_t*)lds;
    bf16_t* A2T = W2T + 64 * 72;
    bf16_t* G2T = A2T + 64 * 72;
    bf16_t* linb = G2T + 64 * 136;
    float* lo = (float*)(linb + 4 * 4 * 264);
    float* rec = lo + 4 * 4 * 192;
    float* obuf = rec + 2 * RT * REC;
    const int tid = tid_, lane = tid & 63, wid = __builtin_amdgcn_readfirstlane(tid >> 6);
    constexpr int NC = SEQ / RT;
    for (int item = bid_; item < BATCH * 8; item += gdim_) {
        const int b = item >> 3, hh = item & 7, hj = hh * 64 + lane;
        __syncthreads();
        for (int e = tid; e < 4096; e += 512) { const int i = e >> 6, j = e & 63; W2T[j * 72 + i] = f2bf(w2p[i * 512 + hh * 64 + j]); A2T[j * 72 + i] = f2bf(a2p[i * 512 + hh * 64 + j]); }
        for (int e = tid; e < 8192; e += 512) { const int i = e >> 6, j = e & 63; G2T[j * 136 + i] = f2bf(g2p[i * 512 + hh * 64 + j]); }
        __syncthreads();
        if (wid < 4) {
            const int r = lane >> 2, kq = lane & 3, row = wid * 16 + r;
            f32x2 S[8];
#pragma unroll
            for (int i = 0; i < 8; ++i) S[i] = (f32x2){0.f, 0.f};
            LDS_BARRIER();
            for (int c = 0; c < NC; ++c) {
                const float* R0 = rec + (c & 1) * RT * REC + kq * 16;
                float* ob = obuf + (c & 1) * RT * 64 + row;
                f32x4 dt[2][8], up[2][12]; float vv[2]; f32x2 scs[2];
#define RW_LOAD(buf, t) do { const float* Rk = R0 + (t) * REC; _Pragma("unroll") for (int i = 0; i < 4; ++i) { dt[buf][i] = *(const f32x4*)(Rk + 4 * i); dt[buf][4 + i] = *(const f32x4*)(Rk + 64 + 4 * i); } \
                    vv[buf] = Rk[320 - kq * 16 + row]; scs[buf] = *(const f32x2*)(Rk + 448 - kq * 16); \
                    _Pragma("unroll") for (int q = 0; q < 3; ++q) _Pragma("unroll") for (int i = 0; i < 4; ++i) up[buf][q * 4 + i] = *(const f32x4*)(Rk + 128 + q * 64 + 4 * i); } while (0)
                RW_LOAD(0, 0);
#pragma unroll
                for (int t = 0; t < RT; ++t) {
                    const int cb = t & 1;
                    if (t + 1 < RT) RW_LOAD(cb ^ 1, t + 1);
                    const float vval = vv[cb];
                    f32x2 sa0 = (f32x2){0.f, 0.f}, sa1 = (f32x2){0.f, 0.f}, yp0 = (f32x2){0.f, 0.f}, yp1 = (f32x2){0.f, 0.f};
#pragma unroll
                    for (int i = 0; i < 4; ++i) {
                        const f32x4 ah = dt[cb][i], wr = dt[cb][4 + i];
                        sa0 += S[2 * i] * (f32x2){ah[0], ah[1]}; sa1 += S[2 * i + 1] * (f32x2){ah[2], ah[3]};
                        yp0 += S[2 * i] * (f32x2){wr[0], wr[1]}; yp1 += S[2 * i + 1] * (f32x2){wr[2], wr[3]};
                    }
                    sa0 += sa1; yp0 += yp1;
                    float sa = sa0[0] + sa0[1], yp = yp0[0] + yp0[1];
                    sa += dpp_x1(sa); yp += dpp_x1(yp);
                    sa += dpp_x2(sa); yp += dpp_x2(yp);
                    if (kq == 0) ob[t * 64] = yp + sa * scs[cb][0] + vval * scs[cb][1];
                    const f32x2 sav = (f32x2){sa, sa}, vvv = (f32x2){vval, vval};
#pragma unroll
                    for (int i = 0; i < 4; ++i) {
                        const f32x4 dc = up[cb][i], bb = up[cb][4 + i], kp = up[cb][8 + i];
                        S[2 * i] = S[2 * i] * (f32x2){dc[0], dc[1]} + sav * (f32x2){bb[0], bb[1]} + vvv * (f32x2){kp[0], kp[1]};
                        S[2 * i + 1] = S[2 * i + 1] * (f32x2){dc[2], dc[3]} + sav * (f32x2){bb[2], bb[3]} + vvv * (f32x2){kp[2], kp[3]};
                    }
                }
#undef RW_LOAD
                LDS_BARRIER();
            }
        } else {
            const int p = wid - 4, lr = lane & 15, quad = lane >> 4;
            bf16_t* lb = linb + p * 4 * 264;
            float* lop = lo + p * 4 * 192;
            const float mu_r = mu[hj], mu_k = mu[512 + hj], mu_v = mu[1024 + hj];
            float mu_l[4];
#pragma unroll
            for (int q = 0; q < 4; ++q) mu_l[q] = mu[1536 + lane + 64 * q];
            const float w0 = w0p[hj], a0 = a0p[hj], k_k = kkp[hj], k_a = kap[hj], r_k = rkp[hj], gn_g = gng[hj], gn_b = gnb[hj];
            const bf16_t* hC = h + (size_t)b * SEQ * INC + COL_C;
            unsigned zraw[5][7];
#define RW_GLOAD(cn) do { _Pragma("unroll") for (int rw = 0; rw < 5; ++rw) { const int t = (cn) * RT + p * 4 + rw - 1; \
                    const bf16_t* ptr = hC + (size_t)(t < 0 ? 0 : t) * INC; \
                    zraw[rw][0] = ptr[hj]; zraw[rw][1] = ptr[512 + hj]; zraw[rw][2] = ptr[1024 + hj]; \
                    _Pragma("unroll") for (int q = 0; q < 4; ++q) zraw[rw][3 + q] = ptr[1536 + lane + 64 * q]; } } while (0)
            RW_GLOAD(0);
            for (int c = -1; c < NC; ++c) {
                const bool do_prep = (c + 1 < NC), do_post = (c >= 1);
                float cr[5], ck[5], cv[5], cl[5][4];
#pragma unroll
                for (int rw = 0; rw < 5; ++rw) { cr[rw] = bf2f(zraw[rw][0]); ck[rw] = bf2f(zraw[rw][1]); cv[rw] = bf2f(zraw[rw][2]);
#pragma unroll
                    for (int q = 0; q < 4; ++q) cl[rw][q] = bf2f(zraw[rw][3 + q]); }
                if (c == -1 && p == 0) { cr[0] = 0.f; ck[0] = 0.f; cv[0] = 0.f; cl[0][0] = 0.f; cl[0][1] = 0.f; cl[0][2] = 0.f; cl[0][3] = 0.f; }
                if (c + 2 < NC) RW_GLOAD(c + 2);
                if (do_post) {
                    const float* Rb = rec + ((c - 1) & 1) * RT * REC;
                    const float* ob = obuf + ((c - 1) & 1) * RT * 64;
                    float ov[4], sm[8];
#pragma unroll
                    for (int u = 0; u < 4; ++u) { ov[u] = ob[(p * 4 + u) * 64 + lane]; sm[2 * u] = ov[u]; sm[2 * u + 1] = ov[u] * ov[u]; }
                    wave_sum_n<8>(sm);
#pragma unroll
                    for (int u = 0; u < 4; ++u) {
                        const int tt = p * 4 + u, t = (c - 1) * RT + tt;
                        const float* R = Rb + tt * REC;
                        const float mean = sm[2 * u] * (1.0f / 64.0f), var = fmaxf(sm[2 * u + 1] * (1.0f / 64.0f) - mean * mean, 0.f);
                        float o = (ov[u] - mean) * __builtin_amdgcn_rsqf(var + GN_EPS) * gn_g + gn_b;
                        o += R[450] * R[320 + lane];
                        yc[(size_t)(b * SEQ + t) * DMIX + hj] = f2bf(o * R[384 + lane]);
                    }
                }
                if (do_prep) {
                    float rr[4], kx[4], vx[4];
#pragma unroll
                    for (int u = 0; u < 4; ++u) {
                        rr[u] = cr[u + 1] + (cr[u] - cr[u + 1]) * mu_r; kx[u] = ck[u + 1] + (ck[u] - ck[u + 1]) * mu_k; vx[u] = cv[u + 1] + (cv[u] - cv[u + 1]) * mu_v;
#pragma unroll
                        for (int q = 0; q < 4; ++q) {
                            const float z = cl[u + 1][q] + (cl[u][q] - cl[u + 1][q]) * mu_l[q];
                            const float val = (q == 0) ? ftanh(z) : (q == 1 ? z : sigmoidf_(z));
                            lb[u * 264 + lane + 64 * q] = f2bf(val);
                        }
                    }
                    asm volatile("s_waitcnt lgkmcnt(0)" ::: "memory");
                    bf16x8 af[8];
#pragma unroll
                    for (int k8 = 0; k8 < 8; ++k8) af[k8] = *(const bf16x8*)(lb + (lane & 3) * 264 + k8 * 32 + quad * 8);
#pragma unroll
                    for (int jt = 0; jt < 4; ++jt) {
                        f32x4 cw = (f32x4){0.f, 0.f, 0.f, 0.f}, ca = cw, cgm = cw;
#pragma unroll
                        for (int kh = 0; kh < 2; ++kh) {
                            cw = __builtin_amdgcn_mfma_f32_16x16x32_bf16(af[kh], *(const bf16x8*)(W2T + (jt * 16 + lr) * 72 + kh * 32 + quad * 8), cw, 0, 0, 0);
                            ca = __builtin_amdgcn_mfma_f32_16x16x32_bf16(af[2 + kh], *(const bf16x8*)(A2T + (jt * 16 + lr) * 72 + kh * 32 + quad * 8), ca, 0, 0, 0);
                        }
#pragma unroll
                        for (int kh = 0; kh < 4; ++kh)
                            cgm = __builtin_amdgcn_mfma_f32_16x16x32_bf16(af[4 + kh], *(const bf16x8*)(G2T + (jt * 16 + lr) * 136 + kh * 32 + quad * 8), cgm, 0, 0, 0);
                        if (quad == 0) {
#pragma unroll
                            for (int jj = 0; jj < 4; ++jj) { lop[jj * 192 + jt * 16 + lr] = cw[jj]; lop[jj * 192 + 64 + jt * 16 + lr] = ca[jj]; lop[jj * 192 + 128 + jt * 16 + lr] = cgm[jj]; }
                        }
                    }
                    asm volatile("s_waitcnt lgkmcnt(0)" ::: "memory");
                    float* Rb = rec + ((c + 1) & 1) * RT * REC;
                    float dcy[4], av[4], kqv[4], kpv[4], ggv[4], red[16];
#pragma unroll
                    for (int u = 0; u < 4; ++u) {
                        const float wl = w0 + lop[u * 192 + lane], ap = a0 + lop[u * 192 + 64 + lane]; ggv[u] = lop[u * 192 + 128 + lane];
                        const float z = -wl;
                        const float sp = fmaxf(z, 0.f) + flog(1.0f + fexp(-fabsf(z)));
                        dcy[u] = fexp(-fexp(-sp - 0.5f));
                        av[u] = sigmoidf_(ap);
                        kqv[u] = kx[u] * k_k;
                        kpv[u] = kx[u] * (1.0f + (av[u] - 1.0f) * k_a);
                        red[4 * u] = kqv[u] * kqv[u]; red[4 * u + 1] = kqv[u] * av[u] * rr[u]; red[4 * u + 2] = kpv[u] * rr[u]; red[4 * u + 3] = rr[u] * kpv[u] * r_k;
                    }
                    wave_sum_n<16>(red);
#pragma unroll
                    for (int u = 0; u < 4; ++u) {
                        const int tt = p * 4 + u;
                        const float inv = __builtin_amdgcn_rcpf(fmaxf(__builtin_amdgcn_sqrtf(red[4 * u]), 1e-12f));
                        const float kkn = kqv[u] * inv;
                        float* R = Rb + tt * REC;
                        R[lane] = -kkn; R[64 + lane] = dcy[u] * rr[u]; R[128 + lane] = dcy[u]; R[192 + lane] = kkn * av[u]; R[256 + lane] = kpv[u]; R[320 + lane] = vx[u]; R[384 + lane] = ggv[u];
                        if (lane == 0) { R[448] = red[4 * u + 1] * inv; R[449] = red[4 * u + 2]; R[450] = red[4 * u + 3]; }
                    }
                }
                LDS_BARRIER();
            }
#undef RW_GLOAD
            {
                const float* Rb = rec + ((NC - 1) & 1) * RT * REC;
                const float* ob = obuf + ((NC - 1) & 1) * RT * 64;
                float ov[4], sm[8];
#pragma unroll
                for (int u = 0; u < 4; ++u) { ov[u] = ob[(p * 4 + u) * 64 + lane]; sm[2 * u] = ov[u]; sm[2 * u + 1] = ov[u] * ov[u]; }
                wave_sum_n<8>(sm);
#pragma unroll
                for (int u = 0; u < 4; ++u) {
                    const int tt = p * 4 + u, t = (NC - 1) * RT + tt;
                    const float* R = Rb + tt * REC;
                    const float mean = sm[2 * u] * (1.0f / 64.0f), var = fmaxf(sm[2 * u + 1] * (1.0f / 64.0f) - mean * mean, 0.f);
                    float o = (ov[u] - mean) * __builtin_amdgcn_rsqf(var + GN_EPS) * gn_g + gn_b;
                    o += R[450] * R[320 + lane];
                    yc[(size_t)(b * SEQ + t) * DMIX + hj] = f2bf(o * R[384 + lane]);
                }
            }
        }
    }
    __syncthreads();
}

#define XB_TMO      128
#define XB_XCNT(j)  (256  + 64 * (j))
#define XB_XSUB(j)  (1280 + 64 * (j))
#define XB_XGEN(j)  (2304 + 64 * (j))
#define XB_TOP      3328
#define XB_TOPGEN   3392
#define XCD_BAR_WORDS 3456
#define XB_SPIN_CAP (1u << 18)
__device__ __forceinline__ unsigned xb_ld(unsigned* p)              { return __hip_atomic_load(p, __ATOMIC_RELAXED, __HIP_MEMORY_SCOPE_AGENT); }
__device__ __forceinline__ unsigned xb_add(unsigned* p, unsigned v) { return __hip_atomic_fetch_add(p, v, __ATOMIC_RELAXED, __HIP_MEMORY_SCOPE_AGENT); }
__device__ __forceinline__ unsigned xb_xcc_id() { return (unsigned)__builtin_amdgcn_s_getreg((3 << 11) | 20) & 0xFu; }
#define XB_SPIN(cond, bar) do { unsigned _sp = 0; while (cond) { __builtin_amdgcn_s_sleep(1); \
    if ((++_sp & 255u) == 0u) { if (xb_ld(&(bar)[XB_TMO])) break; if (_sp > XB_SPIN_CAP) { atomicAdd(&(bar)[XB_TMO], 1u); break; } } } } while (0)
struct XcdBarrier { unsigned* bar; unsigned x; volatile LAS unsigned* st; };
__device__ __forceinline__ XcdBarrier xcd_barrier_post(unsigned* bar, volatile LAS unsigned* st) {
    XcdBarrier b; b.bar = bar; b.x = xb_xcc_id(); b.st = st;
    if (threadIdx.x == 0) (void)xb_add(&bar[XB_XCNT(b.x)], 1u);
    return b;
}
__device__ __forceinline__ void xcd_barrier_complete(unsigned* bar, unsigned x, unsigned& nloc, unsigned& nx) {
    const unsigned G = gridDim.x;
    unsigned sum, cnt, mine, sp = 0u;
    for (;;) {
        sum = 0u; cnt = 0u; mine = 0u;
#pragma unroll
        for (unsigned j = 0; j < 16; ++j) { const unsigned c = xb_ld(&bar[XB_XCNT(j)]); sum += c; cnt += (c > 0u) ? 1u : 0u; mine = (j == x) ? c : mine; }
        if (sum == G) break;
        __builtin_amdgcn_s_sleep(1);
        if ((++sp & 255u) == 0u) { if (xb_ld(&bar[XB_TMO])) break; if (sp > XB_SPIN_CAP) { atomicAdd(&bar[XB_TMO], 1u); break; } }
    }
    nloc = mine > 0u ? mine : 1u; nx = cnt > 0u ? cnt : 1u;
}
__device__ __forceinline__ void xcd_barrier(const XcdBarrier& b, const int tid) {
    asm volatile("s_waitcnt vmcnt(0)" ::: "memory");
    __syncthreads();
    if (tid == 0) {
        unsigned* bar = b.bar;
        __builtin_amdgcn_s_waitcnt(0);
        unsigned nloc = b.st[0], nx = b.st[1];
        if (nloc == 0u) { xcd_barrier_complete(bar, b.x, nloc, nx); b.st[0] = nloc; b.st[1] = nx; }
        const unsigned old = xb_add(&bar[XB_XSUB(b.x)], 1u);
        const unsigned gen = old / nloc;
        if (old + 1u == (gen + 1u) * nloc) {
            __builtin_amdgcn_fence(__ATOMIC_RELEASE, "agent");
            asm volatile("s_waitcnt vmcnt(0)" ::: "memory");
            const unsigned og = xb_add(&bar[XB_TOP], 1u);
            const unsigned tg = og / nx;
            if (og + 1u == (tg + 1u) * nx) xb_add(&bar[XB_TOPGEN], 1u);
            else XB_SPIN(xb_ld(&bar[XB_TOPGEN]) == tg, bar);
            __builtin_amdgcn_fence(__ATOMIC_ACQUIRE, "agent");
            xb_add(&bar[XB_XGEN(b.x)], 1u);
            asm volatile("s_waitcnt vmcnt(0)" ::: "memory");
        } else {
            XB_SPIN(xb_ld(&bar[XB_XGEN(b.x)]) == gen, bar);
            __builtin_amdgcn_fence(__ATOMIC_ACQUIRE, "agent");
            asm volatile("s_waitcnt vmcnt(0)" ::: "memory");
        }
    }
    __syncthreads();
}

constexpr int NPH = 12;
__global__ void __launch_bounds__(512, 2) mega(Params P, int ph_lo, int ph_hi) {
    extern __shared__ __attribute__((aligned(16))) unsigned char shm[];
    LAS unsigned char* lds = (LAS unsigned char*)shm;
    cg::grid_group grid = cg::this_grid();
    const int swid = __builtin_amdgcn_readfirstlane((int)threadIdx.x >> 6);
    volatile LAS unsigned* xst = (volatile LAS unsigned*)(lds + 131072);
    if (threadIdx.x < 2) xst[threadIdx.x] = 0u;
    __syncthreads();
    const XcdBarrier xbar = xcd_barrier_post((unsigned*)(P.ws + WS_BAR), xst);
    unsigned char* ws = P.ws;
    bf16_t* xb = (bf16_t*)(ws + WS_XB);
    bf16_t* wt = (bf16_t*)(ws + WS_WT);
    bf16_t* pb = (bf16_t*)(ws + WS_PB);
    bf16_t* hbuf = (bf16_t*)(ws + WS_H);
    bf16_t* vt = (bf16_t*)(ws + WS_VT);
    bf16_t* pq = hbuf;
    bf16_t* ubuf = hbuf;
    bf16_t* plb = (bf16_t*)(ws + WS_H + 512 * MiB);
    bf16_t* ybase = (bf16_t*)P.out;
    bf16_t* mb = plb;
    bf16_t* ple = (bf16_t*)P.out;
    for (int ph = ph_lo; ph < ph_hi; ++ph) {
        const int l = ph / NPH, k = ph % NPH;
        if (k == 9) continue;
        const int njobs = (k == 1 || k == 6 || k == 10) ? 1 : (k == 4 ? 4 : ((k == 8 || k == 5) ? 2 : 0));
        for (int rep = 0; rep < ((k == REPK) ? REPN : 1); ++rep) {
        int bid_ = blockIdx.x, gdim_ = gridDim.x; asm volatile("" : "+s"(bid_)); asm volatile("" : "+s"(gdim_)); int z_ = 0; asm volatile("" : "+s"(z_));
        int tid_ = (swid << 6) + (int)__builtin_amdgcn_mbcnt_hi(~0u, __builtin_amdgcn_mbcnt_lo(~0u, (unsigned)z_)); asm volatile("" : "+v"(tid_));
        if (njobs) {
            for (int n = 0; n < njobs; ++n) {
                pg8::Epi E; E.mode = 0; E.act = 0; E.ob = nullptr; E.ldo = 0; E.bias = nullptr; E.io2 = nullptr; E.resf = nullptr; E.aux = nullptr;
                pg8::Gemm g; g.M = MTOK; g.A = xb; g.lda = D; g.K = D; g.Bt = wt; g.ldb = D; g.N = D;
                int merge = 0;
                if (k == 1) { E.ob = hbuf; E.ldo = INC; g.Bt = wt + WO_IN; g.N = INC; }
                else if (k == 4) { E.ob = pq + (size_t)n * D; E.ldo = 4 * D; g.A = ybase + (size_t)n * MTOK * DMIX; g.lda = DMIX; g.K = DMIX; g.Bt = wt + WO_B + (size_t)n * D * DMIX; g.ldb = DMIX; }
                else if (k == 5 && n == 0) { E.mode = 3; E.ob = pq; E.ldo = 4 * D; E.bias = P.in[25 + z_] + (size_t)l * 4 * D; E.io2 = mb; g.Bt = wt + WO_G; g.N = 4 * D; merge = 1; }
                else if (k == 5) { E.ob = ple; E.ldo = D; g.A = pb; g.lda = DPLE; g.K = DPLE; g.Bt = wt + WO_PLE; g.ldb = DPLE; }
                else if (k == 6) { E.mode = 2; E.io2 = xb; if (l == 0) E.resf = P.in[0 + z_]; g.A = mb; g.Bt = wt + WO_OUT4; }
                else if (k == 8 && n == 0) { E.act = 1; E.ob = ubuf; E.ldo = DFF; g.Bt = wt + WO_FF1; g.N = DFF; }
                else if (k == 8) { E.mode = 1; E.ob = ple; E.ldo = D; E.bias = P.in[33 + z_] + (size_t)l * D; g.Bt = wt + WO_PLEG; }
                else { E.mode = 2; E.io2 = xb; E.aux = ple; g.A = ubuf; g.lda = DFF; g.K = DFF; g.Bt = wt + WO_FF2; g.ldb = DFF; }
                pg8::StaticOrder S; S.init(g.M, g.N, gdim_, bid_, merge);
                pg8::gemm_phase(tid_, lds, g, S, E);
                __syncthreads();
            }
        } else if (k == 0) {
            float* tile = (float*)shm;
            tconv(tid_, bid_, gdim_, tile, P.in[2 + z_] + (size_t)l * D * INC, D, INC, wt + WO_IN, D);
            for (int n = 0; n < 4; ++n) tconv(tid_, bid_, gdim_, tile, P.in[24 + z_] + ((size_t)l * 4 + n) * D * D, D, D, wt + WO_G + (size_t)n * D * D, D);
            for (int n = 0; n < 4; ++n) tconv(tid_, bid_, gdim_, tile, P.in[23 + z_] + ((size_t)l * 4 + n) * DMIX * D, DMIX, D, wt + WO_B + (size_t)n * D * DMIX, DMIX);
            tconv(tid_, bid_, gdim_, tile, P.in[26 + z_] + (size_t)l * D * D, D, D, wt + WO_OUT4, D);
            tconv(tid_, bid_, gdim_, tile, P.in[29 + z_] + (size_t)l * D * DFF, D, DFF, wt + WO_FF1, D);
            tconv(tid_, bid_, gdim_, tile, P.in[30 + z_] + (size_t)l * DFF * D, DFF, D, wt + WO_FF2, DFF);
            tconv(tid_, bid_, gdim_, tile, P.in[31 + z_] + (size_t)l * DPLE * D, DPLE, D, wt + WO_PLE, DPLE);
            tconv(tid_, bid_, gdim_, tile, P.in[32 + z_] + (size_t)l * D * D, D, D, wt + WO_PLEG, D);
            econv(tid_, bid_, gdim_, P.in[1 + z_] + (size_t)l * MTOK * DPLE, pb, MTOK * DPLE);
            if (l == 0) econv(tid_, bid_, gdim_, P.in[0 + z_], xb, MTOK * D);
        } else if (k == 2) {
            int vt_next = bid_;
            for (int r2 = 0; r2 < REP_LRU; ++r2) { int t2_ = tid_, b2_ = bid_; asm volatile("" : "+v"(t2_)); asm volatile("" : "+s"(b2_));
            vt_next = lru_phase(t2_, b2_, gdim_, shm, hbuf, P.in[3 + z_] + (size_t)l * 4 * DMIX, P.in[4 + z_] + (size_t)l * DMIX, P.in[5 + z_] + (size_t)l * 8 * 4096, P.in[6 + z_] + (size_t)l * DMIX,
                      P.in[7 + z_] + (size_t)l * 8 * 4096, P.in[8 + z_] + (size_t)l * DMIX, P.in[9 + z_] + (size_t)l * DMIX, ybase, vt, P.in[10 + z_] + (size_t)l * 3 * DMIX, ybase + (size_t)1 * MTOK * DMIX);
            }
            for (int r2 = 0; r2 < REP_RWKV; ++r2) { int t2_ = tid_, b2_ = bid_; asm volatile("" : "+v"(t2_)); asm volatile("" : "+s"(b2_));
            rwkv_phase(t2_, b2_, gdim_, shm, hbuf, P.in[11 + z_] + (size_t)l * 1792, P.in[12 + z_] + (size_t)l * DMIX, P.in[13 + z_] + (size_t)l * 64 * DMIX, P.in[14 + z_] + (size_t)l * DMIX,
                       P.in[15 + z_] + (size_t)l * 64 * DMIX, P.in[16 + z_] + (size_t)l * 128 * DMIX, P.in[17 + z_] + (size_t)l * DMIX, P.in[18 + z_] + (size_t)l * DMIX,
                       P.in[19 + z_] + (size_t)l * DMIX, P.in[20 + z_] + (size_t)l * DMIX, P.in[21 + z_] + (size_t)l * DMIX, ybase + (size_t)2 * MTOK * DMIX);
            }
            for (int r2 = 0; r2 < REP_SV; ++r2) { int t2_ = tid_, b2_ = bid_; asm volatile("" : "+v"(t2_)); asm volatile("" : "+s"(b2_));
            vtrans_phase(t2_, vt_next, gdim_, (bf16_t*)shm, hbuf, vt);
            }
        } else if (k == 3) {
            attn_phase(tid_, bid_, gdim_, shm, hbuf, vt, P.in[22 + z_], ybase + (size_t)3 * MTOK * DMIX);
        } else if (k == 7) {
            ln_phase(tid_, bid_, gdim_, xb, P.in[27 + z_] + (size_t)l * D, P.in[28 + z_] + (size_t)l * D, nullptr);
        } else {
            ln_phase(tid_, bid_, gdim_, xb, P.in[34 + z_] + (size_t)l * D, P.in[35 + z_] + (size_t)l * D, l == DEPTH - 1 ? P.out : nullptr);
        }
        }
        if (ph + 1 < ph_hi) { if (ph == ph_lo) { asm volatile("s_waitcnt vmcnt(0) lgkmcnt(0)" ::: "memory"); grid.sync(); } else { int zb_ = 0; asm volatile("" : "+s"(zb_)); const int tb_ = (swid << 6) + (int)__builtin_amdgcn_mbcnt_hi(~0u, __builtin_amdgcn_mbcnt_lo(~0u, (unsigned)zb_)); xcd_barrier(xbar, tb_); } }
    }
}

extern "C" void kernel_launch(void* const* d_in, const int* in_sizes, int n_in, void* d_out, int out_size, void* d_ws, size_t ws_size, hipStream_t stream) {
    static int grid = 0;
    if (grid == 0) {
        int dev = 0, cus = 0, per_cu = 0;
        hipGetDevice(&dev);
        hipDeviceGetAttribute(&cus, hipDeviceAttributeMultiprocessorCount, dev);
        hipFuncSetAttribute((const void*)mega, hipFuncAttributeMaxDynamicSharedMemorySize, LDS_BYTES);
        hipOccupancyMaxActiveBlocksPerMultiprocessor(&per_cu, (const void*)mega, 512, LDS_BYTES);
        if (per_cu < 1) { fprintf(stderr, "kernel_launch: occupancy query says %d blocks/CU\n", per_cu); per_cu = 1; }
        (void)hipGetLastError();
        grid = cus * 1;
        if (n_in != 36 || ws_size < 1013 * MiB) fprintf(stderr, "kernel_launch: unexpected n_in %d / ws_size %zu\n", n_in, ws_size);
    }
    (void)hipMemsetAsync((char*)d_ws + WS_BAR, 0, XCD_BAR_WORDS * sizeof(unsigned), stream);
    Params p{};
    for (int i = 0; i < 36; ++i) p.in[i] = (const float*)d_in[i];
    p.out = (float*)d_out; p.ws = (unsigned char*)d_ws;
#if ONE_LAUNCH
    int lo = 0, hi = DEPTH * NPH;
    void* args[] = {&p, &lo, &hi};
    hipError_t e = hipLaunchCooperativeKernel((const void*)mega, dim3(grid), dim3(512), args, LDS_BYTES, stream);
    if (e != hipSuccess) fprintf(stderr, "cooperative launch failed: %s (grid %d)\n", hipGetErrorString(e), grid);
#else
    for (int ph = 0; ph < DEPTH * NPH; ++ph) hipLaunchKernelGGL(mega, dim3(grid), dim3(512), LDS_BYTES, stream, p, ph, ph + 1);
#endif
}
```

```cpp
#include <hip/hip_runtime.h>
#include <hip/hip_cooperative_groups.h>
#include <cstdio>
#include <cstdint>
namespace cg = cooperative_groups;

#ifndef REPK
#define REPK -1
#endif
#ifndef REPN
#define REPN 1
#endif
#ifndef REP_LRU
#define REP_LRU 1
#endif
#ifndef REP_RWKV
#define REP_RWKV 1
#endif
#ifndef REP_SV
#define REP_SV 1
#endif
#ifndef ONE_LAUNCH
#define ONE_LAUNCH 1
#endif

#define LAS __attribute__((address_space(3)))
typedef unsigned short bf16_t;
typedef short bf16x8 __attribute__((ext_vector_type(8)));
typedef short bf16x4 __attribute__((ext_vector_type(4)));
typedef float f32x4 __attribute__((ext_vector_type(4)));
typedef float f32x2 __attribute__((ext_vector_type(2)));
typedef unsigned u32x4 __attribute__((ext_vector_type(4)));
typedef unsigned u32x2 __attribute__((ext_vector_type(2)));

constexpr int D = 1024, BATCH = 32, SEQ = 2048, DEPTH = 2, MTOK = BATCH * SEQ;
constexpr int DMIX = 512, INC = 5888, DFF = 4096, DPLE = 256;
constexpr int COL_A = 0, COL_B = 1024, COL_C = 2560, COL_D = 4352;
constexpr float ALPHA = 1.4142135623730951f;
constexpr float LN_EPS = 1e-5f, GN_EPS = 64e-5f;

constexpr size_t MiB = 1ull << 20;
constexpr size_t WS_XB = 0, WS_WT = 128 * MiB, WS_PB = 180 * MiB, WS_H = 212 * MiB, WS_VT = 948 * MiB;
constexpr size_t WO_IN = 0, WO_G = 6029312, WO_B = WO_G + 4194304, WO_OUT4 = WO_B + 2097152, WO_FF1 = WO_OUT4 + 4194304,
                 WO_FF2 = WO_FF1 + 4194304, WO_PLE = WO_FF2 + 4194304, WO_PLEG = WO_PLE + 262144;
constexpr int LDS_BYTES = 131072 + 16 + 9216;
constexpr size_t WS_BAR = 1012 * MiB;

struct Params {
    const float* in[36];
    float* out;
    unsigned char* ws;
};

__device__ __forceinline__ float bf2f(unsigned v) { return __uint_as_float(v << 16); }
typedef __bf16 bf16x2_t __attribute__((ext_vector_type(2)));
__device__ __forceinline__ unsigned cvt_pk_bf16(float lo, float hi) { f32x2 v = {lo, hi}; bf16x2_t b = __builtin_convertvector(v, bf16x2_t); unsigned r; __builtin_memcpy(&r, &b, 4); return r; }
__device__ __forceinline__ bf16_t f2bf(float f) { return (bf16_t)(cvt_pk_bf16(f, 0.f) & 0xffffu); }
__device__ __forceinline__ float fexp(float x) { return __builtin_amdgcn_exp2f(x * 1.4426950408889634f); }
__device__ __forceinline__ float flog(float x) { return __builtin_amdgcn_logf(x) * 0.6931471805599453f; }
__device__ __forceinline__ float ftanh(float x) { return 1.0f - 2.0f * __builtin_amdgcn_rcpf(1.0f + fexp(2.0f * x)); }
__device__ __forceinline__ float flog1p_small(float x) { return flog(1.0f + x); }
__device__ __forceinline__ float fneg_expm1(float t) { return 1.0f - fexp(t); }
__device__ __forceinline__ float sigmoidf_(float x) { return __builtin_amdgcn_rcpf(1.0f + fexp(-x)); }
__device__ __forceinline__ float wave_sum(float v) {
    v += __int_as_float(__builtin_amdgcn_update_dpp(0, __float_as_int(v), 0xB1, 0xF, 0xF, true));
    v += __int_as_float(__builtin_amdgcn_update_dpp(0, __float_as_int(v), 0x4E, 0xF, 0xF, true));
    v += __int_as_float(__builtin_amdgcn_update_dpp(0, __float_as_int(v), 0x141, 0xF, 0xF, true));
    v += __int_as_float(__builtin_amdgcn_update_dpp(0, __float_as_int(v), 0x140, 0xF, 0xF, true));
    const float s0 = __int_as_float(__builtin_amdgcn_readlane(__float_as_int(v), 0)), s1 = __int_as_float(__builtin_amdgcn_readlane(__float_as_int(v), 16));
    const float s2 = __int_as_float(__builtin_amdgcn_readlane(__float_as_int(v), 32)), s3 = __int_as_float(__builtin_amdgcn_readlane(__float_as_int(v), 48));
    return (s0 + s1) + (s2 + s3);
}
template <int N> __device__ __forceinline__ void wave_sum_n(float (&v)[N]) {
#pragma unroll
    for (int i = 0; i < N; ++i) v[i] += __int_as_float(__builtin_amdgcn_update_dpp(0, __float_as_int(v[i]), 0xB1, 0xF, 0xF, true));
#pragma unroll
    for (int i = 0; i < N; ++i) v[i] += __int_as_float(__builtin_amdgcn_update_dpp(0, __float_as_int(v[i]), 0x4E, 0xF, 0xF, true));
#pragma unroll
    for (int i = 0; i < N; ++i) v[i] += __int_as_float(__builtin_amdgcn_update_dpp(0, __float_as_int(v[i]), 0x141, 0xF, 0xF, true));
#pragma unroll
    for (int i = 0; i < N; ++i) v[i] += __int_as_float(__builtin_amdgcn_update_dpp(0, __float_as_int(v[i]), 0x140, 0xF, 0xF, true));
#pragma unroll
    for (int i = 0; i < N; ++i) v[i] += __int_as_float(__builtin_amdgcn_update_dpp(0, __float_as_int(v[i]), 0x142, 0xA, 0xF, false));
#pragma unroll
    for (int i = 0; i < N; ++i) v[i] += __int_as_float(__builtin_amdgcn_update_dpp(0, __float_as_int(v[i]), 0x143, 0xC, 0xF, false));
#pragma unroll
    for (int i = 0; i < N; ++i) v[i] = __int_as_float(__builtin_amdgcn_readlane(__float_as_int(v[i]), 63));
}
__device__ __forceinline__ float shflx(float v, int lane, int m) { return __int_as_float(__builtin_amdgcn_ds_bpermute((lane ^ m) << 2, __float_as_int(v))); }
__device__ __forceinline__ void unpack8(u32x4 u, float* f) {
#pragma unroll
    for (int i = 0; i < 4; ++i) { f[2 * i] = __uint_as_float(u[i] << 16); f[2 * i + 1] = __uint_as_float(u[i] & 0xffff0000u); }
}
__device__ __forceinline__ u32x4 pack8(const float* f) {
    u32x4 u;
#pragma unroll
    for (int i = 0; i < 4; ++i) u[i] = cvt_pk_bf16(f[2 * i], f[2 * i + 1]);
    return u;
}

namespace pg8 {
constexpr int BM = 256, BK = 64, HALF = 128, HTB = HALF * BK * 2, STAGE_BYTES = 8 * HTB, NXCD = 8, WGM = 8;
__host__ __device__ __forceinline__ int lds_byte(int r, int c) { const int st = (r >> 4) * 2 + (c >> 5), rr = r & 15, cc = c & 31, ob = rr * 64 + cc * 2; return st * 1024 + (ob ^ (((ob >> 9) & 1) << 5)); }
__host__ __device__ __forceinline__ void stage_rc(int b, int& R, int& C) { const int st = b / 1024, sb = b % 1024, swz = sb ^ (((sb >> 9) & 1) << 5); R = (st >> 1) * 16 + swz / 64; C = (st & 1) * 32 + (swz % 64) / 2; }
__host__ __device__ __forceinline__ int perm32(int rho) { const int n = rho >> 4, i = rho & 15; return 8 * (i >> 2) + 4 * n + (i & 3); }
struct Unit { int pm, pn; };
struct Gemm { const bf16_t* A; const bf16_t* Bt; int M, N, K, lda, ldb; };
struct StaticOrder {
    int nM, nN, nwg, G, c, merge;
    __device__ void init(int M, int N, int G_, int c_, int merge_) { merge = merge_; nM = M / BM; nN = (merge_ ? N / 4 : N) / BM; nwg = nM * nN; G = G_; c = c_; }
    __device__ bool next(int i, Unit& u) const {
        int n = 0; if (merge) { n = i & 3; i >>= 2; }
        const long L = (long)i * G + c; if (L >= nwg) return false;
        int wgid = (int)L; { const int q = nwg / NXCD, r = nwg % NXCD, xcd = wgid % NXCD, off = wgid / NXCD; wgid = (xcd < r ? xcd * (q + 1) : r * (q + 1) + (xcd - r) * q) + off; }
        const int nig = WGM * nN, gid = wgid / nig, fm = gid * WGM, gsz = (nM - fm) < WGM ? (nM - fm) : WGM;
        u.pm = fm + ((wgid % nig) % gsz); u.pn = (wgid % nig) / gsz + n * nN; return true;
    }
};

struct Epi {
    int mode;
    int act;
    bf16_t* ob; int ldo;
    const float* bias;
    bf16_t* io2;
    const float* resf;
    const bf16_t* aux;
    __device__ __forceinline__ void operator()(const f32x4 (&acc)[2][2][4][2], const Unit& u, int wr, int wc, int fr, int fq, LAS unsigned char* dump) const {
        int row0 = u.pm * BM + wr * 64 + fr, col0 = u.pn * BM + wc * 32 + 8 * fq;
        asm volatile("" : "+v"(row0), "+v"(col0));
        float bv[2][8];
        if (mode == 1 || mode == 3) {
#pragma unroll
            for (int bj = 0; bj < 2; ++bj) { const f32x4 b0 = *(const f32x4*)(bias + col0 + bj * HALF), b1 = *(const f32x4*)(bias + col0 + bj * HALF + 4);
#pragma unroll
                for (int j = 0; j < 4; ++j) { bv[bj][j] = b0[j]; bv[bj][4 + j] = b1[j]; } }
        }
        if (mode != 0) {
#pragma unroll
            for (int ai = 0; ai < 2; ++ai)
#pragma unroll
                for (int m = 0; m < 4; ++m)
#pragma unroll
                    for (int bj = 0; bj < 2; ++bj) {
                        const size_t row = (size_t)(row0 + ai * HALF + m * 16); const int col = col0 + bj * HALF;
                        const void* p0 = (mode == 2) ? (resf ? (const void*)(resf + row * D + col) : (const void*)(io2 + row * D + col)) : (const void*)(ob + row * ldo + col);
                        __builtin_amdgcn_global_load_lds((const unsigned*)p0, (LAS unsigned*)dump, 16, 0, 0);
                        if (mode == 2 && aux) __builtin_amdgcn_global_load_lds((const unsigned*)(aux + row * D + col), (LAS unsigned*)dump, 16, 0, 0);
                    }
        }
#pragma unroll
        for (int aim = 0; aim < 4; ++aim) {
            const int ai = aim >> 1, mh = aim & 1;
            u32x4 L0[4], L1[4];
            if (mode != 0) {
#pragma unroll
                for (int m2 = 0; m2 < 2; ++m2)
#pragma unroll
                    for (int bj = 0; bj < 2; ++bj) {
                        const int m = mh * 2 + m2;
                        const size_t row = (size_t)(row0 + ai * HALF + m * 16); const int col = col0 + bj * HALF, e = m2 * 2 + bj;
                        if (mode == 1) L0[e] = *(const u32x4*)(ob + row * ldo + col);
                        else if (mode == 3) { L0[e] = *(const u32x4*)(ob + row * ldo + col);
                            if (col >= D) L1[e] = *(const u32x4*)(io2 + row * D + (col & (D - 1))); }
                        else { if (resf) { L0[e] = *(const u32x4*)(resf + row * D + col); L1[e] = *(const u32x4*)(resf + row * D + col + 4); }
                               else { L0[e] = *(const u32x4*)(io2 + row * D + col); if (aux) L1[e] = *(const u32x4*)(aux + row * D + col); } }
                    }
            }
#pragma unroll
            for (int m2 = 0; m2 < 2; ++m2)
#pragma unroll
                for (int bj = 0; bj < 2; ++bj) {
                    const int m = mh * 2 + m2;
                    const size_t row = (size_t)(row0 + ai * HALF + m * 16); const int col = col0 + bj * HALF, e = m2 * 2 + bj;
                    float v[8];
#pragma unroll
                    for (int j = 0; j < 4; ++j) { v[j] = acc[ai][bj][m][0][j]; v[4 + j] = acc[ai][bj][m][1][j]; }
                    if (mode == 0) {
                        if (act == 1) {
#pragma unroll
                            for (int j = 0; j < 8; ++j) { const float t = fmaxf(v[j], 0.f); v[j] = t * t; }
                        }
                        *(u32x4*)(ob + row * ldo + col) = pack8(v);
                    } else if (mode == 1) {
                        float a[8]; unpack8(L0[e], a);
#pragma unroll
                        for (int j = 0; j < 8; ++j) v[j] = sigmoidf_(v[j] + bv[bj][j]) * a[j];
                        *(u32x4*)(ob + row * ldo + col) = pack8(v);
                    } else if (mode == 3) {
                        float a[8]; unpack8(L0[e], a);
#pragma unroll
                        for (int j = 0; j < 8; ++j) v[j] = sigmoidf_(v[j] + bv[bj][j]) * a[j];
                        if (col >= D) { float q[8]; unpack8(L1[e], q);
#pragma unroll
                            for (int j = 0; j < 8; ++j) v[j] += q[j]; }
                        *(u32x4*)(io2 + row * D + (col & (D - 1))) = pack8(v);
                    } else {
                        float r[8];
                        if (resf) {
#pragma unroll
                            for (int j = 0; j < 4; ++j) { r[j] = __uint_as_float(L0[e][j]); r[4 + j] = __uint_as_float(L1[e][j]); } }
                        else unpack8(L0[e], r);
#pragma unroll
                        for (int j = 0; j < 8; ++j) v[j] += ALPHA * r[j];
                        if (aux) { float a[8]; unpack8(L1[e], a);
#pragma unroll
                            for (int j = 0; j < 8; ++j) v[j] += a[j]; }
                        *(u32x4*)(io2 + row * D + col) = pack8(v);
                    }
                }
        }
    }
};

__device__ __forceinline__ void gemm_phase(const int tid, LAS unsigned char* lds, const Gemm g, const StaticOrder& S, const Epi& E) {
    const int wid = __builtin_amdgcn_readfirstlane(tid >> 6), lane = tid & 63, wr = wid >> 2, wc = wid & 3, fr = lane & 15, fq = lane >> 4;
    const int K = g.K, nt = K / BK;
    unsigned voffA, voffB;
    { int R, C; stage_rc(tid * 16, R, C); const int Rb = (R & ~31) + perm32(R & 31); voffA = (unsigned)(R * g.lda + C) * 2u; voffB = (unsigned)(Rb * g.ldb + C) * 2u; }
    const size_t p2A = (size_t)64 * g.lda * 2, p2B = (size_t)64 * g.ldb * 2;
    const size_t kstep = (size_t)(BK * 2);
    const size_t hstepA = (size_t)HALF * g.lda * 2, hstepB = (size_t)HALF * g.ldb * 2;
    const size_t tstepA = 2 * hstepA, tstepB = 2 * hstepB;
    const unsigned ldsw = (unsigned)wid * 1024u;
    const int aoff = lds_byte(wr * 64 + fr, fq * 8), boff = lds_byte(wc * 32 + fr, fq * 8);
#define XA voffA
#define XB voffB
#define p2XA p2A
#define p2XB p2B
#define PG8_SA(b, h) (((b) * 2 + (h)) * HTB)
#define PG8_SB(b, h) ((4 + (b) * 2 + (h)) * HTB)
#define PG8_STAGE(bufoff, gbase, voff) do { \
        __builtin_amdgcn_global_load_lds((const unsigned*)((const char*)(gbase) + (voff)), (LAS unsigned*)(lds + (bufoff) + ldsw), 16, 0, 0); \
        __builtin_amdgcn_global_load_lds((const unsigned*)((const char*)(gbase) + p2##voff + (voff)), (LAS unsigned*)(lds + (bufoff) + ldsw + 8192), 16, 0, 0); } while (0)
#define PG8_LDA(dst, b, h) do { _Pragma("unroll") for (int m = 0; m < 4; ++m) _Pragma("unroll") for (int k = 0; k < 2; ++k) dst[m][k] = *(const LAS bf16x8*)(lds + PG8_SA(b, h) + aoff + m * 2048 + k * 1024); } while (0)
#define PG8_LDB(dst, b, h) do { _Pragma("unroll") for (int n = 0; n < 2; ++n) _Pragma("unroll") for (int k = 0; k < 2; ++k) dst[n][k] = *(const LAS bf16x8*)(lds + PG8_SB(b, h) + boff + n * 2048 + k * 1024); } while (0)
#define PG8_MMA(ai, bj, At, Bt) do { __builtin_amdgcn_s_setprio(1); _Pragma("unroll") for (int m = 0; m < 4; ++m) _Pragma("unroll") for (int n = 0; n < 2; ++n) _Pragma("unroll") for (int k = 0; k < 2; ++k) \
        acc[ai][bj][m][n] = __builtin_amdgcn_mfma_f32_16x16x32_bf16(Bt[n][k], At[m][k], acc[ai][bj][m][n], 0, 0, 0); __builtin_amdgcn_s_setprio(0); } while (0)
#define PG8_WAIT_V(n) asm volatile("s_waitcnt vmcnt(" #n ")" ::: "memory")
#define PG8_WAIT_L(n) asm volatile("s_waitcnt lgkmcnt(" #n ")" ::: "memory")
#define PG8_BAR __builtin_amdgcn_s_barrier()
#define PG8_SCHED __builtin_amdgcn_sched_barrier(0)
    Unit cur, nxt; int ui = 0;
    if (!S.next(0, cur)) return;
    f32x4 acc[2][2][4][2];
    bf16x8 At[4][2], B0[2][2], B1[2][2];
    const char* cA = (const char*)g.A + (size_t)cur.pm * tstepA; const char* cB = (const char*)g.Bt + (size_t)cur.pn * tstepB;
    PG8_STAGE(PG8_SB(0, 0), cB, XB); PG8_STAGE(PG8_SB(0, 1), cB + hstepB, XB); PG8_STAGE(PG8_SA(0, 0), cA, XA); PG8_STAGE(PG8_SA(0, 1), cA + hstepA, XA);
    if (wr == 1) PG8_BAR;
    PG8_WAIT_V(2); PG8_BAR;
    PG8_STAGE(PG8_SB(1, 0), cB + kstep, XB); PG8_STAGE(PG8_SA(1, 0), cA + kstep, XA); PG8_STAGE(PG8_SB(1, 1), cB + hstepB + kstep, XB);
    PG8_WAIT_V(6); PG8_BAR;
    PG8_SCHED;
#pragma unroll
    for (int a = 0; a < 2; ++a)
#pragma unroll
        for (int b = 0; b < 2; ++b)
#pragma unroll
            for (int m = 0; m < 4; ++m)
#pragma unroll
                for (int n = 0; n < 2; ++n) acc[a][b][m][n] = (f32x4){0.f, 0.f, 0.f, 0.f};
    for (;;) {
        const bool has_next = S.next(ui + 1, nxt);
        const char* nA = has_next ? (const char*)g.A + (size_t)nxt.pm * tstepA : cA; const char* nB = has_next ? (const char*)g.Bt + (size_t)nxt.pn * tstepB : cB;
        for (int t = 0; t < nt; t += 2) {
            const bool last = (t == nt - 2);
            const char* a1 = cA + (size_t)(t + 1) * kstep;
            const char* a2 = last ? nA : cA + (size_t)(t + 2) * kstep; const char* b2 = last ? nB : cB + (size_t)(t + 2) * kstep;
            const char* a3 = a2 + kstep; const char* b3 = b2 + kstep;
            PG8_LDB(B0, 0, 0); PG8_LDB(B1, 0, 1); PG8_SCHED; PG8_LDA(At, 0, 0); PG8_STAGE(PG8_SA(1, 1), a1 + hstepA, XA);
            PG8_WAIT_V(8); PG8_WAIT_L(0); PG8_BAR; PG8_MMA(0, 0, At, B0); PG8_MMA(0, 1, At, B1); PG8_BAR; PG8_SCHED;
            PG8_LDA(At, 0, 1); PG8_STAGE(PG8_SB(0, 0), b2, XB); PG8_STAGE(PG8_SB(0, 1), b2 + hstepB, XB); PG8_STAGE(PG8_SA(0, 0), a2, XA);
            PG8_WAIT_V(8); PG8_WAIT_L(0); PG8_BAR; PG8_MMA(1, 0, At, B0); PG8_MMA(1, 1, At, B1); PG8_BAR; PG8_SCHED;
            PG8_LDB(B0, 1, 0); PG8_LDB(B1, 1, 1); PG8_SCHED; PG8_LDA(At, 1, 0); PG8_STAGE(PG8_SA(0, 1), a2 + hstepA, XA);
            PG8_WAIT_V(8); PG8_WAIT_L(0); PG8_BAR; PG8_MMA(0, 0, At, B0); PG8_MMA(0, 1, At, B1); PG8_BAR; PG8_SCHED;
            PG8_LDA(At, 1, 1); PG8_STAGE(PG8_SB(1, 0), b3, XB); PG8_STAGE(PG8_SB(1, 1), b3 + hstepB, XB); PG8_STAGE(PG8_SA(1, 0), a3, XA);
            PG8_WAIT_V(8); PG8_WAIT_L(0); PG8_BAR; PG8_MMA(1, 0, At, B0); PG8_MMA(1, 1, At, B1); PG8_BAR; PG8_SCHED;
        }
        if (wr == 0) PG8_BAR;
        E(acc, cur, wr, wc, fr, fq, lds + 131088 + ldsw);
        if (!has_next) break;
#pragma unroll
        for (int a = 0; a < 2; ++a)
#pragma unroll
            for (int b = 0; b < 2; ++b)
#pragma unroll
                for (int m = 0; m < 4; ++m)
#pragma unroll
                    for (int n = 0; n < 2; ++n) acc[a][b][m][n] = (f32x4){0.f, 0.f, 0.f, 0.f};
        cur = nxt; cA = nA; cB = nB; ++ui;
        if (wr == 1) PG8_BAR;
    }
    PG8_WAIT_V(0);
    PG8_BAR;
#undef PG8_SA
#undef PG8_SB
#undef PG8_STAGE
#undef PG8_LDA
#undef PG8_LDB
#undef PG8_MMA
#undef PG8_WAIT_V
#undef PG8_WAIT_L
#undef PG8_BAR
#undef PG8_SCHED
}
}

#define LDS_BARRIER() do { asm volatile("s_waitcnt lgkmcnt(0)" ::: "memory"); __builtin_amdgcn_s_barrier(); asm volatile("" ::: "memory"); } while (0)

__device__ __forceinline__ void tconv(const int tid_, const int bid_, const int gdim_, float* tile, const float* __restrict__ src, int K, int N, bf16_t* __restrict__ dst, int ldd) {
    const int tn = N / 64, nt = (K / 64) * tn;
    const int r = tid_ >> 3, c = (tid_ & 7) * 8;
    int t = bid_;
    f32x4 a, b;
    if (t < nt) { const f32x4* s = (const f32x4*)(src + (size_t)((t / tn) * 64 + r) * N + (t % tn) * 64 + c); a = s[0]; b = s[1]; }
    for (; t < nt; t += gdim_) {
        const int k0 = (t / tn) * 64, n0 = (t % tn) * 64;
#pragma unroll
        for (int j = 0; j < 4; ++j) { tile[r * 65 + c + j] = a[j]; tile[r * 65 + c + 4 + j] = b[j]; }
        const int t2 = t + gdim_;
        if (t2 < nt) { const f32x4* s = (const f32x4*)(src + (size_t)((t2 / tn) * 64 + r) * N + (t2 % tn) * 64 + c); a = s[0]; b = s[1]; }
        LDS_BARRIER();
        float v[8];
#pragma unroll
        for (int j = 0; j < 8; ++j) v[j] = tile[(c + j) * 65 + r];
        *(u32x4*)(dst + (size_t)(n0 + r) * ldd + k0 + c) = pack8(v);
        LDS_BARRIER();
    }
}
__device__ __forceinline__ void econv(const int tid_, const int bid_, const int gdim_, const float* __restrict__ src, bf16_t* __restrict__ dst, int n) {
    const int nth = gdim_ * 512 * 8;
    for (int i = (bid_ * 512 + tid_) * 8; i < n; i += nth) {
        const f32x4 a = *(const f32x4*)(src + i), b = *(const f32x4*)(src + i + 4);
        float v[8] = {a[0], a[1], a[2], a[3], b[0], b[1], b[2], b[3]};
        *(u32x4*)(dst + i) = pack8(v);
    }
}

__device__ __forceinline__ void ln_phase(const int tid_, const int bid_, const int gdim_, bf16_t* xio, const float* __restrict__ g, const float* __restrict__ b, float* outf) {
    const int lane = tid_ & 63, wid = tid_ >> 6;
    const int nw = gdim_ * 8;
    float gg[16], bb[16];
#pragma unroll
    for (int i = 0; i < 2; ++i)
#pragma unroll
        for (int j = 0; j < 8; ++j) { gg[i * 8 + j] = g[i * 512 + lane * 8 + j]; bb[i * 8 + j] = b[i * 512 + lane * 8 + j]; }
    for (int row = bid_ * 8 + wid; row < MTOK; row += nw) {
        bf16_t* p = xio + (size_t)row * D + lane * 8;
        float v[16]; unpack8(*(const u32x4*)p, v); unpack8(*(const u32x4*)(p + 512), v + 8);
        float s = 0.f;
#pragma unroll
        for (int j = 0; j < 16; ++j) s += v[j];
        const float mean = wave_sum(s) * (1.0f / D);
        float q = 0.f;
#pragma unroll
        for (int j = 0; j < 16; ++j) { const float d = v[j] - mean; q += d * d; }
        const float rstd = __builtin_amdgcn_rsqf(wave_sum(q) * (1.0f / D) + LN_EPS);
#pragma unroll
        for (int j = 0; j < 16; ++j) v[j] = (v[j] - mean) * rstd * gg[j] + bb[j];
        if (!outf) { *(u32x4*)p = pack8(v); *(u32x4*)(p + 512) = pack8(v + 8); }
        else { float* o = outf + (size_t)row * D + lane * 8;
            *(f32x4*)o = (f32x4){v[0], v[1], v[2], v[3]}; *(f32x4*)(o + 4) = (f32x4){v[4], v[5], v[6], v[7]};
            *(f32x4*)(o + 512) = (f32x4){v[8], v[9], v[10], v[11]}; *(f32x4*)(o + 516) = (f32x4){v[12], v[13], v[14], v[15]}; }
    }
}

__device__ __forceinline__ void sconv_phase(const int tid_, const int bid_, const int gdim_, const bf16_t* __restrict__ h, const float* __restrict__ w  , bf16_t* __restrict__ yb) {
    const size_t nth = (size_t)gdim_ * 512;
    for (size_t idx = (size_t)bid_ * 512 + tid_; idx < (size_t)MTOK * 64; idx += nth) {
        const int tok = (int)(idx >> 6), c8 = (int)(idx & 63) * 8, t = tok & (SEQ - 1);
        float acc[8];
#pragma unroll
        for (int j = 0; j < 8; ++j) acc[j] = 0.f;
#pragma unroll
        for (int k = 0; k < 3; ++k) {
            const int tt = t - 2 + k;
            if (tt >= 0) {
                const bf16_t* row = h + (size_t)(tok - 2 + k) * INC + COL_B;
                float cgv[8], xh[8]; unpack8(*(const u32x4*)(row + 512 + c8), cgv); unpack8(*(const u32x4*)(row + 1024 + c8), xh);
                const f32x4 w0 = *(const f32x4*)(w + k * 512 + c8), w1 = *(const f32x4*)(w + k * 512 + c8 + 4);
#pragma unroll
                for (int j = 0; j < 4; ++j) { acc[j] += w0[j] * (cgv[j] * xh[j]); acc[4 + j] += w1[j] * (cgv[4 + j] * xh[4 + j]); }
            }
        }
        float bg[8]; unpack8(*(const u32x4*)(h + (size_t)tok * INC + COL_B + c8), bg);
#pragma unroll
        for (int j = 0; j < 8; ++j) acc[j] *= bg[j];
        *(u32x4*)(yb + (size_t)tok * DMIX + c8) = pack8(acc);
    }
}

__device__ __forceinline__ void vtrans_phase(const int tid_, const int it0, const int gdim_, bf16_t* tile  , const bf16_t* __restrict__ h, bf16_t* __restrict__ vt) {
    const int r = tid_ >> 3, c = (tid_ & 7) * 8;
    int it = it0;
    u32x4 u;
    if (it < BATCH * 8 * 32) { const int bh = it >> 5, tc = it & 31; u = *(const u32x4*)(h + (size_t)((bh >> 3) * SEQ + tc * 64 + r) * INC + COL_D + 1024 + (bh & 7) * 64 + c); }
    for (; it < BATCH * 8 * 32; it += gdim_) {
        const int bh = it >> 5, tc = it & 31;
#pragma unroll
        for (int j = 0; j < 4; ++j) { tile[(c + 2 * j) * 72 + r] = (bf16_t)(u[j] & 0xffffu); tile[(c + 2 * j + 1) * 72 + r] = (bf16_t)(u[j] >> 16); }
        const int i2 = it + gdim_;
        if (i2 < BATCH * 8 * 32) { const int bh2 = i2 >> 5, tc2 = i2 & 31; u = *(const u32x4*)(h + (size_t)((bh2 >> 3) * SEQ + tc2 * 64 + r) * INC + COL_D + 1024 + (bh2 & 7) * 64 + c); }
        LDS_BARRIER();
        *(u32x4*)(vt + (size_t)(bh * 64 + r) * SEQ + tc * 64 + c) = *(const u32x4*)(tile + r * 72 + c);
        LDS_BARRIER();
    }
}

__device__ __forceinline__ void attn_phase(const int tid_, const int bid_, const int gdim_, unsigned char* ldsb, const bf16_t* __restrict__ h, const bf16_t* __restrict__ vt, const float* __restrict__ rel_bias, bf16_t* __restrict__ yd) {
    constexpr float L2E = 1.4426950408889634f;
    float* rb = (float*)(ldsb + 131088);
    for (int i = tid_; i < 8 * 257; i += 512) rb[i] = rel_bias[i] * L2E;
    __syncthreads();
    const int lane = tid_ & 63, wid = __builtin_amdgcn_readfirstlane(tid_ >> 6), lr = lane & 15, quad = lane >> 4;
    const int nw = gdim_ * 8;
    unsigned char* wl = ldsb + wid * 16384;
    const int krow = lane >> 3, kchunk = (lane & 7) ^ (krow & 7);
    const int vrow = lane >> 2, vchunk = (lane & 3) ^ ((vrow >> 2) & 3);
    int koff[2][2], voff[4];
#pragma unroll
    for (int tt = 0; tt < 2; ++tt)
#pragma unroll
        for (int dh = 0; dh < 2; ++dh) { const int row = (lr >> 2) * 8 + tt * 4 + (lr & 3); koff[tt][dh] = row * 128 + (((dh * 4 + quad) ^ (row & 7)) * 16); }
#pragma unroll
    for (int dt = 0; dt < 4; ++dt) { const int d = dt * 16 + lr; voff[dt] = 4096 + d * 64 + ((quad ^ ((d >> 2) & 3)) * 16); }
    int it = 0;
    const int vbid = (bid_ & 7) * (gdim_ >> 3) + (bid_ >> 3);
    for (int item0 = vbid * 8 + wid; item0 < BATCH * 8 * 32; item0 += nw, ++it) {
        const int c = ((item0 & 31) + 8 * it) & 31, hh = (item0 >> 5) & 7, b = item0 >> 8;
        const int q0 = c * 64;
        const bf16_t* hb = h + (size_t)b * SEQ * INC + COL_D + hh * 64;
        bf16x8 qf[4][2];
        asm volatile("s_waitcnt lgkmcnt(0)" ::: "memory");
        {
            const bf16_t* qg = hb + (size_t)(q0 + krow) * INC + kchunk * 8;
#pragma unroll
            for (int i = 0; i < 8; ++i) __builtin_amdgcn_global_load_lds((const unsigned*)(qg + (size_t)i * 8 * INC), (LAS unsigned*)(wl + 8192 + i * 1024), 16, 0, 0);
        }
        const bf16_t* vb = vt + (size_t)((b * 8 + hh) * 64) * SEQ;
        const float* rbh = rb + hh * 257;
        const float cb2 = rbh[256];
        f32x4 oacc[4][4];
#pragma unroll
        for (int qi = 0; qi < 4; ++qi)
#pragma unroll
            for (int dt = 0; dt < 4; ++dt) oacc[qi][dt] = (f32x4){0.f, 0.f, 0.f, 0.f};
        float mrun[4] = {-1e30f, -1e30f, -1e30f, -1e30f}, lsum[4] = {0.f, 0.f, 0.f, 0.f};
        const int kstart = (c > 8 ? c - 8 : 0) * 64, kend = c * 64 + 64;
        const bf16_t* kg = hb + 512 + (size_t)krow * INC + kchunk * 8;
        const bf16_t* vg = vb + (size_t)vrow * SEQ + vchunk * 8;
#define AT_LOAD(buf, kt) do { _Pragma("unroll") for (int i = 0; i < 4; ++i) \
                __builtin_amdgcn_global_load_lds((const unsigned*)(kg + (size_t)((kt) + i * 8) * INC), (LAS unsigned*)(wl + (buf) * 8192 + i * 1024), 16, 0, 0); \
            _Pragma("unroll") for (int i = 0; i < 4; ++i) \
                __builtin_amdgcn_global_load_lds((const unsigned*)(vg + (size_t)i * 16 * SEQ + (kt)), (LAS unsigned*)(wl + (buf) * 8192 + 4096 + i * 1024), 16, 0, 0); } while (0)
#define AT_COMPUTE(buf, kt) do { \
            const bool far_ = ((kt) + 31 + 128 <= q0); \
            const unsigned char* bb_ = wl + (buf) * 8192; \
            bf16x8 kf[2][2], vf[4]; \
            _Pragma("unroll") for (int tt = 0; tt < 2; ++tt) _Pragma("unroll") for (int dh = 0; dh < 2; ++dh) kf[tt][dh] = *(const bf16x8*)(bb_ + koff[tt][dh]); \
            _Pragma("unroll") for (int dt = 0; dt < 4; ++dt) vf[dt] = *(const bf16x8*)(bb_ + voff[dt]); \
            _Pragma("unroll") for (int qi = 0; qi < 4; ++qi) { \
                f32x4 s[2]; \
                _Pragma("unroll") for (int tt = 0; tt < 2; ++tt) { f32x4 a = (f32x4){0.f, 0.f, 0.f, 0.f}; \
                    a = __builtin_amdgcn_mfma_f32_16x16x32_bf16(kf[tt][0], qf[qi][0], a, 0, 0, 0); \
                    a = __builtin_amdgcn_mfma_f32_16x16x32_bf16(kf[tt][1], qf[qi][1], a, 0, 0, 0); s[tt] = a; } \
                float mx = -1e30f; \
                if (far_) { _Pragma("unroll") for (int tt = 0; tt < 2; ++tt) _Pragma("unroll") for (int j = 0; j < 4; ++j) { const float v = s[tt][j] * (0.125f * L2E) + cb2; s[tt][j] = v; mx = fmaxf(mx, v); } } \
                else { const int qpos = q0 + qi * 16 + lr; float bz[8]; \
                    _Pragma("unroll") for (int tt = 0; tt < 2; ++tt) _Pragma("unroll") for (int j = 0; j < 4; ++j) { \
                        int rel = qpos - ((kt) + quad * 8 + tt * 4 + j); rel = rel > 128 ? 128 : (rel < -128 ? -128 : rel); bz[tt * 4 + j] = rbh[rel + 128]; } \
                    _Pragma("unroll") for (int tt = 0; tt < 2; ++tt) _Pragma("unroll") for (int j = 0; j < 4; ++j) { \
                        const float v = s[tt][j] * (0.125f * L2E) + bz[tt * 4 + j]; s[tt][j] = v; mx = fmaxf(mx, v); } } \
                mx = fmaxf(mx, shflx(mx, lane, 16)); mx = fmaxf(mx, shflx(mx, lane, 32)); \
                const float mnew = fmaxf(mrun[qi], mx), sc = __builtin_amdgcn_exp2f(mrun[qi] - mnew); \
                mrun[qi] = mnew; \
                float ps = 0.f; float pv[8]; \
                _Pragma("unroll") for (int tt = 0; tt < 2; ++tt) _Pragma("unroll") for (int j = 0; j < 4; ++j) { const float p = __builtin_amdgcn_exp2f(s[tt][j] - mnew); pv[tt * 4 + j] = p; ps += p; } \
                lsum[qi] = lsum[qi] * sc + ps; \
                const u32x4 pu = pack8(pv); bf16x8 pf; __builtin_memcpy(&pf, &pu, 16); \
                _Pragma("unroll") for (int dt = 0; dt < 4; ++dt) { \
                    f32x4 o = oacc[qi][dt]; \
                    _Pragma("unroll") for (int j = 0; j < 4; ++j) o[j] *= sc; \
                    oacc[qi][dt] = __builtin_amdgcn_mfma_f32_16x16x32_bf16(vf[dt], pf, o, 0, 0, 0); } \
            } } while (0)
        AT_LOAD(0, kstart);
        asm volatile("s_waitcnt vmcnt(8)" ::: "memory");
#pragma unroll
        for (int qi = 0; qi < 4; ++qi)
#pragma unroll
            for (int dh = 0; dh < 2; ++dh) { const int row = qi * 16 + lr; qf[qi][dh] = *(const bf16x8*)(wl + 8192 + row * 128 + (((dh * 4 + quad) ^ (row & 7)) * 16)); }
        asm volatile("s_waitcnt lgkmcnt(0)" ::: "memory");
        for (int kt0 = kstart; kt0 < kend; kt0 += 64) {
            AT_LOAD(1, kt0 + 32);
            asm volatile("s_waitcnt vmcnt(8)" ::: "memory");
            AT_COMPUTE(0, kt0);
            if (kt0 + 64 < kend) { AT_LOAD(0, kt0 + 64); asm volatile("s_waitcnt vmcnt(8)" ::: "memory"); }
            else asm volatile("s_waitcnt vmcnt(0)" ::: "memory");
            AT_COMPUTE(1, kt0 + 32);
        }
#undef AT_LOAD
#undef AT_COMPUTE
#pragma unroll
        for (int qi = 0; qi < 4; ++qi) {
            float l = lsum[qi]; l += shflx(l, lane, 16); l += shflx(l, lane, 32);
            const float inv = __builtin_amdgcn_rcpf(l);
#pragma unroll
            for (int dt = 0; dt < 4; ++dt) {
                u32x2 pk; pk[0] = cvt_pk_bf16(oacc[qi][dt][0] * inv, oacc[qi][dt][1] * inv); pk[1] = cvt_pk_bf16(oacc[qi][dt][2] * inv, oacc[qi][dt][3] * inv);
                *(u32x2*)(wl + (qi * 16 + lr) * 136 + (dt * 16 + quad * 4) * 2) = pk;
            }
        }
        asm volatile("" ::: "memory");
#pragma unroll
        for (int i = 0; i < 8; ++i) {
            const int row = i * 8 + krow;
            *(u32x4*)(yd + (size_t)(b * SEQ + q0 + row) * DMIX + hh * 64 + (lane & 7) * 8) = *(const u32x4*)(wl + row * 136 + (lane & 7) * 16);
        }
    }
    __syncthreads();
}

__device__ __forceinline__ int lru_phase(const int tid_, const int bid_, const int gdim_, unsigned char* lds, const bf16_t* __restrict__ h, const float* __restrict__ conv_w, const float* __restrict__ conv_b,
                          const float* __restrict__ wrp, const float* __restrict__ brp, const float* __restrict__ wip, const float* __restrict__ bip,
                          const float* __restrict__ lam, bf16_t* __restrict__ ya_out, bf16_t* __restrict__ vt, const float* __restrict__ scw  , bf16_t* __restrict__ yb_out) {
    bf16_t* vtile = (bf16_t*)(lds + 131088);
    bf16_t* WrT = (bf16_t*)lds;
    bf16_t* WiT = WrT + 64 * 72;
    bf16_t* xcb = WiT + 64 * 72;
    bf16_t* xraw = xcb + 64 * 72;
    bf16_t* yraw = xraw + 67 * 64 + 64;
    float* xcf = (float*)(yraw + 64 * 64);
    float* abuf = xcf + 4096;
    float* ubuf = abuf + 4096;
    float* ibuf = ubuf + 4096;
    float* hbuf = ibuf + 4096;
    float* gbuf = xcf;
    const int tid = tid_, lane = tid & 63, wid = tid >> 6, lr = lane & 15, quad = lane >> 4;
    const int sc_nth = gdim_ * 512; int sc_idx = bid_ * 512 + tid;
    int vt_it = bid_; u32x4 vt_u = (u32x4){0u, 0u, 0u, 0u};
    if (vt_it < BATCH * 8 * 32) { const int bh = vt_it >> 5, tcv = vt_it & 31; vt_u = *(const u32x4*)(h + (size_t)((bh >> 3) * SEQ + tcv * 64 + (tid >> 3)) * INC + COL_D + 1024 + (bh & 7) * 64 + (tid & 7) * 8); }
    for (int item = bid_; item < BATCH * 8; item += gdim_) {
        const int b = item >> 3, g = item & 7;
        __syncthreads();
        for (int e = tid; e < 4096; e += 512) { const int i = e >> 6, j = e & 63;
            WrT[j * 72 + i] = f2bf(wrp[(size_t)g * 4096 + e]); WiT[j * 72 + i] = f2bf(wip[(size_t)g * 4096 + e]); }
        const int ch = tid & 63, trow = tid >> 6;
        const int cg_ = g * 64 + ch;
        const float cw0 = conv_w[cg_], cw1 = conv_w[512 + cg_], cw2 = conv_w[1024 + cg_], cw3 = conv_w[1536 + cg_], cb = conv_b[cg_];
        const int r8 = tid >> 3, pc = (tid & 7) * 8;
        const bf16_t* hrow = h + (size_t)(b * SEQ + r8) * INC + COL_A + g * 64 + pc;
        u32x4 xa16 = *(const u32x4*)hrow, ya16 = *(const u32x4*)(hrow + 512), prev16 = (u32x4){0u, 0u, 0u, 0u};
        float hstate = 0.f;
        for (int tc = 0; tc < SEQ / 64; ++tc) {
            const int t0 = tc * 64;
            *(u32x4*)(xraw + (3 + r8) * 64 + pc) = xa16; *(u32x4*)(yraw + r8 * 64 + pc) = ya16;
            if (r8 >= 61) *(u32x4*)(xraw + (r8 - 61) * 64 + pc) = prev16;
            prev16 = xa16;
            if (tc + 1 < SEQ / 64) { const bf16_t* nx = hrow + (size_t)(t0 + 64) * INC; xa16 = *(const u32x4*)nx; ya16 = *(const u32x4*)(nx + 512); }
            const bool sc_ok = sc_idx < MTOK * 64;
            const int sc_tok = sc_idx >> 6, sc_c8 = (sc_idx & 63) * 8, sc_t = sc_tok & (SEQ - 1);
            u32x4 sc_bg, sc_c[3], sc_x[3];
            if (sc_ok) {
                sc_bg = *(const u32x4*)(h + (size_t)sc_tok * INC + COL_B + sc_c8);
#pragma unroll
                for (int k = 0; k < 3; ++k) { const bf16_t* row = h + (size_t)(sc_tok - (sc_t - 2 + k >= 0 ? 2 - k : 0)) * INC + COL_B; sc_c[k] = *(const u32x4*)(row + 512 + sc_c8); sc_x[k] = *(const u32x4*)(row + 1024 + sc_c8); }
            }
            const int vt_cur = vt_it;
            if (vt_cur < BATCH * 8 * 32) {
#pragma unroll
                for (int j = 0; j < 4; ++j) { vtile[(pc + 2 * j) * 72 + r8] = (bf16_t)(vt_u[j] & 0xffffu); vtile[(pc + 2 * j + 1) * 72 + r8] = (bf16_t)(vt_u[j] >> 16); }
                vt_it += gdim_;
                if (vt_it < BATCH * 8 * 32) { const int bh = vt_it >> 5, tcv = vt_it & 31; vt_u = *(const u32x4*)(h + (size_t)((bh >> 3) * SEQ + tcv * 64 + r8) * INC + COL_D + 1024 + (bh & 7) * 64 + pc); }
            }
            LDS_BARRIER();
            if (vt_cur < BATCH * 8 * 32) { const int bh = vt_cur >> 5, tcv = vt_cur & 31;
                *(u32x4*)(vt + (size_t)(bh * 64 + r8) * SEQ + tcv * 64 + pc) = *(const u32x4*)(vtile + r8 * 72 + pc); }
#pragma unroll
            for (int i = 0; i < 8; ++i) {
                const int tl = trow + 8 * i;
                const float x3 = bf2f(xraw[tl * 64 + ch]), x2 = bf2f(xraw[(tl + 1) * 64 + ch]), x1 = bf2f(xraw[(tl + 2) * 64 + ch]), x0 = bf2f(xraw[(tl + 3) * 64 + ch]);
                const float xc = cw3 * x0 + cw2 * x1 + cw1 * x2 + cw0 * x3 + cb;
                xcf[tl * 64 + ch] = xc; xcb[tl * 72 + ch] = f2bf(xc);
            }
            LDS_BARRIER();
            {
                const int tt = wid & 3, which = wid >> 2;
                const bf16_t* WT = which ? WiT : WrT;
                const bf16x8 a0 = *(const bf16x8*)(xcb + (tt * 16 + lr) * 72 + quad * 8), a1 = *(const bf16x8*)(xcb + (tt * 16 + lr) * 72 + 32 + quad * 8);
#pragma unroll
                for (int jt = 0; jt < 4; ++jt) {
                    const bf16x8 b0 = *(const bf16x8*)(WT + (jt * 16 + lr) * 72 + quad * 8), b1 = *(const bf16x8*)(WT + (jt * 16 + lr) * 72 + 32 + quad * 8);
                    f32x4 cacc = (f32x4){0.f, 0.f, 0.f, 0.f};
                    cacc = __builtin_amdgcn_mfma_f32_16x16x32_bf16(a0, b0, cacc, 0, 0, 0);
                    cacc = __builtin_amdgcn_mfma_f32_16x16x32_bf16(a1, b1, cacc, 0, 0, 0);
                    const int j = jt * 16 + lr, cj = g * 64 + j;
                    if (which == 0) {
                        const float bias = brp[cj], lm = lam[cj];
                        const float sp = fmaxf(-lm, 0.f) + flog1p_small(fexp(-fabsf(lm)));
#pragma unroll
                        for (int jj = 0; jj < 4; ++jj) {
                            const int tl = tt * 16 + quad * 4 + jj;
                            const float r = sigmoidf_(cacc[jj] + bias);
                            const float la = -8.0f * r * sp;
                            abuf[tl * 64 + j] = fexp(la);
                            ubuf[tl * 64 + j] = __builtin_amdgcn_sqrtf(fneg_expm1(2.0f * la)) * xcf[tl * 64 + j];
                        }
                    } else {
                        const float bias = bip[cj];
#pragma unroll
                        for (int jj = 0; jj < 4; ++jj) { const int tl = tt * 16 + quad * 4 + jj; ibuf[tl * 64 + j] = sigmoidf_(cacc[jj] + bias); }
                    }
                }
            }
            LDS_BARRIER();
            if (wid == 0) {
#pragma unroll 8
                for (int tl = 0; tl < 64; ++tl) { hstate = abuf[tl * 64 + lane] * hstate + ubuf[tl * 64 + lane] * ibuf[tl * 64 + lane]; hbuf[tl * 64 + lane] = hstate; }
            } else {
                for (int e = tid - 64; e < 4096; e += 448) {
                    const float y = bf2f(yraw[e]);
                    gbuf[e] = 0.5f * y * (1.0f + ftanh(0.7978845608028654f * (y + 0.044715f * y * y * y)));
                }
            }
            LDS_BARRIER();
            {
                float o[8];
                const f32x4 h0 = *(const f32x4*)(hbuf + r8 * 64 + pc), h1 = *(const f32x4*)(hbuf + r8 * 64 + pc + 4);
                const f32x4 g0 = *(const f32x4*)(gbuf + r8 * 64 + pc), g1 = *(const f32x4*)(gbuf + r8 * 64 + pc + 4);
#pragma unroll
                for (int j = 0; j < 4; ++j) { o[j] = h0[j] * g0[j]; o[4 + j] = h1[j] * g1[j]; }
                *(u32x4*)(ya_out + (size_t)(b * SEQ + t0 + r8) * DMIX + g * 64 + pc) = pack8(o);
            }
            if (sc_ok) {
                float acc[8], bg[8];
#pragma unroll
                for (int j = 0; j < 8; ++j) acc[j] = 0.f;
#pragma unroll
                for (int k = 0; k < 3; ++k) {
                    const float mk = (sc_t - 2 + k >= 0) ? 1.f : 0.f;
                    float cgv[8], xh[8]; unpack8(sc_c[k], cgv); unpack8(sc_x[k], xh);
                    const f32x4 w0 = *(const f32x4*)(scw + k * 512 + sc_c8), w1 = *(const f32x4*)(scw + k * 512 + sc_c8 + 4);
#pragma unroll
                    for (int j = 0; j < 4; ++j) { acc[j] += (mk * w0[j]) * (cgv[j] * xh[j]); acc[4 + j] += (mk * w1[j]) * (cgv[4 + j] * xh[4 + j]); }
                }
                unpack8(sc_bg, bg);
#pragma unroll
                for (int j = 0; j < 8; ++j) acc[j] *= bg[j];
                *(u32x4*)(yb_out + (size_t)sc_tok * DMIX + sc_c8) = pack8(acc);
            }
            sc_idx += sc_nth;
        }
    }
    for (; sc_idx < MTOK * 64; sc_idx += sc_nth) {
        const int tok = sc_idx >> 6, c8 = (sc_idx & 63) * 8, t = tok & (SEQ - 1);
        float acc[8], bg[8];
#pragma unroll
        for (int j = 0; j < 8; ++j) acc[j] = 0.f;
#pragma unroll
        for (int k = 0; k < 3; ++k) {
            if (t - 2 + k >= 0) {
                const bf16_t* row = h + (size_t)(tok - 2 + k) * INC + COL_B;
                float cgv[8], xh[8]; unpack8(*(const u32x4*)(row + 512 + c8), cgv); unpack8(*(const u32x4*)(row + 1024 + c8), xh);
                const f32x4 w0 = *(const f32x4*)(scw + k * 512 + c8), w1 = *(const f32x4*)(scw + k * 512 + c8 + 4);
#pragma unroll
                for (int j = 0; j < 4; ++j) { acc[j] += w0[j] * (cgv[j] * xh[j]); acc[4 + j] += w1[j] * (cgv[4 + j] * xh[4 + j]); }
            }
        }
        unpack8(*(const u32x4*)(h + (size_t)tok * INC + COL_B + c8), bg);
#pragma unroll
        for (int j = 0; j < 8; ++j) acc[j] *= bg[j];
        *(u32x4*)(yb_out + (size_t)tok * DMIX + c8) = pack8(acc);
    }
    __syncthreads();
    return vt_it;
}

constexpr int RT = 16, REC = 456;
__device__ __forceinline__ float dpp_x1(float v) { return __int_as_float(__builtin_amdgcn_update_dpp(0, __float_as_int(v), 0xB1, 0xF, 0xF, true)); }
__device__ __forceinline__ float dpp_x2(float v) { return __int_as_float(__builtin_amdgcn_update_dpp(0, __float_as_int(v), 0x4E, 0xF, 0xF, true)); }
__device__ __forceinline__ void rwkv_phase(const int tid_, const int bid_, const int gdim_, unsigned char* lds, const bf16_t* __restrict__ h, const float* __restrict__ mu, const float* __restrict__ w0p, const float* __restrict__ w2p,
                           const float* __restrict__ a0p, const float* __restrict__ a2p, const float* __restrict__ g2p, const float* __restrict__ kkp, const float* __restrict__ kap,
                           const float* __restrict__ rkp, const float* __restrict__ gng, const float* __restrict__ gnb, bf16_t* __restrict__ yc) {
    bf16_t* W2T = (bf16_t*)lds;
    bf16_t* A2T = W2T + 64 * 72;
    bf16_t* G2T = A2T + 64 * 72;
    bf16_t* linb = G2T + 64 * 136;
    float* lo = (float*)(linb + 4 * 4 * 264);
    float* rec = lo + 4 * 4 * 192;
    float* obuf = rec + 2 * RT * REC;
    const int tid = tid_, lane = tid & 63, wid = __builtin_amdgcn_readfirstlane(tid >> 6);
    constexpr int NC = SEQ / RT;
    for (int item = bid_; item < BATCH * 8; item += gdim_) {
        const int b = item >> 3, hh = item & 7, hj = hh * 64 + lane;
        __syncthreads();
        for (int e = tid; e < 4096; e += 512) { const int i = e >> 6, j = e & 63; W2T[j * 72 + i] = f2bf(w2p[i * 512 + hh * 64 + j]); A2T[j * 72 + i] = f2bf(a2p[i * 512 + hh * 64 + j]); }
        for (int e = tid; e < 8192; e += 512) { const int i = e >> 6, j = e & 63; G2T[j * 136 + i] = f2bf(g2p[i * 512 + hh * 64 + j]); }
        __syncthreads();
        if (wid < 4) {
            const int r = lane >> 2, kq = lane & 3, row = wid * 16 + r;
            f32x2 S[8];
#pragma unroll
            for (int i = 0; i < 8; ++i) S[i] = (f32x2){0.f, 0.f};
            LDS_BARRIER();
            for (int c = 0; c < NC; ++c) {
                const float* R0 = rec + (c & 1) * RT * REC + kq * 16;
                float* ob = obuf + (c & 1) * RT * 64 + row;
                f32x4 dt[2][8], up[2][12]; float vv[2]; f32x2 scs[2];
#define RW_LOAD(buf, t) do { const float* Rk = R0 + (t) * REC; _Pragma("unroll") for (int i = 0; i < 4; ++i) { dt[buf][i] = *(const f32x4*)(Rk + 4 * i); dt[buf][4 + i] = *(const f32x4*)(Rk + 64 + 4 * i); } \
                    vv[buf] = Rk[320 - kq * 16 + row]; scs[buf] = *(const f32x2*)(Rk + 448 - kq * 16); \
                    _Pragma("unroll") for (int q = 0; q < 3; ++q) _Pragma("unroll") for (int i = 0; i < 4; ++i) up[buf][q * 4 + i] = *(const f32x4*)(Rk + 128 + q * 64 + 4 * i); } while (0)
                RW_LOAD(0, 0);
#pragma unroll
                for (int t = 0; t < RT; ++t) {
                    const int cb = t & 1;
                    if (t + 1 < RT) RW_LOAD(cb ^ 1, t + 1);
                    const float vval = vv[cb];
                    f32x2 sa0 = (f32x2){0.f, 0.f}, sa1 = (f32x2){0.f, 0.f}, yp0 = (f32x2){0.f, 0.f}, yp1 = (f32x2){0.f, 0.f};
#pragma unroll
                    for (int i = 0; i < 4; ++i) {
                        const f32x4 ah = dt[cb][i], wr = dt[cb][4 + i];
                        sa0 += S[2 * i] * (f32x2){ah[0], ah[1]}; sa1 += S[2 * i + 1] * (f32x2){ah[2], ah[3]};
                        yp0 += S[2 * i] * (f32x2){wr[0], wr[1]}; yp1 += S[2 * i + 1] * (f32x2){wr[2], wr[3]};
                    }
                    sa0 += sa1; yp0 += yp1;
                    float sa = sa0[0] + sa0[1], yp = yp0[0] + yp0[1];
                    sa += dpp_x1(sa); yp += dpp_x1(yp);
                    sa += dpp_x2(sa); yp += dpp_x2(yp);
                    if (kq == 0) ob[t * 64] = yp + sa * scs[cb][0] + vval * scs[cb][1];
                    const f32x2 sav = (f32x2){sa, sa}, vvv = (f32x2){vval, vval};
#pragma unroll
                    for (int i = 0; i < 4; ++i) {
                        const f32x4 dc = up[cb][i], bb = up[cb][4 + i], kp = up[cb][8 + i];
                        S[2 * i] = S[2 * i] * (f32x2){dc[0], dc[1]} + sav * (f32x2){bb[0], bb[1]} + vvv * (f32x2){kp[0], kp[1]};
                        S[2 * i + 1] = S[2 * i + 1] * (f32x2){dc[2], dc[3]} + sav * (f32x2){bb[2], bb[3]} + vvv * (f32x2){kp[2], kp[3]};
                    }
                }
#undef RW_LOAD
                LDS_BARRIER();
            }
        } else {
            const int p = wid - 4, lr = lane & 15, quad = lane >> 4;
            bf16_t* lb = linb + p * 4 * 264;
            float* lop = lo + p * 4 * 192;
            const float mu_r = mu[hj], mu_k = mu[512 + hj], mu_v = mu[1024 + hj];
            float mu_l[4];
#pragma unroll
            for (int q = 0; q < 4; ++q) mu_l[q] = mu[1536 + lane + 64 * q];
            const float w0 = w0p[hj], a0 = a0p[hj], k_k = kkp[hj], k_a = kap[hj], r_k = rkp[hj], gn_g = gng[hj], gn_b = gnb[hj];
            const bf16_t* hC = h + (size_t)b * SEQ * INC + COL_C;
            unsigned zraw[5][7];
#define RW_GLOAD(cn) do { _Pragma("unroll") for (int rw = 0; rw < 5; ++rw) { const int t = (cn) * RT + p * 4 + rw - 1; \
                    const bf16_t* ptr = hC + (size_t)(t < 0 ? 0 : t) * INC; \
                    zraw[rw][0] = ptr[hj]; zraw[rw][1] = ptr[512 + hj]; zraw[rw][2] = ptr[1024 + hj]; \
                    _Pragma("unroll") for (int q = 0; q < 4; ++q) zraw[rw][3 + q] = ptr[1536 + lane + 64 * q]; } } while (0)
            RW_GLOAD(0);
            for (int c = -1; c < NC; ++c) {
                const bool do_prep = (c + 1 < NC), do_post = (c >= 1);
                float cr[5], ck[5], cv[5], cl[5][4];
#pragma unroll
                for (int rw = 0; rw < 5; ++rw) { cr[rw] = bf2f(zraw[rw][0]); ck[rw] = bf2f(zraw[rw][1]); cv[rw] = bf2f(zraw[rw][2]);
#pragma unroll
                    for (int q = 0; q < 4; ++q) cl[rw][q] = bf2f(zraw[rw][3 + q]); }
                if (c == -1 && p == 0) { cr[0] = 0.f; ck[0] = 0.f; cv[0] = 0.f; cl[0][0] = 0.f; cl[0][1] = 0.f; cl[0][2] = 0.f; cl[0][3] = 0.f; }
                if (c + 2 < NC) RW_GLOAD(c + 2);
                if (do_post) {
                    const float* Rb = rec + ((c - 1) & 1) * RT * REC;
                    const float* ob = obuf + ((c - 1) & 1) * RT * 64;
                    float ov[4], sm[8];
#pragma unroll
                    for (int u = 0; u < 4; ++u) { ov[u] = ob[(p * 4 + u) * 64 + lane]; sm[2 * u] = ov[u]; sm[2 * u + 1] = ov[u] * ov[u]; }
                    wave_sum_n<8>(sm);
#pragma unroll
                    for (int u = 0; u < 4; ++u) {
                        const int tt = p * 4 + u, t = (c - 1) * RT + tt;
                        const float* R = Rb + tt * REC;
                        const float mean = sm[2 * u] * (1.0f / 64.0f), var = fmaxf(sm[2 * u + 1] * (1.0f / 64.0f) - mean * mean, 0.f);
                        float o = (ov[u] - mean) * __builtin_amdgcn_rsqf(var + GN_EPS) * gn_g + gn_b;
                        o += R[450] * R[320 + lane];
                        yc[(size_t)(b * SEQ + t) * DMIX + hj] = f2bf(o * R[384 + lane]);
                    }
                }
                if (do_prep) {
                    float rr[4], kx[4], vx[4];
#pragma unroll
                    for (int u = 0; u < 4; ++u) {
                        rr[u] = cr[u + 1] + (cr[u] - cr[u + 1]) * mu_r; kx[u] = ck[u + 1] + (ck[u] - ck[u + 1]) * mu_k; vx[u] = cv[u + 1] + (cv[u] - cv[u + 1]) * mu_v;
#pragma unroll
                        for (int q = 0; q < 4; ++q) {
                            const float z = cl[u + 1][q] + (cl[u][q] - cl[u + 1][q]) * mu_l[q];
                            const float val = (q == 0) ? ftanh(z) : (q == 1 ? z : sigmoidf_(z));
                            lb[u * 264 + lane + 64 * q] = f2bf(val);
                        }
                    }
                    asm volatile("s_waitcnt lgkmcnt(0)" ::: "memory");
                    bf16x8 af[8];
#pragma unroll
                    for (int k8 = 0; k8 < 8; ++k8) af[k8] = *(const bf16x8*)(lb + (lane & 3) * 264 + k8 * 32 + quad * 8);
#pragma unroll
                    for (int jt = 0; jt < 4; ++jt) {
                        f32x4 cw = (f32x4){0.f, 0.f, 0.f, 0.f}, ca = cw, cgm = cw;
#pragma unroll
                        for (int kh = 0; kh < 2; ++kh) {
                            cw = __builtin_amdgcn_mfma_f32_16x16x32_bf16(af[kh], *(const bf16x8*)(W2T + (jt * 16 + lr) * 72 + kh * 32 + quad * 8), cw, 0, 0, 0);
                            ca = __builtin_amdgcn_mfma_f32_16x16x32_bf16(af[2 + kh], *(const bf16x8*)(A2T + (jt * 16 + lr) * 72 + kh * 32 + quad * 8), ca, 0, 0, 0);
                        }
#pragma unroll
                        for (int kh = 0; kh < 4; ++kh)
                            cgm = __builtin_amdgcn_mfma_f32_16x16x32_bf16(af[4 + kh], *(const bf16x8*)(G2T + (jt * 16 + lr) * 136 + kh * 32 + quad * 8), cgm, 0, 0, 0);
                        if (quad == 0) {
#pragma unroll
                            for (int jj = 0; jj < 4; ++jj) { lop[jj * 192 + jt * 16 + lr] = cw[jj]; lop[jj * 192 + 64 + jt * 16 + lr] = ca[jj]; lop[jj * 192 + 128 + jt * 16 + lr] = cgm[jj]; }
                        }
                    }
                    asm volatile("s_waitcnt lgkmcnt(0)" ::: "memory");
                    float* Rb = rec + ((c + 1) & 1) * RT * REC;
                    float dcy[4], av[4], kqv[4], kpv[4], ggv[4], red[16];
#pragma unroll
                    for (int u = 0; u < 4; ++u) {
                        const float wl = w0 + lop[u * 192 + lane], ap = a0 + lop[u * 192 + 64 + lane]; ggv[u] = lop[u * 192 + 128 + lane];
                        const float z = -wl;
                        const float sp = fmaxf(z, 0.f) + flog(1.0f + fexp(-fabsf(z)));
                        dcy[u] = fexp(-fexp(-sp - 0.5f));
                        av[u] = sigmoidf_(ap);
                        kqv[u] = kx[u] * k_k;
                        kpv[u] = kx[u] * (1.0f + (av[u] - 1.0f) * k_a);
                        red[4 * u] = kqv[u] * kqv[u]; red[4 * u + 1] = kqv[u] * av[u] * rr[u]; red[4 * u + 2] = kpv[u] * rr[u]; red[4 * u + 3] = rr[u] * kpv[u] * r_k;
                    }
                    wave_sum_n<16>(red);
#pragma unroll
                    for (int u = 0; u < 4; ++u) {
                        const int tt = p * 4 + u;
                        const float inv = __builtin_amdgcn_rcpf(fmaxf(__builtin_amdgcn_sqrtf(red[4 * u]), 1e-12f));
                        const float kkn = kqv[u] * inv;
                        float* R = Rb + tt * REC;
                        R[lane] = -kkn; R[64 + lane] = dcy[u] * rr[u]; R[128 + lane] = dcy[u]; R[192 + lane] = kkn * av[u]; R[256 + lane] = kpv[u]; R[320 + lane] = vx[u]; R[384 + lane] = ggv[u];
                        if (lane == 0) { R[448] = red[4 * u + 1] * inv; R[449] = red[4 * u + 2]; R[450] = red[4 * u + 3]; }
                    }
                }
                LDS_BARRIER();
            }
#undef RW_GLOAD
            {
                const float* Rb = rec + ((NC - 1) & 1) * RT * REC;
                const float* ob = obuf + ((NC - 1) & 1) * RT * 64;
                float ov[4], sm[8];
#pragma unroll
                for (int u = 0; u < 4; ++u) { ov[u] = ob[(p * 4 + u) * 64 + lane]; sm[2 * u] = ov[u]; sm[2 * u + 1] = ov[u] * ov[u]; }
                wave_sum_n<8>(sm);
#pragma unroll
                for (int u = 0; u < 4; ++u) {
                    const int tt = p * 4 + u, t = (NC - 1) * RT + tt;
                    const float* R = Rb + tt * REC;
                    const float mean = sm[2 * u] * (1.0f / 64.0f), var = fmaxf(sm[2 * u + 1] * (1.0f / 64.0f) - mean * mean, 0.f);
                    float o = (ov[u] - mean) * __builtin_amdgcn_rsqf(var + GN_EPS) * gn_g + gn_b;
                    o += R[450] * R[320 + lane];
                    yc[(size_t)(b * SEQ + t) * DMIX + hj] = f2bf(o * R[384 + lane]);
                }
            }
        }
    }
    __syncthreads();
}

#define XB_TMO      128
#define XB_XCNT(j)  (256  + 64 * (j))
#define XB_XSUB(j)  (1280 + 64 * (j))
#define XB_XGEN(j)  (2304 + 64 * (j))
#define XB_TOP      3328
#define XB_TOPGEN   3392
#define XCD_BAR_WORDS 3456
#define XB_SPIN_CAP (1u << 18)
__device__ __forceinline__ unsigned xb_ld(unsigned* p)              { return __hip_atomic_load(p, __ATOMIC_RELAXED, __HIP_MEMORY_SCOPE_AGENT); }
__device__ __forceinline__ unsigned xb_add(unsigned* p, unsigned v) { return __hip_atomic_fetch_add(p, v, __ATOMIC_RELAXED, __HIP_MEMORY_SCOPE_AGENT); }
__device__ __forceinline__ unsigned xb_xcc_id() { return (unsigned)__builtin_amdgcn_s_getreg((3 << 11) | 20) & 0xFu; }
#define XB_SPIN(cond, bar) do { unsigned _sp = 0; while (cond) { __builtin_amdgcn_s_sleep(1); \
    if ((++_sp & 255u) == 0u) { if (xb_ld(&(bar)[XB_TMO])) break; if (_sp > XB_SPIN_CAP) { atomicAdd(&(bar)[XB_TMO], 1u); break; } } } } while (0)
struct XcdBarrier { unsigned* bar; unsigned x; volatile LAS unsigned* st; };
__device__ __forceinline__ XcdBarrier xcd_barrier_post(unsigned* bar, volatile LAS unsigned* st) {
    XcdBarrier b; b.bar = bar; b.x = xb_xcc_id(); b.st = st;
    if (threadIdx.x == 0) (void)xb_add(&bar[XB_XCNT(b.x)], 1u);
    return b;
}
__device__ __forceinline__ void xcd_barrier_complete(unsigned* bar, unsigned x, unsigned& nloc, unsigned& nx) {
    const unsigned G = gridDim.x;
    unsigned sum, cnt, mine, sp = 0u;
    for (;;) {
        sum = 0u; cnt = 0u; mine = 0u;
#pragma unroll
        for (unsigned j = 0; j < 16; ++j) { const unsigned c = xb_ld(&bar[XB_XCNT(j)]); sum += c; cnt += (c > 0u) ? 1u : 0u; mine = (j == x) ? c : mine; }
        if (sum == G) break;
        __builtin_amdgcn_s_sleep(1);
        if ((++sp & 255u) == 0u) { if (xb_ld(&bar[XB_TMO])) break; if (sp > XB_SPIN_CAP) { atomicAdd(&bar[XB_TMO], 1u); break; } }
    }
    nloc = mine > 0u ? mine : 1u; nx = cnt > 0u ? cnt : 1u;
}
__device__ __forceinline__ void xcd_barrier(const XcdBarrier& b, const int tid) {
    asm volatile("s_waitcnt vmcnt(0)" ::: "memory");
    __syncthreads();
    if (tid == 0) {
        unsigned* bar = b.bar;
        __builtin_amdgcn_s_waitcnt(0);
        unsigned nloc = b.st[0], nx = b.st[1];
        if (nloc == 0u) { xcd_barrier_complete(bar, b.x, nloc, nx); b.st[0] = nloc; b.st[1] = nx; }
        const unsigned old = xb_add(&bar[XB_XSUB(b.x)], 1u);
        const unsigned gen = old / nloc;
        if (old + 1u == (gen + 1u) * nloc) {
            __builtin_amdgcn_fence(__ATOMIC_RELEASE, "agent");
            asm volatile("s_waitcnt vmcnt(0)" ::: "memory");
            const unsigned og = xb_add(&bar[XB_TOP], 1u);
            const unsigned tg = og / nx;
            if (og + 1u == (tg + 1u) * nx) xb_add(&bar[XB_TOPGEN], 1u);
            else XB_SPIN(xb_ld(&bar[XB_TOPGEN]) == tg, bar);
            __builtin_amdgcn_fence(__ATOMIC_ACQUIRE, "agent");
            xb_add(&bar[XB_XGEN(b.x)], 1u);
            asm volatile("s_waitcnt vmcnt(0)" ::: "memory");
        } else {
            XB_SPIN(xb_ld(&bar[XB_XGEN(b.x)]) == gen, bar);
            __builtin_amdgcn_fence(__ATOMIC_ACQUIRE, "agent");
            asm volatile("s_waitcnt vmcnt(0)" ::: "memory");
        }
    }
    __syncthreads();
}

constexpr int NPH = 12;
__global__ void __launch_bounds__(512, 2) mega(Params P, int ph_lo, int ph_hi) {
    extern __shared__ __attribute__((aligned(16))) unsigned char shm[];
    LAS unsigned char* lds = (LAS unsigned char*)shm;
    cg::grid_group grid = cg::this_grid();
    const int swid = __builtin_amdgcn_readfirstlane((int)threadIdx.x >> 6);
    volatile LAS unsigned* xst = (volatile LAS unsigned*)(lds + 131072);
    if (threadIdx.x < 2) xst[threadIdx.x] = 0u;
    __syncthreads();
    const XcdBarrier xbar = xcd_barrier_post((unsigned*)(P.ws + WS_BAR), xst);
    unsigned char* ws = P.ws;
    bf16_t* xb = (bf16_t*)(ws + WS_XB);
    bf16_t* wt = (bf16_t*)(ws + WS_WT);
    bf16_t* pb = (bf16_t*)(ws + WS_PB);
    bf16_t* hbuf = (bf16_t*)(ws + WS_H);
    bf16_t* vt = (bf16_t*)(ws + WS_VT);
    bf16_t* pq = hbuf;
    bf16_t* ubuf = hbuf;
    bf16_t* plb = (bf16_t*)(ws + WS_H + 512 * MiB);
    bf16_t* ybase = (bf16_t*)P.out;
    bf16_t* mb = plb;
    bf16_t* ple = (bf16_t*)P.out;
    for (int ph = ph_lo; ph < ph_hi; ++ph) {
        const int l = ph / NPH, k = ph % NPH;
        if (k == 9) continue;
        const int njobs = (k == 1 || k == 6 || k == 10) ? 1 : (k == 4 ? 4 : ((k == 8 || k == 5) ? 2 : 0));
        for (int rep = 0; rep < ((k == REPK) ? REPN : 1); ++rep) {
        int bid_ = blockIdx.x, gdim_ = gridDim.x; asm volatile("" : "+s"(bid_)); asm volatile("" : "+s"(gdim_)); int z_ = 0; asm volatile("" : "+s"(z_));
        int tid_ = (swid << 6) + (int)__builtin_amdgcn_mbcnt_hi(~0u, __builtin_amdgcn_mbcnt_lo(~0u, (unsigned)z_)); asm volatile("" : "+v"(tid_));
        if (njobs) {
            for (int n = 0; n < njobs; ++n) {
                pg8::Epi E; E.mode = 0; E.act = 0; E.ob = nullptr; E.ldo = 0; E.bias = nullptr; E.io2 = nullptr; E.resf = nullptr; E.aux = nullptr;
                pg8::Gemm g; g.M = MTOK; g.A = xb; g.lda = D; g.K = D; g.Bt = wt; g.ldb = D; g.N = D;
                int merge = 0;
                if (k == 1) { E.ob = hbuf; E.ldo = INC; g.Bt = wt + WO_IN; g.N = INC; }
                else if (k == 4) { E.ob = pq + (size_t)n * D; E.ldo = 4 * D; g.A = ybase + (size_t)n * MTOK * DMIX; g.lda = DMIX; g.K = DMIX; g.Bt = wt + WO_B + (size_t)n * D * DMIX; g.ldb = DMIX; }
                else if (k == 5 && n == 0) { E.mode = 3; E.ob = pq; E.ldo = 4 * D; E.bias = P.in[25 + z_] + (size_t)l * 4 * D; E.io2 = mb; g.Bt = wt + WO_G; g.N = 4 * D; merge = 1; }
                else if (k == 5) { E.ob = ple; E.ldo = D; g.A = pb; g.lda = DPLE; g.K = DPLE; g.Bt = wt + WO_PLE; g.ldb = DPLE; }
                else if (k == 6) { E.mode = 2; E.io2 = xb; if (l == 0) E.resf = P.in[0 + z_]; g.A = mb; g.Bt = wt + WO_OUT4; }
                else if (k == 8 && n == 0) { E.act = 1; E.ob = ubuf; E.ldo = DFF; g.Bt = wt + WO_FF1; g.N = DFF; }
                else if (k == 8) { E.mode = 1; E.ob = ple; E.ldo = D; E.bias = P.in[33 + z_] + (size_t)l * D; g.Bt = wt + WO_PLEG; }
                else { E.mode = 2; E.io2 = xb; E.aux = ple; g.A = ubuf; g.lda = DFF; g.K = DFF; g.Bt = wt + WO_FF2; g.ldb = DFF; }
                pg8::StaticOrder S; S.init(g.M, g.N, gdim_, bid_, merge);
                pg8::gemm_phase(tid_, lds, g, S, E);
                __syncthreads();
            }
        } else if (k == 0) {
            float* tile = (float*)shm;
            tconv(tid_, bid_, gdim_, tile, P.in[2 + z_] + (size_t)l * D * INC, D, INC, wt + WO_IN, D);
            for (int n = 0; n < 4; ++n) tconv(tid_, bid_, gdim_, tile, P.in[24 + z_] + ((size_t)l * 4 + n) * D * D, D, D, wt + WO_G + (size_t)n * D * D, D);
            for (int n = 0; n < 4; ++n) tconv(tid_, bid_, gdim_, tile, P.in[23 + z_] + ((size_t)l * 4 + n) * DMIX * D, DMIX, D, wt + WO_B + (size_t)n * D * DMIX, DMIX);
            tconv(tid_, bid_, gdim_, tile, P.in[26 + z_] + (size_t)l * D * D, D, D, wt + WO_OUT4, D);
            tconv(tid_, bid_, gdim_, tile, P.in[29 + z_] + (size_t)l * D * DFF, D, DFF, wt + WO_FF1, D);
            tconv(tid_, bid_, gdim_, tile, P.in[30 + z_] + (size_t)l * DFF * D, DFF, D, wt + WO_FF2, DFF);
            tconv(tid_, bid_, gdim_, tile, P.in[31 + z_] + (size_t)l * DPLE * D, DPLE, D, wt + WO_PLE, DPLE);
            tconv(tid_, bid_, gdim_, tile, P.in[32 + z_] + (size_t)l * D * D, D, D, wt + WO_PLEG, D);
            econv(tid_, bid_, gdim_, P.in[1 + z_] + (size_t)l * MTOK * DPLE, pb, MTOK * DPLE);
            if (l == 0) econv(tid_, bid_, gdim_, P.in[0 + z_], xb, MTOK * D);
        } else if (k == 2) {
            int vt_next = bid_;
            for (int r2 = 0; r2 < REP_LRU; ++r2) { int t2_ = tid_, b2_ = bid_; asm volatile("" : "+v"(t2_)); asm volatile("" : "+s"(b2_));
            vt_next = lru_phase(t2_, b2_, gdim_, shm, hbuf, P.in[3 + z_] + (size_t)l * 4 * DMIX, P.in[4 + z_] + (size_t)l * DMIX, P.in[5 + z_] + (size_t)l * 8 * 4096, P.in[6 + z_] + (size_t)l * DMIX,
                      P.in[7 + z_] + (size_t)l * 8 * 4096, P.in[8 + z_] + (size_t)l * DMIX, P.in[9 + z_] + (size_t)l * DMIX, ybase, vt, P.in[10 + z_] + (size_t)l * 3 * DMIX, ybase + (size_t)1 * MTOK * DMIX);
            }
            for (int r2 = 0; r2 < REP_RWKV; ++r2) { int t2_ = tid_, b2_ = bid_; asm volatile("" : "+v"(t2_)); asm volatile("" : "+s"(b2_));
            rwkv_phase(t2_, b2_, gdim_, shm, hbuf, P.in[11 + z_] + (size_t)l * 1792, P.in[12 + z_] + (size_t)l * DMIX, P.in[13 + z_] + (size_t)l * 64 * DMIX, P.in[14 + z_] + (size_t)l * DMIX,
                       P.in[15 + z_] + (size_t)l * 64 * DMIX, P.in[16 + z_] + (size_t)l * 128 * DMIX, P.in[17 + z_] + (size_t)l * DMIX, P.in[18 + z_] + (size_t)l * DMIX,
                       P.in[19 + z_] + (size_t)l * DMIX, P.in[20 + z_] + (size_t)l * DMIX, P.in[21 + z_] + (size_t)l * DMIX, ybase + (size_t)2 * MTOK * DMIX);
            }
            for (int r2 = 0; r2 < REP_SV; ++r2) { int t2_ = tid_, b2_ = bid_; asm volatile("" : "+v"(t2_)); asm volatile("" : "+s"(b2_));
            vtrans_phase(t2_, vt_next, gdim_, (bf16_t*)shm, hbuf, vt);
            }
        } else if (k == 3) {
            attn_phase(tid_, bid_, gdim_, shm, hbuf, vt, P.in[22 + z_], ybase + (size_t)3 * MTOK * DMIX);
        } else if (k == 7) {
            ln_phase(tid_, bid_, gdim_, xb, P.in[27 + z_] + (size_t)l * D, P.in[28 + z_] + (size_t)l * D, nullptr);
        } else {
            ln_phase(tid_, bid_, gdim_, xb, P.in[34 + z_] + (size_t)l * D, P.in[35 + z_] + (size_t)l * D, l == DEPTH - 1 ? P.out : nullptr);
        }
        }
        if (ph + 1 < ph_hi) { if (ph_hi < 0) grid.sync();
            int zb_ = 0; asm volatile("" : "+s"(zb_)); const int tb_ = (swid << 6) + (int)__builtin_amdgcn_mbcnt_hi(~0u, __builtin_amdgcn_mbcnt_lo(~0u, (unsigned)zb_)); xcd_barrier(xbar, tb_); }
    }
}

extern "C" void kernel_launch(void* const* d_in, const int* in_sizes, int n_in, void* d_out, int out_size, void* d_ws, size_t ws_size, hipStream_t stream) {
    static int grid = 0;
    if (grid == 0) {
        int dev = 0, cus = 0, per_cu = 0;
        hipGetDevice(&dev);
        hipDeviceGetAttribute(&cus, hipDeviceAttributeMultiprocessorCount, dev);
        hipFuncSetAttribute((const void*)mega, hipFuncAttributeMaxDynamicSharedMemorySize, LDS_BYTES);
        hipOccupancyMaxActiveBlocksPerMultiprocessor(&per_cu, (const void*)mega, 512, LDS_BYTES);
        if (per_cu < 1) { fprintf(stderr, "kernel_launch: occupancy query says %d blocks/CU\n", per_cu); per_cu = 1; }
        (void)hipGetLastError();
        grid = cus * 1;
        if (n_in != 36 || ws_size < 1013 * MiB) fprintf(stderr, "kernel_launch: unexpected n_in %d / ws_size %zu\n", n_in, ws_size);
    }
    (void)hipMemsetAsync((char*)d_ws + WS_BAR, 0, XCD_BAR_WORDS * sizeof(unsigned), stream);
    Params p{};
    for (int i = 0; i < 36; ++i) p.in[i] = (const float*)d_in[i];
    p.out = (float*)d_out; p.ws = (unsigned char*)d_ws;
#if ONE_LAUNCH
    int lo = 0, hi = DEPTH * NPH;
    void* args[] = {&p, &lo, &hi};
    hipError_t e = hipLaunchCooperativeKernel((const void*)mega, dim3(grid), dim3(512), args, LDS_BYTES, stream);
    if (e != hipSuccess) fprintf(stderr, "cooperative launch failed: %s (grid %d)\n", hipGetErrorString(e), grid);
#else
    for (int ph = 0; ph < DEPTH * NPH; ++ph) hipLaunchKernelGGL(mega, dim3(grid), dim3(512), LDS_BYTES, stream, p, ph, ph + 1);
#endif
}
```
